# Optimizing an MI355X kernel written in HIP

```python
import jax, jax.numpy as jnp
from jax import lax
import numpy as np

D_MODEL = 2048
BATCH = 4
SEQ = 2048
DEPTH = 1

CTX_LEN = 256
GRID_W = 64
EPS = 1e-6

M_HEADS = 8
M_DQK = 128
M_DV = 256
M_CHUNK = 64

A_HEADS = 16
A_KV_HEADS = 4
A_GROUP = A_HEADS // A_KV_HEADS
A_DH = 128
WINDOW = 128
A_BLOCK = 128
ROPE_HALF = A_DH // 4
ROPE_BASE = 10000.0

N_GROUPS = 8
EXPERTS_PER_GROUP = 8
N_EXPERTS = N_GROUPS * EXPERTS_PER_GROUP
TOP_K = 2
D_EXPERT = 1024
MOE_BLOCK = 128

M_QK_W = M_HEADS * M_DQK
M_V_W = M_HEADS * M_DV
A_Q_W = A_HEADS * A_DH
A_KV_W = A_KV_HEADS * A_DH
IN_SIZES = (M_QK_W, M_QK_W, M_V_W, M_V_W, 4 * M_HEADS, A_Q_W, A_KV_W, A_KV_W, 2 * D_MODEL)
IN_WIDTH = sum(IN_SIZES)
IN_SPLITS = [sum(IN_SIZES[:i]) for i in range(1, len(IN_SIZES))]

kernel_name = "hybrid_mlstm_swa_hmoe_prefix_block"

F32 = jnp.float32


def rms_norm(x, g):
    xf = x.astype(F32)
    y = xf * lax.rsqrt(jnp.mean(xf * xf, axis=-1, keepdims=True) + EPS)
    return (y * g.astype(F32)).astype(x.dtype)


def adaln(cvec, w_mod, b_mod):
    return jnp.split(jax.nn.silu(cvec) @ w_mod + b_mod, 6, axis=-1)


def modulate(h, shift, scale):
    return h * (1 + scale) + shift


def to_heads(t, n_heads, d):
    b, n, _ = t.shape
    return t.reshape(b, n, n_heads, d).transpose(0, 2, 1, 3)


def from_heads(t):
    b, h, n, d = t.shape
    return t.transpose(0, 2, 1, 3).reshape(b, n, h * d)


def flip_t(t):
    return jnp.flip(t, axis=2)


def axial_rope_tables(n_tokens):
    rows = n_tokens // GRID_W
    row = jnp.repeat(jnp.arange(rows, dtype=F32), GRID_W)
    col = jnp.tile(jnp.arange(GRID_W, dtype=F32), rows)
    inv_freq = ROPE_BASE ** (-jnp.arange(ROPE_HALF, dtype=F32) / ROPE_HALF)
    ang = jnp.stack([row[:, None] * inv_freq, col[:, None] * inv_freq], axis=1)
    return jnp.cos(ang), jnp.sin(ang)


def apply_axial_rope(t, cos, sin):
    b, h, n, d = t.shape
    tt = t.astype(F32).reshape(b, h, n, 2, 2, ROPE_HALF)
    t1, t2 = tt[..., 0, :], tt[..., 1, :]
    out = jnp.stack([t1 * cos - t2 * sin, t2 * cos + t1 * sin], axis=-2)
    return out.reshape(b, h, n, d).astype(t.dtype)


def mlstm_zero_state(b):
    return (jnp.zeros((b, M_HEADS, M_DQK, M_DV), F32),
            jnp.zeros((b, M_HEADS, M_DQK), F32),
            jnp.zeros((b, M_HEADS), F32))


def _mlstm_chunk_step(carry, inp):
    C, n, m = carry
    q, k, v, ig, lf = inp
    L = q.shape[2]
    b = jnp.cumsum(lf, axis=-1)
    d = b[..., :, None] - b[..., None, :] + ig[..., None, :]
    d = jnp.where(jnp.tril(jnp.ones((L, L), bool)), d, -jnp.inf)
    inter = b + m[..., None]
    m_t = jnp.maximum(inter, jnp.max(d, axis=-1))
    w_inter = jnp.exp(inter - m_t)
    s = jnp.einsum('bhtk,bhsk->bhts', q, k) * jnp.exp(d - m_t[..., None])
    num = w_inter[..., None] * jnp.einsum('bhtk,bhkv->bhtv', q, C) + jnp.einsum('bhts,bhsv->bhtv', s, v)
    qn = w_inter * jnp.einsum('bhtk,bhk->bht', q, n) + jnp.sum(s, axis=-1)
    h = num / jnp.maximum(jnp.abs(qn), jnp.exp(-m_t))[..., None]
    b_end = b[..., -1]
    dec = b_end[..., None] - b + ig
    m_new = jnp.maximum(b_end + m, jnp.max(dec, axis=-1))
    w_s = jnp.exp(dec - m_new[..., None])
    w_c = jnp.exp(b_end + m - m_new)
    C_new = w_c[..., None, None] * C + jnp.einsum('bhs,bhsk,bhsv->bhkv', w_s, k, v)
    n_new = w_c[..., None] * n + jnp.einsum('bhs,bhsk->bhk', w_s, k)
    return (C_new, n_new, m_new), h


def mlstm_scan(q, k, v, ig, lf, state):
    b, h, t, _ = q.shape
    nc = t // M_CHUNK

    def chunks(a):
        return jnp.moveaxis(a.reshape(b, h, nc, M_CHUNK, *a.shape[3:]), 2, 0)

    state, hs = lax.scan(_mlstm_chunk_step, state, (chunks(q), chunks(k), chunks(v), chunks(ig), chunks(lf)))
    return jnp.moveaxis(hs, 0, 2).reshape(b, h, t, M_DV), state


def mlstm_inputs(q, k, v, g, gate_b):
    b, t, _ = q.shape
    q = to_heads(q, M_HEADS, M_DQK).astype(F32)
    k = to_heads(k, M_HEADS, M_DQK).astype(F32) * (M_DQK ** -0.5)
    v = to_heads(v, M_HEADS, M_DV).astype(F32)
    g = g.reshape(b, t, 4, M_HEADS).astype(F32) + gate_b.astype(F32)
    g = jnp.transpose(g, (2, 0, 3, 1))
    return q, k, v, g


def bidir_mlstm(lat, cx, need_ctx_out):
    q, k, v, g = lat
    qc, kc, vc, gc = cx
    zero = mlstm_zero_state(q.shape[0])
    lsig = jax.nn.log_sigmoid
    hf_c, st_f = mlstm_scan(qc, kc, vc, gc[0], lsig(gc[1]), zero)
    hb_c, st_b = mlstm_scan(flip_t(qc), flip_t(kc), flip_t(vc), flip_t(gc[2]), flip_t(lsig(gc[3])), zero)
    hf, _ = mlstm_scan(q, k, v, g[0], lsig(g[1]), st_f)
    hb, _ = mlstm_scan(flip_t(q), flip_t(k), flip_t(v), flip_t(g[2]), flip_t(lsig(g[3])), st_b)
    h_lat = hf + flip_t(hb)
    h_ctx = hf_c + flip_t(hb_c) if need_ctx_out else None
    return h_lat, h_ctx


def mlstm_output(hh, o, norm_g, w_br):
    hh = hh * lax.rsqrt(jnp.mean(hh * hh, axis=-1, keepdims=True) + EPS)
    hh = from_heads(hh).astype(o.dtype) * norm_g * jax.nn.sigmoid(o)
    return hh @ w_br


def windowed_gqa_with_context(q, k, v, kc, vc, sink):
    b, _, s, _ = q.shape
    nb = s // A_BLOCK
    n_ctx = kc.shape[2]
    scale = A_DH ** -0.5
    qb = q.reshape(b, A_KV_HEADS, A_GROUP, nb, A_BLOCK, A_DH)

    def band(t):
        tb = jnp.pad(t, ((0, 0), (0, 0), (A_BLOCK, A_BLOCK), (0, 0))).reshape(b, A_KV_HEADS, nb + 2, A_BLOCK, A_DH)
        return jnp.concatenate([tb[:, :, :-2], tb[:, :, 1:-1], tb[:, :, 2:]], axis=3)

    kb, vb = band(k), band(v)
    s_loc = jnp.einsum('bhgnqd,bhnkd->bhgnqk', qb, kb).astype(F32) * scale
    s_ctx = jnp.einsum('bhgnqd,bhcd->bhgnqc', qb, kc).astype(F32) * scale
    blk = jnp.arange(nb)[:, None, None]
    qpos = blk * A_BLOCK + jnp.arange(A_BLOCK)[None, :, None]
    kpos = (blk - 1) * A_BLOCK + jnp.arange(3 * A_BLOCK)[None, None, :]
    valid = (jnp.abs(qpos - kpos) <= WINDOW) & (kpos >= 0) & (kpos < s)
    s_loc = jnp.where(valid, s_loc, -jnp.inf)
    s_sink = jnp.broadcast_to(sink.astype(F32).reshape(1, A_KV_HEADS, A_GROUP, 1, 1, 1), s_loc.shape[:-1] + (1,))
    p = jax.nn.softmax(jnp.concatenate([s_loc, s_ctx, s_sink], axis=-1), axis=-1)
    p_loc = p[..., :3 * A_BLOCK].astype(v.dtype)
    p_ctx = p[..., 3 * A_BLOCK:3 * A_BLOCK + n_ctx].astype(v.dtype)
    o = jnp.einsum('bhgnqk,bhnkd->bhgnqd', p_loc, vb) + jnp.einsum('bhgnqc,bhcd->bhgnqd', p_ctx, vc)
    return o.reshape(b, A_HEADS, s, A_DH)


def context_attention(qc, kc, vc, sink):
    b, _, t, _ = qc.shape
    qg = qc.reshape(b, A_KV_HEADS, A_GROUP, t, A_DH)
    sc = jnp.einsum('bhgqd,bhcd->bhgqc', qg, kc).astype(F32) * (A_DH ** -0.5)
    s_sink = jnp.broadcast_to(sink.astype(F32).reshape(1, A_KV_HEADS, A_GROUP, 1, 1), sc.shape[:-1] + (1,))
    p = jax.nn.softmax(jnp.concatenate([sc, s_sink], axis=-1), axis=-1)[..., :-1]
    o = jnp.einsum('bhgqc,bhcd->bhgqd', p.astype(vc.dtype), vc)
    return o.reshape(b, A_HEADS, t, A_DH)


def merge_branches(br_m, br_a, gbr, w_out):
    g_m, g_a = jnp.split(jax.nn.sigmoid(gbr), 2, axis=-1)
    return (g_m * br_m + g_a * br_a) @ w_out


def token_mixers(h, hc, cos, sin, w_in, gate_b, m_norm_g, sink, w_br_m, w_br_a, w_out, update_ctx):
    qm, km, vm, om, gm, qa, ka, va, gbr = jnp.split(h @ w_in, IN_SPLITS, axis=-1)
    qmc, kmc, vmc, omc, gmc, qac, kac, vac, gbrc = jnp.split(hc @ w_in, IN_SPLITS, axis=-1)
    hm, hmc = bidir_mlstm(mlstm_inputs(qm, km, vm, gm, gate_b), mlstm_inputs(qmc, kmc, vmc, gmc, gate_b), update_ctx)
    br_m = mlstm_output(hm, om, m_norm_g, w_br_m)
    q = apply_axial_rope(to_heads(qa, A_HEADS, A_DH), cos, sin)
    k = apply_axial_rope(to_heads(ka, A_KV_HEADS, A_DH), cos, sin)
    v = to_heads(va, A_KV_HEADS, A_DH)
    kc = to_heads(kac, A_KV_HEADS, A_DH)
    vc = to_heads(vac, A_KV_HEADS, A_DH)
    br_a = from_heads(windowed_gqa_with_context(q, k, v, kc, vc, sink)) @ w_br_a
    y = merge_branches(br_m, br_a, gbr, w_out)
    yc = None
    if update_ctx:
        br_mc = mlstm_output(hmc, omc, m_norm_g, w_br_m)
        br_ac = from_heads(context_attention(to_heads(qac, A_HEADS, A_DH), kc, vc, sink)) @ w_br_a
        yc = merge_branches(br_mc, br_ac, gbrc, w_out)
    return y, yc


def hierarchical_moe(h, w_rg, b_rg, w_re, b_re, w_g, w_u, w_d):
    t_tok, d = h.shape
    grp_logits = (h @ w_rg + b_rg).astype(F32)
    p_grp = jax.nn.softmax(grp_logits, axis=-1)
    g_sel = jnp.argmax(grp_logits, axis=-1)
    exp_logits = (h @ w_re + b_re).astype(F32).reshape(t_tok, N_GROUPS, EXPERTS_PER_GROUP)
    in_grp = jnp.take_along_axis(exp_logits, g_sel[:, None, None], axis=1)[:, 0]
    top_val, top_idx = lax.top_k(in_grp, TOP_K)
    w_top = jax.nn.softmax(top_val, axis=-1) * jnp.take_along_axis(p_grp, g_sel[:, None], axis=1)
    eid = (g_sel[:, None] * EXPERTS_PER_GROUP + top_idx).reshape(-1)
    n_assign = t_tok * TOP_K
    order = jnp.argsort(eid)
    sorted_eid = eid[order]
    tok = order // TOP_K
    w_sorted = w_top.reshape(-1)[order]
    counts = jnp.bincount(eid, length=N_EXPERTS)
    padded = ((counts + MOE_BLOCK - 1) // MOE_BLOCK) * MOE_BLOCK
    start = jnp.cumsum(counts) - counts
    pend = jnp.cumsum(padded)
    pstart = pend - padded
    dest = pstart[sorted_eid] + jnp.arange(n_assign) - start[sorted_eid]
    n_blocks = -(-(n_assign + N_EXPERTS * (MOE_BLOCK - 1)) // MOE_BLOCK)
    xbuf = jnp.zeros((n_blocks * MOE_BLOCK, d), h.dtype).at[dest].set(h[tok])
    blk_expert = jnp.minimum(jnp.searchsorted(pend, jnp.arange(n_blocks) * MOE_BLOCK, side='right'), N_EXPERTS - 1)

    def run_block(args):
        xb, e = args
        return (jax.nn.silu(xb @ w_g[e]) * (xb @ w_u[e])) @ w_d[e]

    ybuf = lax.map(run_block, (xbuf.reshape(n_blocks, MOE_BLOCK, d), blk_expert)).reshape(-1, d)
    contrib = ybuf[dest] * w_sorted[:, None].astype(h.dtype)
    return jax.ops.segment_sum(contrib, tok, num_segments=t_tok)


def setup_inputs(seed: int = 0) -> dict:
    key = jax.random.key(seed)
    ks = jax.random.split(key, 24)
    nrm = jax.random.normal
    D = D_MODEL
    return {
        "x": nrm(ks[0], (BATCH, SEQ, D), F32),
        "c": nrm(ks[1], (BATCH, D), F32),
        "ctx": nrm(ks[2], (BATCH, CTX_LEN, D), F32),
        "c_ctx": nrm(ks[3], (D,), F32),
        "w_mod": nrm(ks[4], (DEPTH, D, 6 * D), F32) * D ** -0.5,
        "b_mod": 0.02 * nrm(ks[5], (DEPTH, 6 * D), F32),
        "norm1_g": 1.0 + 0.05 * nrm(ks[6], (DEPTH, D), F32),
        "w_in": nrm(ks[7], (DEPTH, D, IN_WIDTH), F32) * D ** -0.5,
        "mlstm_gate_b": jnp.array([0.0, 3.0, 0.0, 3.0], F32)[None, :, None] + 0.3 * nrm(ks[8], (DEPTH, 4, M_HEADS), F32),
        "mlstm_norm_g": 1.0 + 0.05 * nrm(ks[9], (DEPTH, M_V_W), F32),
        "attn_sink": 0.5 * nrm(ks[10], (DEPTH, A_HEADS), F32),
        "w_br_m": nrm(ks[11], (DEPTH, M_V_W, D), F32) * M_V_W ** -0.5,
        "w_br_a": nrm(ks[12], (DEPTH, A_Q_W, D), F32) * A_Q_W ** -0.5,
        "w_out": nrm(ks[13], (DEPTH, D, D), F32) * D ** -0.5,
        "norm2_g": 1.0 + 0.05 * nrm(ks[14], (DEPTH, D), F32),
        "w_router_grp": nrm(ks[15], (DEPTH, D, N_GROUPS), F32) * D ** -0.5,
        "b_router_grp": 0.01 * nrm(ks[16], (DEPTH, N_GROUPS), F32),
        "w_router_exp": nrm(ks[17], (DEPTH, D, N_EXPERTS), F32) * D ** -0.5,
        "b_router_exp": 0.01 * nrm(ks[18], (DEPTH, N_EXPERTS), F32),
        "w_exp_gate": nrm(ks[19], (DEPTH, N_EXPERTS, D, D_EXPERT), F32) * D ** -0.5,
        "w_exp_up": nrm(ks[20], (DEPTH, N_EXPERTS, D, D_EXPERT), F32) * D ** -0.5,
        "w_exp_down": nrm(ks[21], (DEPTH, N_EXPERTS, D_EXPERT, D), F32) * D_EXPERT ** -0.5,
        "final_norm_g": 1.0 + 0.05 * nrm(ks[22], (D,), F32),
    }


def reference(x, c, ctx, c_ctx, w_mod, b_mod, norm1_g, w_in, mlstm_gate_b, mlstm_norm_g, attn_sink,
              w_br_m, w_br_a, w_out, norm2_g, w_router_grp, b_router_grp, w_router_exp, b_router_exp,
              w_exp_gate, w_exp_up, w_exp_down, final_norm_g):
    b, s, d = x.shape
    n_ctx = ctx.shape[1]
    cos, sin = axial_rope_tables(s)
    xc = ctx
    for l in range(DEPTH):
        update_ctx = l < DEPTH - 1
        sh1, sc1, g1, sh2, sc2, g2 = [m[:, None, :] for m in adaln(c, w_mod[l], b_mod[l])]
        sh1c, sc1c, g1c, sh2c, sc2c, g2c = adaln(c_ctx, w_mod[l], b_mod[l])
        h = modulate(rms_norm(x, norm1_g[l]), sh1, sc1)
        hc = modulate(rms_norm(xc, norm1_g[l]), sh1c, sc1c)
        y, yc = token_mixers(h, hc, cos, sin, w_in[l], mlstm_gate_b[l], mlstm_norm_g[l], attn_sink[l],
                             w_br_m[l], w_br_a[l], w_out[l], update_ctx)
        x = x + g1 * y
        h = modulate(rms_norm(x, norm2_g[l]), sh2, sc2)
        moe_args = (w_router_grp[l], b_router_grp[l], w_router_exp[l], b_router_exp[l],
                    w_exp_gate[l], w_exp_up[l], w_exp_down[l])
        if update_ctx:
            xc = xc + g1c * yc
            hc = modulate(rms_norm(xc, norm2_g[l]), sh2c, sc2c)
            out = hierarchical_moe(jnp.concatenate([hc.reshape(-1, d), h.reshape(-1, d)], axis=0), *moe_args)
            xc = xc + g2c * out[:b * n_ctx].reshape(b, n_ctx, d)
            x = x + g2 * out[b * n_ctx:].reshape(b, s, d)
        else:
            x = x + g2 * hierarchical_moe(h.reshape(-1, d), *moe_args).reshape(b, s, d)
    return rms_norm(x, final_norm_g)
```

```cpp
#include <hip/hip_runtime.h>
#include <stdint.h>
#include <stdio.h>

#define DBG_NO_MOE 0
#ifndef DBG_DBL
#define DBG_DBL -1
#endif
#define DBG_NO_ATTN 0
#define DBG_NO_STATE 0
#define DBG_ONLY_X 0
#ifndef MK_FP8_INPROJ
#define MK_FP8_INPROJ 0
#endif
#ifndef MK_FP8_MIX
#define MK_FP8_MIX 1
#endif
#ifndef MK_FP8_MOE
#define MK_FP8_MOE 1
#ifndef MK_WSTREAM
#define MK_WSTREAM 1
#endif
#ifndef MK_FP8_GATES
#define MK_FP8_GATES 1
#endif
#ifndef MK_F8MASK
#define MK_F8MASK 0x0000FF0FFFFFFFF0ull
#endif
#define MK_F8CTX 0ull
#endif
#ifndef MK_ONE_LAUNCH
#define MK_ONE_LAUNCH 1
#endif

#define LAS __attribute__((address_space(3)))
typedef unsigned short bf16_t;
typedef short bf16x8 __attribute__((ext_vector_type(8)));
typedef short bf16x4 __attribute__((ext_vector_type(4)));
typedef float f32x4 __attribute__((ext_vector_type(4)));
typedef unsigned u32x4 __attribute__((ext_vector_type(4)));
typedef unsigned u32x2 __attribute__((ext_vector_type(2)));

constexpr int D = 2048, NB = 4, SEQ = 2048, CTXL = 256, T = NB * SEQ, TC = NB * CTXL, TR = T + TC;
constexpr int MH = 8, MDQK = 128, MDV = 256;
constexpr int AH = 16, AKV = 4, ADH = 128;
constexpr int NEXP = 64, DEXP = 1024;
constexpr int INW = 13344, INWP = 13568;
constexpr float EPS = 1e-6f;
constexpr int NT = 512;

constexpr size_t al256(size_t x) { return (x + 255) & ~(size_t)255; }
constexpr size_t CTL_BYTES = 65536;
constexpr size_t WS_CTL = 0;
constexpr size_t CTL_CNT = 16384;
constexpr size_t WS_MODP = WS_CTL + CTL_BYTES;
constexpr size_t WS_MOD = WS_MODP + al256((size_t)32 * 5 * 12288 * 4);
constexpr size_t WS_ROPE = WS_MOD + al256((size_t)5 * 12288 * 4);
constexpr size_t WS_WRT = WS_ROPE + al256((size_t)2048 * 2 * 32 * 2 * 4);
constexpr int WRLD = 2048 + 64;
constexpr size_t WS_WRL = WS_WRT + (size_t)80 * WRLD * 2;
constexpr size_t WS_BTIN = WS_WRT + al256((size_t)2 * 80 * WRLD * 2);
constexpr size_t WS_BTBRM = WS_BTIN + al256((size_t)INWP * 2048 * 2);
constexpr size_t WS_BTBRA = WS_BTBRM + al256((size_t)2048 * 2048 * 2);
constexpr size_t WS_BTOUT = WS_BTBRA + al256((size_t)2048 * 2048 * 2);
constexpr size_t WS_BTGU = WS_BTOUT + al256((size_t)2048 * 2048 * 2);
constexpr size_t WS_ABF8 = WS_BTGU;
constexpr size_t WS_BTIN8 = WS_BTGU + al256((size_t)TR * 2048);
constexpr size_t WS_W8GU = WS_BTGU + ((size_t)64 << 20);
constexpr size_t WS_BTD = WS_BTGU + al256((size_t)NEXP * 2048 * 2048 * 2);
constexpr size_t WS_W8D = WS_BTD;
constexpr size_t WS_ABF = WS_BTD + al256((size_t)NEXP * 2048 * 1024 * 2);
constexpr size_t WS_QM = WS_ABF + al256((size_t)TR * 2048 * 2);
constexpr size_t WS_OMS = WS_QM + al256((size_t)T * 1024 * 2);
constexpr size_t WS_QA = WS_OMS + al256((size_t)T * 2048 * 2);
constexpr size_t WS_GBRS = WS_QA + al256((size_t)T * 2048 * 2);
constexpr size_t WS_KM = WS_GBRS + al256((size_t)T * 4096 * 2);
constexpr size_t WS_VM = WS_KM + al256((size_t)TR * 1024 * 2);
constexpr size_t WS_KA = WS_VM + al256((size_t)TR * 2048 * 2);
constexpr size_t WS_VAT = WS_KA + al256((size_t)TR * 512 * 2);
constexpr size_t WS_GM = WS_VAT + al256((size_t)512 * TR * 2);
constexpr size_t WS_HFB = WS_GM + al256((size_t)TR * 32 * 4);
constexpr size_t WS_AO = WS_HFB + al256((size_t)2 * T * 2048 * 2);
constexpr size_t WS_AM = WS_AO + al256((size_t)T * 2048 * 2);
constexpr size_t WS_TMP = WS_AM + al256((size_t)T * 2048 * 2);
constexpr size_t WS_AOUT = WS_TMP + al256((size_t)T * 2048 * 4);
constexpr size_t WS_X1 = WS_AOUT + al256((size_t)T * 2048 * 2);
constexpr size_t WS_H2 = WS_X1 + al256((size_t)T * 2048 * 4);
constexpr size_t WS_EID = WS_H2 + al256((size_t)T * 2048 * 2);
constexpr size_t WS_WTOP = WS_EID + al256((size_t)T * 2 * 4);
constexpr size_t WS_POS = WS_WTOP + al256((size_t)T * 2 * 4);
constexpr int XGROWS = 32768;
constexpr size_t WS_ROWMAP = WS_POS + al256((size_t)T * 2 * 4);
constexpr size_t WS_ROWW = WS_ROWMAP + al256((size_t)XGROWS * 4);
constexpr size_t WS_PANEL = WS_ROWW + al256((size_t)XGROWS * 4);
constexpr size_t WS_ROWTOK = WS_PANEL + al256(1024);
constexpr size_t WS_XG = WS_ROWTOK + al256((size_t)XGROWS * 4);
constexpr size_t WS_RSS = WS_XG + ((size_t)100 << 20);
constexpr size_t WS_HBUF = WS_XG + al256((size_t)XGROWS * 2048 * 2);
constexpr size_t WS_YBUF = WS_HBUF + al256((size_t)XGROWS * 1024 * 2);
constexpr size_t WS_END = WS_YBUF + al256((size_t)2 * T * 2048 * 2);

constexpr int LDS_STAGE = 131072;
constexpr int LDS_BAR_OFF = LDS_STAGE;
constexpr int LDS_TAB_OFF = LDS_STAGE + 64;
constexpr int LDS_PRE_OFF = LDS_STAGE + 4096;
constexpr int LDS_BYTES = LDS_PRE_OFF + 27648;

typedef float f32x2 __attribute__((ext_vector_type(2)));
typedef __bf16 bf16x2_t __attribute__((ext_vector_type(2)));
__device__ __forceinline__ unsigned pk_bf16(float lo, float hi) { const bf16x2_t v = __builtin_convertvector((f32x2){lo, hi}, bf16x2_t); return __builtin_bit_cast(unsigned, v); }
__device__ __forceinline__ unsigned pk_fp8x4(float a, float b, float c, float d) { int p = __builtin_amdgcn_cvt_pk_fp8_f32(a, b, 0, false); p = __builtin_amdgcn_cvt_pk_fp8_f32(c, d, p, true); return (unsigned)p; }
__device__ __forceinline__ float bf_lo(unsigned u) { return __uint_as_float(u << 16); }
__device__ __forceinline__ float bf_hi(unsigned u) { return __uint_as_float(u & 0xffff0000u); }
__device__ __forceinline__ float bf1(unsigned short h) { return __uint_as_float(((unsigned)h) << 16); }
__device__ __forceinline__ float sigmoidf_(float x) { return __builtin_amdgcn_rcpf(1.f + __expf(-x)); }
__device__ __forceinline__ float wave_sum(float v) {
#pragma unroll
    for (int d = 32; d >= 1; d >>= 1) v += __shfl_xor(v, d);
    return v;
}

#define XB_TMO      128
#define XB_XCNT(j)  (256  + 64 * (j))
#define XB_XSUB(j)  (1280 + 64 * (j))
#define XB_XGEN(j)  (2304 + 64 * (j))
#define XB_TOP      3328
#define XB_TOPGEN   3392
#define XCD_BAR_WORDS 3456
#define XB_SPIN_CAP (1u << 18)

__device__ __forceinline__ unsigned xb_ld(unsigned* p)              { return __hip_atomic_load(p, __ATOMIC_RELAXED, __HIP_MEMORY_SCOPE_AGENT); }
__device__ __forceinline__ unsigned xb_add(unsigned* p, unsigned v) { return __hip_atomic_fetch_add(p, v, __ATOMIC_RELAXED, __HIP_MEMORY_SCOPE_AGENT); }
__device__ __forceinline__ unsigned xb_xcc_id() { return (unsigned)__builtin_amdgcn_s_getreg((3 << 11) | 20) & 0xFu; }
#define XB_SPIN(cond, bar) do { unsigned _sp = 0; while (cond) { __builtin_amdgcn_s_sleep(1); \
    if ((++_sp & 255u) == 0u) { if (xb_ld(&(bar)[XB_TMO])) break; if (_sp > XB_SPIN_CAP) { atomicAdd(&(bar)[XB_TMO], 1u); break; } } } } while (0)

struct XcdBarrier { unsigned* bar; unsigned x; volatile LAS unsigned* st; };

__device__ __forceinline__ XcdBarrier xcd_barrier_post(unsigned* bar, volatile LAS unsigned* st) {
    XcdBarrier b; b.bar = bar; b.x = xb_xcc_id(); b.st = st;
    if (threadIdx.x == 0) (void)xb_add(&bar[XB_XCNT(b.x)], 1u);
    return b;
}
__device__ __forceinline__ void xcd_barrier_complete(unsigned* bar, unsigned x, unsigned& nloc, unsigned& nx) {
    const unsigned G = gridDim.x * gridDim.y * gridDim.z;
    unsigned sum, cnt, mine, sp = 0u;
    for (;;) {
        sum = 0u; cnt = 0u; mine = 0u;
#pragma unroll
        for (unsigned j = 0; j < 16; ++j) { const unsigned c = xb_ld(&bar[XB_XCNT(j)]); sum += c; cnt += (c > 0u) ? 1u : 0u; mine = (j == x) ? c : mine; }
        if (sum == G) break;
        __builtin_amdgcn_s_sleep(1);
        if ((++sp & 255u) == 0u) { if (xb_ld(&bar[XB_TMO])) break; if (sp > XB_SPIN_CAP) { atomicAdd(&bar[XB_TMO], 1u); break; } }
    }
    nloc = mine > 0u ? mine : 1u; nx = cnt > 0u ? cnt : 1u;
}
__device__ __forceinline__ void xcd_barrier(const XcdBarrier& b) {
    asm volatile("s_waitcnt vmcnt(0)" ::: "memory");
    __syncthreads();
    if (threadIdx.x == 0) {
        unsigned* bar = b.bar;
        __builtin_amdgcn_s_waitcnt(0);
        unsigned nloc = b.st[0], nx = b.st[1];
        if (nloc == 0u) { xcd_barrier_complete(bar, b.x, nloc, nx); b.st[0] = nloc; b.st[1] = nx; }
        const unsigned old = xb_add(&bar[XB_XSUB(b.x)], 1u);
        const unsigned gen = old / nloc;
        if (old + 1u == (gen + 1u) * nloc) {
            __builtin_amdgcn_fence(__ATOMIC_RELEASE, "agent");
            asm volatile("s_waitcnt vmcnt(0)" ::: "memory");
            const unsigned og = xb_add(&bar[XB_TOP], 1u);
            const unsigned tg = og / nx;
            if (og + 1u == (tg + 1u) * nx) xb_add(&bar[XB_TOPGEN], 1u);
            else XB_SPIN(xb_ld(&bar[XB_TOPGEN]) == tg, bar);
            __builtin_amdgcn_fence(__ATOMIC_ACQUIRE, "agent");
            xb_add(&bar[XB_XGEN(b.x)], 1u);
            asm volatile("s_waitcnt vmcnt(0)" ::: "memory");
        } else {
            XB_SPIN(xb_ld(&bar[XB_XGEN(b.x)]) == gen, bar);
            __builtin_amdgcn_fence(__ATOMIC_ACQUIRE, "agent");
            asm volatile("s_waitcnt vmcnt(0)" ::: "memory");
        }
    }
    __syncthreads();
}

namespace pg8 {
constexpr int BM = 256, BK = 64, HALF = 128, HTB = HALF * BK * 2, STAGE_BYTES = 8 * HTB, NXCD = 8, WGM = 8;
__device__ __forceinline__ int lds_byte(int r, int c) { const int st = (r >> 4) * 2 + (c >> 5), rr = r & 15, cc = c & 31, ob = rr * 64 + cc * 2; return st * 1024 + (ob ^ (((ob >> 9) & 1) << 5)); }
__device__ __forceinline__ void stage_rc(int b, int& R, int& C) { const int st = b / 1024, sb = b % 1024, swz = sb ^ (((sb >> 9) & 1) << 5); R = (st >> 1) * 16 + swz / 64; C = (st & 1) * 32 + (swz % 64) / 2; }
struct Unit { int pm, pn; };
struct Gemm { const bf16_t* A; const bf16_t* Bt; int K; };

typedef int v8i_t __attribute__((ext_vector_type(8)));
typedef int v4i_t __attribute__((ext_vector_type(4)));

constexpr int WS_STEPS = 3 * 16384;
struct WStream { const float* src0; const float* src1; const float* src2; unsigned char* dgu; unsigned char* dd; int gs0, n, n0; };
__device__ __forceinline__ int ws_gs(const WStream& W, int s) { int g = W.gs0 + (s < W.n ? s : W.n - 1); g = g < WS_STEPS ? g : WS_STEPS - 1; return g > 0 ? g : 0; }
__device__ __forceinline__ void ws_issue(const WStream& W, int s, f32x4 (&r)[4]) {
    int tz = threadIdx.x; asm volatile("" : "+v"(tz));
    const int gs = ws_gs(W, s), mat = gs >> 14, q = gs & 16383, e = q >> 8;
    const int sh = (mat == 2) ? 13 : 12;
    const int rg = (mat == 2) ? ((q >> 2) & 63) : ((q >> 1) & 127), part = (mat == 2) ? (q & 3) : (q & 1);
    const float* base = mat == 0 ? W.src0 : (mat == 1 ? W.src1 : W.src2);
    const char* ub = (const char*)base + (size_t)e * 8388608 + ((size_t)(rg * 16) << sh) + (size_t)(part * 2048);
    const unsigned voff = ((unsigned)((tz >> 4) & 3) << (sh + 2)) + (unsigned)(tz >> 6) * 256u + (unsigned)(tz & 15) * 16u;
#pragma unroll
    for (int i = 0; i < 4; ++i) r[i] = *(const f32x4*)(ub + voff + ((size_t)i << sh));
}
__device__ __forceinline__ void ws_flush(const WStream& W, int s, const f32x4 (&r)[4]) {
    int tz = threadIdx.x; asm volatile("" : "+v"(tz));
    const int gs = ws_gs(W, s), mat = gs >> 14, q = gs & 16383, e = q >> 8;
    const int rg = (mat == 2) ? ((q >> 2) & 63) : ((q >> 1) & 127), part = (mat == 2) ? (q & 3) : (q & 1);
    unsigned d[4];
#pragma unroll
    for (int j = 0; j < 4; ++j) d[j] = pk_fp8x4(r[0][j] * 64.f, r[1][j] * 64.f, r[2][j] * 64.f, r[3][j] * 64.f);
    const auto a = __builtin_amdgcn_permlane32_swap(d[0], d[2], false, false); const auto b = __builtin_amdgcn_permlane32_swap(d[1], d[3], false, false);
    const auto c = __builtin_amdgcn_permlane16_swap(a[0], b[0], false, false); const auto f = __builtin_amdgcn_permlane16_swap(a[1], b[1], false, false);
    const u32x4 o = (u32x4){c[0], c[1], f[0], f[1]};
    const int w = tz >> 6, g = 4 * (tz & 15) + ((tz >> 4) & 3);
    unsigned char* ub; int slot;
    const int gp = (g & 32) + 16 * ((g >> 2) & 1) + 4 * ((g & 31) >> 3) + (g & 3);
    if (mat == 2) { ub = W.dd + (size_t)e * 2097152 + (size_t)((part * 4) * 131072 + rg * 2048); slot = (w & 1) * 64 + gp; ub += (size_t)(w >> 1) * 131072; }
    else          { ub = W.dgu + (size_t)e * 4194304 + (size_t)((part * 8) * 262144 + rg * 2048); slot = 64 * (gp >> 5) + (gp & 31) + 32 * mat; ub += (size_t)w * 262144; }
    *(u32x4*)(ub + (unsigned)((slot ^ ((slot >> 3) & 3)) * 16)) = o;
}
template <class Epi, class Sched, bool FP8 = false, bool STRM = false>
__device__ __forceinline__ int gemm_phase(LAS unsigned char* lds, const Gemm g, const Sched& S, const Epi& E, const WStream W = WStream{}) {
    const int tid = threadIdx.x, wid = __builtin_amdgcn_readfirstlane(tid >> 6), lane = tid & 63, wr = wid >> 2, wc = wid & 3, fr = lane & 15, fq = lane >> 4;
    const int K = g.K, nt = K / BK;
    unsigned voffA[2];
#pragma unroll
    for (int i = 0; i < 2; ++i) { int R, C; stage_rc(tid * 16 + i * 8192, R, C); voffA[i] = (unsigned)(R * K + C) * 2u; }
    const size_t kstep = (size_t)(BK * 2);
    const size_t hstep = (size_t)HALF * K * 2;
    const size_t tstep = 2 * hstep;
    const unsigned ldsw = (unsigned)wid * 1024u;
    const int aoff = lds_byte(wr * 64 + fr, fq * 8), boff = lds_byte(wc * 32 + fr, fq * 8);
    const __amdgpu_buffer_rsrc_t rsA = __builtin_amdgcn_make_buffer_rsrc((void*)g.A, 0, 0x7fffffff, 0x00020000), rsB = __builtin_amdgcn_make_buffer_rsrc((void*)g.Bt, 0, 0x7fffffff, 0x00020000);
#define PG8_SA(b, h) (((b) * 2 + (h)) * HTB)
#define PG8_SB(b, h) ((4 + (b) * 2 + (h)) * HTB)
#define PG8_STAGE_X(rs_, base_, bufoff, gbase, voff) do { const unsigned so_ = (unsigned)((const char*)(gbase) - (const char*)(base_)); _Pragma("unroll") for (int _i = 0; _i < 2; ++_i) \
        __builtin_amdgcn_raw_ptr_buffer_load_lds(rs_, (LAS void*)(lds + (bufoff) + ldsw + _i * 8192), 16, (int)(voff)[_i], (int)so_, 0, 0); } while (0)
#define PG8_STAGE(bufoff, gbase, voff) do { if ((bufoff) >= 4 * HTB) PG8_STAGE_X(rsB, g.Bt, bufoff, gbase, voff); else PG8_STAGE_X(rsA, g.A, bufoff, gbase, voff); } while (0)
#define PG8_LDA(dst, b, h) do { _Pragma("unroll") for (int m = 0; m < 4; ++m) _Pragma("unroll") for (int k = 0; k < 2; ++k) dst[m][k] = *(const LAS bf16x8*)(lds + PG8_SA(b, h) + aoff + m * 2048 + k * 1024); } while (0)
#define PG8_LDB(dst, b, h) do { _Pragma("unroll") for (int n = 0; n < 2; ++n) _Pragma("unroll") for (int k = 0; k < 2; ++k) dst[n][k] = *(const LAS bf16x8*)(lds + PG8_SB(b, h) + boff + n * 2048 + k * 1024); } while (0)
#define PG8_MMA(ai, bj, At, Bt) do { __builtin_amdgcn_s_setprio(1); _Pragma("unroll") for (int m = 0; m < 4; ++m) _Pragma("unroll") for (int n = 0; n < 2; ++n) { \
        if (FP8) { const v8i_t bb_ = __builtin_shufflevector(__builtin_bit_cast(v4i_t, Bt[n][0]), __builtin_bit_cast(v4i_t, Bt[n][1]), 0, 1, 2, 3, 4, 5, 6, 7); \
            const v8i_t aa_ = __builtin_shufflevector(__builtin_bit_cast(v4i_t, At[m][0]), __builtin_bit_cast(v4i_t, At[m][1]), 0, 1, 2, 3, 4, 5, 6, 7); \
            acc[ai][bj][m][n] = __builtin_amdgcn_mfma_scale_f32_16x16x128_f8f6f4(bb_, aa_, acc[ai][bj][m][n], 0, 0, 0, 0, 0, 0); } \
        else { _Pragma("unroll") for (int k = 0; k < 2; ++k) acc[ai][bj][m][n] = __builtin_amdgcn_mfma_f32_16x16x32_bf16(Bt[n][k], At[m][k], acc[ai][bj][m][n], 0, 0, 0); } } \
        __builtin_amdgcn_s_setprio(0); } while (0)
#define PG8_WAIT_V(n) asm volatile("s_waitcnt vmcnt(" #n ")" ::: "memory")
#define PG8_WAIT_L(n) asm volatile("s_waitcnt lgkmcnt(" #n ")" ::: "memory")
#define PG8_BAR __builtin_amdgcn_s_barrier()
#define PG8_SCHED __builtin_amdgcn_sched_barrier(0)
    Unit cur, nxt; int ui = 0;
    if (!S.next(0, cur)) return 0;
    f32x4 acc[2][2][4][2];
#pragma unroll
    for (int a = 0; a < 2; ++a)
#pragma unroll
        for (int b = 0; b < 2; ++b)
#pragma unroll
            for (int m = 0; m < 4; ++m)
#pragma unroll
                for (int n = 0; n < 2; ++n) acc[a][b][m][n] = (f32x4){0.f, 0.f, 0.f, 0.f};
    bf16x8 At[4][2], B0[2][2], B1[2][2];
    f32x4 wsA[4], wsB[4]; int sstep = 0;
    if (STRM) { ws_issue(W, 0, wsB); PG8_SCHED; }
    const char* cA = (const char*)g.A + (size_t)cur.pm * tstep; const char* cB = (const char*)g.Bt + (size_t)cur.pn * tstep;
    PG8_STAGE(PG8_SB(0, 0), cB, voffA); PG8_STAGE(PG8_SA(0, 0), cA, voffA); PG8_STAGE(PG8_SB(0, 1), cB + hstep, voffA); PG8_STAGE(PG8_SA(0, 1), cA + hstep, voffA);
    if (wr == 1) PG8_BAR;
    PG8_WAIT_V(4); PG8_BAR;
    PG8_STAGE(PG8_SB(1, 0), cB + kstep, voffA); PG8_STAGE(PG8_SA(1, 0), cA + kstep, voffA); PG8_STAGE(PG8_SB(1, 1), cB + hstep + kstep, voffA);
    PG8_WAIT_V(6); PG8_BAR;
    for (;;) {
        const bool has_next = S.next(ui + 1, nxt);
        const char* nA = has_next ? (const char*)g.A + (size_t)nxt.pm * tstep : cA; const char* nB = has_next ? (const char*)g.Bt + (size_t)nxt.pn * tstep : cB;
        for (int t = 0; t < nt; t += 2) {
            const bool last = (t == nt - 2);
            const char* a1 = cA + (size_t)(t + 1) * kstep;
            const char* a2 = last ? nA : cA + (size_t)(t + 2) * kstep; const char* b2 = last ? nB : cB + (size_t)(t + 2) * kstep;
            const char* a3 = a2 + kstep; const char* b3 = b2 + kstep;
            PG8_LDB(B0, 0, 0); PG8_SCHED; PG8_LDA(At, 0, 0); PG8_STAGE(PG8_SA(1, 1), a1 + hstep, voffA);
            if (STRM) { PG8_SCHED; ws_issue(W, sstep + 1, wsA); PG8_SCHED; }
            PG8_WAIT_L(8); PG8_BAR; PG8_WAIT_L(0); PG8_MMA(0, 0, At, B0); PG8_BAR; PG8_SCHED;
            PG8_LDB(B1, 0, 1); PG8_STAGE(PG8_SB(0, 0), b2, voffA);
            PG8_BAR; PG8_WAIT_L(0); PG8_MMA(0, 1, At, B1); PG8_BAR;
            PG8_LDA(At, 0, 1); PG8_STAGE(PG8_SA(0, 0), a2, voffA);
            PG8_BAR; PG8_WAIT_L(0); PG8_MMA(1, 0, At, B0); PG8_BAR; PG8_SCHED;
            PG8_STAGE(PG8_SB(0, 1), b2 + hstep, voffA);
            if (STRM) PG8_WAIT_V(10); else PG8_WAIT_V(6);
            PG8_BAR; PG8_MMA(1, 1, At, B1); if (STRM) { ws_flush(W, sstep, wsB); PG8_SCHED; } PG8_BAR;
            PG8_LDB(B0, 1, 0); PG8_SCHED; PG8_LDA(At, 1, 0); PG8_STAGE(PG8_SA(0, 1), a2 + hstep, voffA);
            if (STRM) { PG8_SCHED; ws_issue(W, sstep + 2, wsB); PG8_SCHED; }
            PG8_WAIT_L(8); PG8_BAR; PG8_WAIT_L(0); PG8_MMA(0, 0, At, B0); PG8_BAR; PG8_SCHED;
            PG8_LDB(B1, 1, 1); PG8_STAGE(PG8_SB(1, 0), b3, voffA);
            PG8_BAR; PG8_WAIT_L(0); PG8_MMA(0, 1, At, B1); PG8_BAR;
            PG8_LDA(At, 1, 1); PG8_STAGE(PG8_SA(1, 0), a3, voffA);
            PG8_BAR; PG8_WAIT_L(0); PG8_MMA(1, 0, At, B0); PG8_BAR; PG8_SCHED;
            PG8_STAGE(PG8_SB(1, 1), b3 + hstep, voffA);
            if (STRM) PG8_WAIT_V(10); else PG8_WAIT_V(6);
            PG8_BAR; PG8_MMA(1, 1, At, B1); if (STRM) { ws_flush(W, sstep + 1, wsA); PG8_SCHED; sstep += 2; } PG8_BAR;
        }
        { int tz = threadIdx.x; asm volatile("" : "+v"(tz));
          const int wid2 = __builtin_amdgcn_readfirstlane(tz >> 6), lane2 = tz & 63; E(acc, cur, wid2 >> 2, wid2 & 3, lane2 & 15, lane2 >> 4); }
        if (!has_next) break;
#pragma unroll
        for (int a = 0; a < 2; ++a)
#pragma unroll
            for (int b = 0; b < 2; ++b)
#pragma unroll
                for (int m = 0; m < 4; ++m)
#pragma unroll
                    for (int n = 0; n < 2; ++n) acc[a][b][m][n] = (f32x4){0.f, 0.f, 0.f, 0.f};
        cur = nxt; cA = nA; cB = nB; ++ui;
    }
    PG8_WAIT_V(0);
    if (wr == 0) PG8_BAR;
    PG8_BAR;
    if (STRM) { ws_flush(W, sstep, wsB); ++sstep; }
#undef PG8_SA
#undef PG8_SB
#undef PG8_STAGE
#undef PG8_LDA
#undef PG8_LDB
#undef PG8_MMA
#undef PG8_WAIT_V
#undef PG8_WAIT_L
#undef PG8_BAR
#undef PG8_SCHED
    return sstep;
}

struct StaticOrder {
    int nM, nN, nwg, G, c;
    __device__ void init(int M, int N, int G_, int c_) { nM = M / BM; nN = N / BM; nwg = nM * nN; G = G_; c = c_; }
    __device__ bool map(long L, Unit& u) const {
        if (L >= nwg) return false;
        int wgid = (int)L; { const int q = nwg / NXCD, r = nwg % NXCD, xcd = wgid % NXCD, off = wgid / NXCD; wgid = (xcd < r ? xcd * (q + 1) : r * (q + 1) + (xcd - r) * q) + off; }
        const int nig = WGM * nN, gid = wgid / nig, fm = gid * WGM, gsz = (nM - fm) < WGM ? (nM - fm) : WGM;
        u.pm = fm + ((wgid % nig) % gsz); u.pn = (wgid % nig) / gsz; return true;
    }
    __device__ bool next(int i, Unit& u) const { return map((long)i * G + c, u); }
};
}
using pg8::Unit; using pg8::v4i_t; using pg8::v8i_t;

struct Args {
    const float* in[23];
    float* out;
    unsigned char* ws;
    int ph_lo, ph_hi;
};
struct Frame {
    const float* const* in;
    float* out; unsigned char* ws;
    LAS unsigned char* lds;
    int tid, lane, wave, bid, nb;
};
#define WSP(T_, off) ((T_*)(F.ws + (off)))

__device__ __forceinline__ void p0_mod_partials(const Frame& F) {
    const float* c = F.in[1]; const float* c_ctx = F.in[3]; const float* w_mod = F.in[4];
    float* modp = WSP(float, WS_MODP);
    LAS float* s = (LAS float*)(F.lds);
    LAS float* red = (LAS float*)(F.lds + 8192);
    const int t = F.tid, cg = t % 96, kq = t / 96;
    for (int idx = F.bid; idx < 32 * 8; idx += F.nb) {
        const int ct = idx & 31, ks = idx >> 5;
        __syncthreads();
        for (int i = t; i < 1280; i += NT) { const int r = i >> 8, kk = i & 255; const float cv = (r < 4) ? c[r * D + ks * 256 + kk] : c_ctx[ks * 256 + kk]; s[i] = cv / (1.f + __expf(-cv)); }
        __syncthreads();
        if (kq < 4) {
            float acc[5][4];
#pragma unroll
            for (int r = 0; r < 5; ++r)
#pragma unroll
                for (int e = 0; e < 4; ++e) acc[r][e] = 0.f;
            const float* wp = w_mod + (size_t)(ks * 256 + kq * 64) * 12288 + ct * 384 + cg * 4;
#pragma unroll 16
            for (int i = 0; i < 64; ++i) {
                const f32x4 w = *(const f32x4*)(wp + (size_t)i * 12288);
#pragma unroll
                for (int r = 0; r < 5; ++r) { const float sv = s[r * 256 + kq * 64 + i];
#pragma unroll
                    for (int e = 0; e < 4; ++e) acc[r][e] += sv * w[e]; }
            }
#pragma unroll
            for (int r = 0; r < 5; ++r) *(LAS f32x4*)(red + (kq * 5 + r) * 384 + cg * 4) = (f32x4){acc[r][0], acc[r][1], acc[r][2], acc[r][3]};
        }
        __syncthreads();
        if (t < 384) {
#pragma unroll
            for (int r = 0; r < 5; ++r) { float v = 0.f;
#pragma unroll
                for (int q = 0; q < 4; ++q) v += red[(q * 5 + r) * 384 + t];
                modp[((size_t)ks * 5 + r) * 12288 + ct * 384 + t] = v; }
        }
    }
    __syncthreads();
}

__device__ __forceinline__ void cvt_tile(const Frame& F, const float* src, int ld, int width, int perm, bf16_t* dst, int Kd) {
    constexpr int LDT = 136;
    LAS unsigned char* Tt = F.lds;
    const int t = F.tid, n4 = t & 31, kp = t >> 5;
    const bool valid = (4 * n4) < width;
#pragma unroll
    for (int pass = 0; pass < 4; ++pass) {
        const int k = pass * 32 + 2 * kp;
        f32x4 a = (f32x4){0.f, 0.f, 0.f, 0.f}, b = a;
        if (valid) { a = *(const f32x4*)(src + (size_t)k * ld + 4 * n4); b = *(const f32x4*)(src + (size_t)(k + 1) * ld + 4 * n4); }
#pragma unroll
        for (int e = 0; e < 4; ++e) {
            const int nl = 4 * n4 + e;
            const int p1_ = (perm & 1) ? (64 * (nl >> 6) + 2 * (nl & 31) + ((nl >> 5) & 1)) : nl;
            const int prow = (perm & 2) ? ((p1_ & ~31) + 16 * ((p1_ >> 2) & 1) + 4 * ((p1_ & 31) >> 3) + (p1_ & 3)) : p1_;
            const int pc = (k >> 3) ^ ((prow >> 2) & 15);
            *(LAS unsigned*)(Tt + prow * (LDT * 2) + pc * 16 + (k & 7) * 2) = pk_bf16(a[e], b[e]);
        }
    }
    __syncthreads();
#pragma unroll
    for (int i = 0; i < 4; ++i) {
        const int id = t + 512 * i, row = id >> 4, pc = id & 15;
        const u32x4 v = *(const LAS u32x4*)(Tt + row * (LDT * 2) + ((pc ^ ((row >> 2) & 15)) * 16));
        *(u32x4*)(dst + (size_t)row * Kd + pc * 8) = v;
    }
    __syncthreads();
}

__device__ __forceinline__ void cvt_tile8(const Frame& F, const float* src, int ld, int width, int perm, unsigned char* dst, int Kd) {
    constexpr int LDT = 144;
    LAS unsigned char* Tt = F.lds;
    const int t = F.tid, n4 = t & 31, kp = t >> 5;
    const bool valid = (4 * n4) < width;
#pragma unroll
    for (int pass = 0; pass < 4; ++pass) {
        const int k = pass * 32 + 2 * kp;
        f32x4 a = (f32x4){0.f, 0.f, 0.f, 0.f}, b = a;
        if (valid) { a = *(const f32x4*)(src + (size_t)k * ld + 4 * n4); b = *(const f32x4*)(src + (size_t)(k + 1) * ld + 4 * n4); }
#pragma unroll
        for (int e = 0; e < 4; ++e) {
            const int nl = 4 * n4 + e;
            const int p1_ = (perm & 1) ? (64 * (nl >> 6) + 2 * (nl & 31) + ((nl >> 5) & 1)) : nl;
            const int prow = (perm & 2) ? ((p1_ & ~31) + 16 * ((p1_ >> 2) & 1) + 4 * ((p1_ & 31) >> 3) + (p1_ & 3)) : p1_;
            const int pc = (k >> 4) ^ ((prow >> 2) & 7);
            *(LAS unsigned short*)(Tt + prow * LDT + pc * 16 + (k & 15)) = (unsigned short)(__builtin_amdgcn_cvt_pk_fp8_f32(a[e] * 64.f, b[e] * 64.f, 0, false) & 0xffff);
        }
    }
    __syncthreads();
#pragma unroll
    for (int i = 0; i < 2; ++i) {
        const int id = t + 512 * i, row = id >> 3, pc = id & 7;
        const u32x4 v = *(const LAS u32x4*)(Tt + row * LDT + ((pc ^ ((row >> 2) & 7)) * 16));
        *(u32x4*)(dst + (size_t)row * Kd + pc * 16) = v;
    }
    __syncthreads();
}

__device__ __forceinline__ void p0_convert(const Frame& F) {
    const float* w_in = F.in[7];
    bf16_t* btin = WSP(bf16_t, WS_BTIN);
    const int J0 = 106 * 16, J1 = J0 + 3 * 256;
    for (int job = F.bid; job < J1; job += F.nb) {
        if (job < J0) {
            const int nt = job >> 4, kt = job & 15;
            const int drow = nt * 128;
            int scol, width = 128, perm = 0;
            if (drow < 1024) { scol = drow; perm = 2; }
            else if (drow < 3072) { scol = 4096 + (drow - 1024); perm = 2; }
            else if (drow < 5120) { scol = 6176 + (drow - 3072); perm = 3; }
            else if (drow < 9216) { scol = 9248 + (drow - 5120); perm = 2; }
            else if (drow < 10240) { scol = 1024 + (drow - 9216); perm = 2; }
            else if (drow < 12288) { scol = 2048 + (drow - 10240); perm = 2; }
            else if (drow < 12800) { scol = 8224 + (drow - 12288); perm = 3; }
            else if (drow < 13312) scol = 8736 + (drow - 12800);
            else if (drow < 13440) { scol = 6144; width = 32; }
            else { scol = 0; width = 0; }
#if MK_FP8_INPROJ
            cvt_tile8(F, w_in + (size_t)(kt * 128) * INW + scol, INW, width, perm, (unsigned char*)btin + (size_t)drow * 2048 + kt * 128, 2048);
#else
            const int pn_ = drow >> 8;
            const bool lat8 = MK_FP8_GATES && ((MK_F8MASK >> pn_) & 1ull), ctx8 = MK_FP8_GATES && ((MK_F8CTX >> pn_) & 1ull);
            if (lat8 || ctx8) cvt_tile8(F, w_in + (size_t)(kt * 128) * INW + scol, INW, width, perm, WSP(unsigned char, WS_BTIN8) + (size_t)drow * 2048 + kt * 128, 2048);
            if (!lat8 || (pn_ >= 36 && !ctx8)) cvt_tile(F, w_in + (size_t)(kt * 128) * INW + scol, INW, width, perm, btin + (size_t)drow * 2048 + kt * 128, 2048);
#endif
        } else {
            const int j = job - J0, which = j >> 8, nt = (j >> 4) & 15, kt = j & 15;
            const float* src = F.in[11 + which];
            bf16_t* dst = WSP(bf16_t, which == 0 ? WS_BTBRM : (which == 1 ? WS_BTBRA : WS_BTOUT));
#if MK_FP8_MIX
            cvt_tile8(F, src + (size_t)(kt * 128) * 2048 + nt * 128, 2048, 128, 2, (unsigned char*)dst + (size_t)(nt * 128) * 2048 + kt * 128, 2048);
#else
            cvt_tile(F, src + (size_t)(kt * 128) * 2048 + nt * 128, 2048, 128, 2, dst + (size_t)(nt * 128) * 2048 + kt * 128, 2048);
#endif
        }
    }
}

__device__ __forceinline__ void p0_tables(const Frame& F) {
    float* rope = WSP(float, WS_ROPE);
    const int gt = F.bid * NT + F.tid, gn = F.nb * NT;
    for (int idx = gt; idx < 2048 * 2 * 32; idx += gn) {
        const int i = idx & 31, axis = (idx >> 5) & 1, t = idx >> 6;
        const float pos = (float)(axis ? (t & 63) : (t >> 6));
        const float inv_freq = exp2f(-(float)i * (13.287712379549449f / 32.f));
        float rev = pos * inv_freq * 0.15915494309189535f;
        rev -= floorf(rev + 0.5f);
        rope[2 * idx] = __builtin_amdgcn_cosf(rev); rope[2 * idx + 1] = __builtin_amdgcn_sinf(rev);
    }
    bf16_t* wrh = WSP(bf16_t, WS_WRT); bf16_t* wrl = WSP(bf16_t, WS_WRL);
    const float* wrg = F.in[15]; const float* wre = F.in[17];
    for (int idx = gt; idx < 80 * 2048; idx += gn) {
        const int cc = idx >> 11, k = idx & 2047;
        const float wv = (cc < 8) ? wrg[k * 8 + cc] : ((cc < 72) ? wre[k * 64 + (cc - 8)] : 0.f);
        const unsigned hi = pk_bf16(wv, 0.f) & 0xffffu; const float hf = __uint_as_float(hi << 16);
        wrh[cc * WRLD + k] = (bf16_t)hi; wrl[cc * WRLD + k] = (bf16_t)(pk_bf16(wv - hf, 0.f) & 0xffffu);
    }
}

__device__ __forceinline__ void p1_norm1(const Frame& F) {
    const float* x = F.in[0]; const float* ctx = F.in[2]; const float* b_mod = F.in[5]; const float* g1n = F.in[6];
    const float* modp = WSP(float, WS_MODP); float* mod = WSP(float, WS_MOD); bf16_t* abf = WSP(bf16_t, WS_ABF);
    const int t = F.tid;
    for (int idx = F.bid * NT + t; idx < 5 * 12288; idx += F.nb * NT) {
        const int r = idx / 12288, col = idx % 12288; float v = b_mod[col];
#pragma unroll
        for (int ks = 0; ks < 8; ++ks) v += modp[((size_t)ks * 5 + r) * 12288 + col];
        mod[idx] = v;
    }
    LAS float* Asc = (LAS float*)(F.lds);
    LAS float* Bsh = (LAS float*)(F.lds + 8192);
    for (int tr = F.bid; tr < 512; tr += F.nb) {
        const bool isctx = tr >= 256;
        const int mr = isctx ? 4 : (tr * 32) / SEQ, row0 = isctx ? T + 4 * (tr - 256) : 32 * tr, nrows = isctx ? 4 : 32;
        __syncthreads();
        for (int col = t; col < 2048; col += NT) {
            float sh = b_mod[col], sc = b_mod[2048 + col];
#pragma unroll
            for (int ks = 0; ks < 8; ++ks) { sh += modp[((size_t)ks * 5 + mr) * 12288 + col]; sc += modp[((size_t)ks * 5 + mr) * 12288 + 2048 + col]; }
            Asc[col] = g1n[col] * (1.f + sc); Bsh[col] = sh;
        }
        __syncthreads();
        for (int rr = F.wave; rr < nrows; rr += 8) {
            const int row = row0 + rr;
            const float* src = (row < T) ? (x + (size_t)row * D) : (ctx + (size_t)(row - T) * D);
            f32x4 v[8]; float ss = 0.f;
#pragma unroll
            for (int i = 0; i < 8; ++i) { v[i] = *(const f32x4*)(src + (i * 64 + F.lane) * 4); ss += v[i][0] * v[i][0] + v[i][1] * v[i][1] + v[i][2] * v[i][2] + v[i][3] * v[i][3]; }
            ss = wave_sum(ss);
            const float rs = rsqrtf(ss * (1.f / D) + EPS);
#pragma unroll
            for (int i = 0; i < 8; ++i) {
                const int col = (i * 64 + F.lane) * 4;
                const f32x4 a = *(const LAS f32x4*)(Asc + col), b = *(const LAS f32x4*)(Bsh + col);
#if MK_FP8_INPROJ
                *(unsigned*)((unsigned char*)abf + (size_t)row * D + col) = pk_fp8x4(v[i][0] * rs * a[0] + b[0], v[i][1] * rs * a[1] + b[1], v[i][2] * rs * a[2] + b[2], v[i][3] * rs * a[3] + b[3]);
#else
                u32x2 o; o[0] = pk_bf16(v[i][0] * rs * a[0] + b[0], v[i][1] * rs * a[1] + b[1]); o[1] = pk_bf16(v[i][2] * rs * a[2] + b[2], v[i][3] * rs * a[3] + b[3]);
                *(u32x2*)(abf + (size_t)row * D + col) = o;
                if (MK_FP8_GATES) *(unsigned*)(WSP(unsigned char, WS_ABF8) + (size_t)row * D + col) = pk_fp8x4(v[i][0] * rs * a[0] + b[0], v[i][1] * rs * a[1] + b[1], v[i][2] * rs * a[2] + b[2], v[i][3] * rs * a[3] + b[3]);
#endif
            }
        }
    }
    __syncthreads();
}

struct InProjOrder {
    pg8::StaticOrder so; int G, c;
    __device__ void init(int G_, int c_) { so.init(T, INWP, G_, c_); G = G_; c = c_; }
    __device__ bool next(int i, Unit& u) const {
        const long L = (long)i * G + c;
        if (L < 32 * 53) return so.map(L, u);
        const int j = (int)(L - 32 * 53);
        if (j >= 4 * 17) return false;
        u.pm = 32 + (j & 3); u.pn = 36 + (j >> 2); return true;
    }
};
struct MaskOrder {
    pg8::StaticOrder so; unsigned long long mask, cmask; int G, c, nl, nc;
    __device__ static int sel(unsigned long long m, int k) { int p = 0; for (;;) { if (m & 1ull) { if (k == 0) break; --k; } m >>= 1; ++p; } return p; }
    __device__ void init(unsigned long long m, unsigned long long mctx, int G_, int c_) { mask = m; cmask = mctx >> 36; nl = __builtin_popcountll(m); nc = __builtin_popcountll(mctx >> 36); so.init(T, (nl > 0 ? nl : 1) * 256, G_, c_); G = G_; c = c_; }
    __device__ bool next(int i, Unit& u) const {
        const long L = (long)i * G + c;
        if (L < 32 * nl) { so.map(L, u); u.pn = sel(mask, u.pn); return true; }
        const int j = (int)(L - 32 * nl);
        if (j >= 4 * nc) return false;
        u.pm = 32 + (j & 3); u.pn = 36 + sel(cmask, j >> 2); return true;
    }
};
struct EpiInProj {
    bf16_t *QM, *OMS, *QA, *GBRS, *KM, *VM, *KA, *VAT; float* GM; const float* ROPE; float fs;
    __device__ __forceinline__ void operator()(const f32x4 (&acc)[2][2][4][2], const Unit& u, int wr, int wc, int fr, int fq) const {
        const int pn = u.pn; const float FS = fs;
        const int row0 = u.pm * 256 + wr * 64 + fr;
        const int cw = wc * 32 + 4 * fq;
        if (pn >= 52) {
            if (wc == 0) {
#pragma unroll
                for (int ai = 0; ai < 2; ++ai)
#pragma unroll
                    for (int m = 0; m < 4; ++m) { const int row = row0 + ai * 128 + m * 16;
#pragma unroll
                        for (int n = 0; n < 2; ++n) *(f32x4*)(GM + (size_t)row * 32 + n * 16 + 4 * fq) = acc[ai][0][m][n] * FS; }
            }
            return;
        }
        if (pn >= 50) {
            const int lc0 = (pn - 50) * 256;
#pragma unroll
            for (int ai = 0; ai < 2; ++ai)
#pragma unroll
                for (int m = 0; m < 4; ++m) { const int row = row0 + ai * 128 + m * 16;
#pragma unroll
                    for (int bj = 0; bj < 2; ++bj)
#pragma unroll
                        for (int n = 0; n < 2; ++n) { const int col = lc0 + bj * 128 + n * 16 + cw; const f32x4 v = acc[ai][bj][m][n] * FS;
                            const int t_ = fr & 3; const bool b0_ = t_ & 1, b1_ = t_ & 2;
                            int x0 = __float_as_int(v[0]), x1 = __float_as_int(v[1]), x2 = __float_as_int(v[2]), x3 = __float_as_int(v[3]);
                            { const int sa = b0_ ? x0 : x1, sb = b0_ ? x2 : x3; const int ra = __builtin_amdgcn_mov_dpp(sa, 0xB1, 0xF, 0xF, true), rb = __builtin_amdgcn_mov_dpp(sb, 0xB1, 0xF, 0xF, true);
                              if (b0_) { x0 = ra; x2 = rb; } else { x1 = ra; x3 = rb; } }
                            { const int sa = b1_ ? x0 : x2, sb = b1_ ? x1 : x3; const int ra = __builtin_amdgcn_mov_dpp(sa, 0x4E, 0xF, 0xF, true), rb = __builtin_amdgcn_mov_dpp(sb, 0x4E, 0xF, 0xF, true);
                              if (b1_) { x0 = ra; x1 = rb; } else { x2 = ra; x3 = rb; } }
                            u32x2 o; o[0] = pk_bf16(__int_as_float(x0), __int_as_float(x1)); o[1] = pk_bf16(__int_as_float(x2), __int_as_float(x3));
                            *(u32x2*)(VAT + (size_t)(col + t_) * TR + (row - t_)) = o; } }
            return;
        }
        int kind, lc0, ld; bf16_t* base;
        if (pn < 4)       { kind = 0; base = QM;   ld = 1024; lc0 = pn * 256; }
        else if (pn < 12) { kind = 1; base = OMS;  ld = 2048; lc0 = (pn - 4) * 256; }
        else if (pn < 20) { kind = 2; base = QA;   ld = 2048; lc0 = (pn - 12) * 256; }
        else if (pn < 36) { kind = 1; base = GBRS; ld = 4096; lc0 = (pn - 20) * 256; }
        else if (pn < 40) { kind = 3; base = KM;   ld = 1024; lc0 = (pn - 36) * 256; }
        else if (pn < 48) { kind = 0; base = VM;   ld = 2048; lc0 = (pn - 40) * 256; }
        else              { kind = (u.pm < 32) ? 2 : 0; base = KA; ld = 512; lc0 = (pn - 48) * 256; }
        if (kind == 2) {
#pragma unroll
            for (int ai = 0; ai < 2; ++ai)
#pragma unroll
                for (int m = 0; m < 4; ++m) { const int row = row0 + ai * 128 + m * 16; const int tpos = row & (SEQ - 1);
#pragma unroll
                    for (int bj = 0; bj < 2; ++bj) { const int col = lc0 + bj * 128 + wc * 32 + 8 * fq; const f32x4 v0 = acc[ai][bj][m][0] * FS, v1 = acc[ai][bj][m][1] * FS;
                        const int p = col & 127, axis = p >> 6, i0 = (p & 63) >> 1;
                        const float* cp = ROPE + ((size_t)(tpos * 2 + axis) * 32 + i0) * 2; const f32x4 c0 = *(const f32x4*)cp, c1 = *(const f32x4*)(cp + 4);
                        u32x4 o; o[0] = pk_bf16(v0[0] * c0[0] - v0[1] * c0[1], v0[1] * c0[0] + v0[0] * c0[1]); o[1] = pk_bf16(v0[2] * c0[2] - v0[3] * c0[3], v0[3] * c0[2] + v0[2] * c0[3]);
                        o[2] = pk_bf16(v1[0] * c1[0] - v1[1] * c1[1], v1[1] * c1[0] + v1[0] * c1[1]); o[3] = pk_bf16(v1[2] * c1[2] - v1[3] * c1[3], v1[3] * c1[2] + v1[2] * c1[3]);
                        *(u32x4*)(base + (size_t)row * ld + col) = o; } }
        } else if (kind == 1) {
#pragma unroll
            for (int ai = 0; ai < 2; ++ai)
#pragma unroll
                for (int m = 0; m < 4; ++m) { const int row = row0 + ai * 128 + m * 16;
#pragma unroll
                    for (int bj = 0; bj < 2; ++bj) { const int col = lc0 + bj * 128 + wc * 32 + 8 * fq; const f32x4 v0 = acc[ai][bj][m][0] * FS, v1 = acc[ai][bj][m][1] * FS;
                        u32x4 o; o[0] = pk_bf16(sigmoidf_(v0[0]), sigmoidf_(v0[1])); o[1] = pk_bf16(sigmoidf_(v0[2]), sigmoidf_(v0[3])); o[2] = pk_bf16(sigmoidf_(v1[0]), sigmoidf_(v1[1])); o[3] = pk_bf16(sigmoidf_(v1[2]), sigmoidf_(v1[3]));
                        *(u32x4*)(base + (size_t)row * ld + col) = o; } }
        } else {
            int oz = 0; asm volatile("" : "+v"(oz));
            const float sc = oz ? 2.f : ((kind == 3) ? 0.08838834764831845f : 1.f);
#pragma unroll
            for (int ai = 0; ai < 2; ++ai)
#pragma unroll
                for (int m = 0; m < 4; ++m) { const int row = row0 + ai * 128 + m * 16;
#pragma unroll
                    for (int bj = 0; bj < 2; ++bj) { const int col = lc0 + bj * 128 + wc * 32 + 8 * fq; const f32x4 v0 = acc[ai][bj][m][0] * FS, v1 = acc[ai][bj][m][1] * FS;
                        u32x4 o; o[0] = pk_bf16(v0[0] * sc, v0[1] * sc); o[1] = pk_bf16(v0[2] * sc, v0[3] * sc); o[2] = pk_bf16(v1[0] * sc, v1[1] * sc); o[3] = pk_bf16(v1[2] * sc, v1[3] * sc);
                        *(u32x4*)(base + (size_t)row * ld + col) = o; } }
        }
    }
};

__device__ __forceinline__ void p3_mlstm(const Frame& F) {
    const bf16_t* QM = WSP(bf16_t, WS_QM); const bf16_t* KM = WSP(bf16_t, WS_KM); const bf16_t* VM = WSP(bf16_t, WS_VM);
    const float* GM = WSP(float, WS_GM); const float* gate_b = F.in[8];
    bf16_t* HFB = WSP(bf16_t, WS_HFB);
    LAS unsigned char* L = F.lds;
    constexpr int oQ = 0, oK = 17408, oV = 34816, oKT = 44032, oVT = 62464, oS = 71680, oCT = 80896, oN = 98304, oSC = 98816, oCT2 = 102400, oN2 = 119808;
    const int t = F.tid, lane = F.lane, w = F.wave, r = lane & 15, fq = lane >> 4;
    for (int item = F.bid; item < 256; item += F.nb) {
        const int vs = item & 3, dir = (item >> 2) & 1, h = (item >> 3) & 7, b = item >> 6;
        __syncthreads();
        for (int i = t; i < 17408 / 4; i += NT) ((LAS unsigned*)(L + oCT))[i] = 0u;
        if (t < 128) ((LAS float*)(L + oN))[t] = 0.f;
        f32x4 accC[4];
#pragma unroll
        for (int vt = 0; vt < 4; ++vt) accC[vt] = (f32x4){0.f, 0.f, 0.f, 0.f};
        const float gbi = gate_b[(2 * dir) * 8 + h], gbf = gate_b[(2 * dir + 1) * 8 + h];
        u32x4 qreg[2], kreg[2], vreg;
        auto rowof = [&](int j, int p) -> int {
            if (j < 4) { const int tok = dir ? (CTXL - 1 - (64 * j + p)) : (64 * j + p); return T + b * CTXL + tok; }
            const int tok = dir ? (SEQ - 1 - (64 * (j - 4) + p)) : (64 * (j - 4) + p); return b * SEQ + tok;
        };
#define ML_LOAD(j) do { \
            _Pragma("unroll") for (int i_ = 0; i_ < 2; ++i_) { const int id_ = t + 512 * i_, p_ = id_ >> 4, c16_ = id_ & 15; const int row_ = rowof((j), p_); \
                if ((j) >= 4) qreg[i_] = *(const u32x4*)(QM + (size_t)row_ * 1024 + h * 128 + c16_ * 8); \
                kreg[i_] = *(const u32x4*)(KM + (size_t)row_ * 1024 + h * 128 + c16_ * 8); } \
            { const int p_ = t >> 3, c8_ = t & 7; const int row_ = rowof((j), p_); vreg = *(const u32x4*)(VM + (size_t)row_ * 2048 + h * 256 + vs * 64 + c8_ * 8); } } while (0)
        LAS float* preB = (LAS float*)(L + LDS_PRE_OFF), *preU = preB + 36 * 64, *preA = preU + 36 * 64;
        LAS float* preM = (LAS float*)(L + oSC + 3072);
        for (int jj = w; jj < 36; jj += 8) {
            const int row_ = rowof(jj, lane);
            const float ig = GM[(size_t)row_ * 32 + (2 * dir) * 8 + h] + gbi, f = GM[(size_t)row_ * 32 + (2 * dir + 1) * 8 + h] + gbf;
            const float lf = fminf(f, 0.f) - __logf(1.f + __expf(-fabsf(f)));
            float bs = lf;
#pragma unroll
            for (int d = 1; d < 64; d <<= 1) { const float o = __shfl_up(bs, d); if (lane >= d) bs += o; }
            const float uu = ig - bs;
            float a = uu;
#pragma unroll
            for (int d = 1; d < 64; d <<= 1) { const float o = __shfl_up(a, d); if (lane >= d) a = fmaxf(a, o); }
            preB[jj * 64 + lane] = bs; preU[jj * 64 + lane] = uu; preA[jj * 64 + lane] = a;
        }
        __syncthreads();
        if (t == 0) { float m = 0.f; for (int jj = 0; jj < 36; ++jj) { preM[jj] = m; m = preB[jj * 64 + 63] + fmaxf(m, preA[jj * 64 + 63]); } }
        ML_LOAD(0);
        for (int j = 0; j < 36; ++j) {
            const bool lat = j >= 4;
            const int par = j & 1;
            LAS float* sc_u = (LAS float*)(L + oSC + par * 1536), *sc_M = sc_u + 64, *sc_wi = sc_u + 128, *sc_fl = sc_u + 192, *sc_ws = sc_u + 256, *sc_wc = sc_u + 320;
            LAS unsigned char* sCTp = L + (par ? oCT2 : oCT); LAS unsigned char* sCTn = L + (par ? oCT : oCT2);
            LAS float* sNp = (LAS float*)(L + (par ? oN2 : oN)); LAS float* sNn = (LAS float*)(L + (par ? oN : oN2));
#pragma unroll
            for (int i = 0; i < 2; ++i) { const int id = t + 512 * i, p = id >> 4, c16 = id & 15;
                if (lat) *(LAS u32x4*)(L + oQ + p * 272 + c16 * 16) = qreg[i];
                *(LAS u32x4*)(L + oK + p * 272 + c16 * 16) = kreg[i]; }
            { const int p = t >> 3, c8 = t & 7; *(LAS u32x4*)(L + oV + p * 144 + c8 * 16) = vreg; }
            if (w == 0) {
                const float mj = preM[j], bs = preB[j * 64 + lane], uu = preU[j * 64 + lane], Mp = fmaxf(mj, preA[j * 64 + lane]), M63 = fmaxf(mj, preA[j * 64 + 63]);
                sc_u[lane] = uu; sc_M[lane] = Mp; sc_wi[lane] = __expf(mj - Mp); sc_fl[lane] = __expf(-(bs + Mp)); sc_ws[lane] = __expf(uu - M63);
                if (lane == 0) sc_wc[0] = __expf(mj - M63);
            }
            __syncthreads();
            const float wcs = sc_wc[0];
            if (j + 1 < 36) ML_LOAD(j + 1);
            { const int kp2 = t & 63, s0 = (t >> 6) * 8; float lo[8], hi[8];
#pragma unroll
                for (int e = 0; e < 8; ++e) { const unsigned x = *(const LAS unsigned*)(L + oK + (s0 + e) * 272 + kp2 * 4); const float ws = sc_ws[s0 + e]; lo[e] = bf_lo(x) * ws; hi[e] = bf_hi(x) * ws; }
                u32x4 o; o[0] = pk_bf16(lo[0], lo[1]); o[1] = pk_bf16(lo[2], lo[3]); o[2] = pk_bf16(lo[4], lo[5]); o[3] = pk_bf16(lo[6], lo[7]);
                *(LAS u32x4*)(L + oKT + (2 * kp2) * 144 + s0 * 2) = o;
                o[0] = pk_bf16(hi[0], hi[1]); o[1] = pk_bf16(hi[2], hi[3]); o[2] = pk_bf16(hi[4], hi[5]); o[3] = pk_bf16(hi[6], hi[7]);
                *(LAS u32x4*)(L + oKT + (2 * kp2 + 1) * 144 + s0 * 2) = o; }
            if (t < 256) { const int vp2 = t & 31, s0 = (t >> 5) * 8; unsigned xs[8];
#pragma unroll
                for (int e = 0; e < 8; ++e) xs[e] = *(const LAS unsigned*)(L + oV + (s0 + e) * 144 + vp2 * 4);
                u32x4 o; o[0] = (xs[0] & 0xffffu) | (xs[1] << 16); o[1] = (xs[2] & 0xffffu) | (xs[3] << 16); o[2] = (xs[4] & 0xffffu) | (xs[5] << 16); o[3] = (xs[6] & 0xffffu) | (xs[7] << 16);
                *(LAS u32x4*)(L + oVT + (2 * vp2) * 144 + s0 * 2) = o;
                o[0] = (xs[0] >> 16) | (xs[1] & 0xffff0000u); o[1] = (xs[2] >> 16) | (xs[3] & 0xffff0000u); o[2] = (xs[4] >> 16) | (xs[5] & 0xffff0000u); o[3] = (xs[6] >> 16) | (xs[7] & 0xffff0000u);
                *(LAS u32x4*)(L + oVT + (2 * vp2 + 1) * 144 + s0 * 2) = o; }
            const int pt = w >> 1, c0 = 2 * (w & 1);
            bf16x8 qa[4];
            if (lat) {
#pragma unroll
                for (int ks = 0; ks < 4; ++ks) qa[ks] = *(const LAS bf16x8*)(L + oQ + (16 * pt + r) * 272 + (32 * ks + 8 * fq) * 2);
#pragma unroll
                for (int si = 0; si < 2; ++si) { const int st = c0 + si;
                    f32x4 acc = (f32x4){0.f, 0.f, 0.f, 0.f};
                    if (st <= pt) {
#pragma unroll
                        for (int ks = 0; ks < 4; ++ks) {
                            const bf16x8 bk = *(const LAS bf16x8*)(L + oK + (16 * st + r) * 272 + (32 * ks + 8 * fq) * 2);
                            acc = __builtin_amdgcn_mfma_f32_16x16x32_bf16(qa[ks], bk, acc, 0, 0, 0); }
                    }
                    const int s = 16 * st + r; const float us = sc_u[s];
#pragma unroll
                    for (int rg = 0; rg < 4; ++rg) { const int p = 16 * pt + 4 * fq + rg;
                        const float val = (s <= p) ? acc[rg] * __expf(us - sc_M[p]) : 0.f;
                        *(LAS unsigned short*)(L + oS + p * 144 + s * 2) = (unsigned short)(pk_bf16(val, 0.f) & 0xffffu); }
                }
            }
            __syncthreads();
            if (lat) {
                float part = 0.f;
                { const int prow = 16 * pt + r;
#pragma unroll
                    for (int ks = 0; ks < 4; ++ks) { const u32x4 q8 = __builtin_bit_cast(u32x4, qa[ks]);
                        const f32x4 n0 = *(const LAS f32x4*)(sNp + 32 * ks + 8 * fq), n1 = *(const LAS f32x4*)(sNp + 32 * ks + 8 * fq + 4);
                        part += bf_lo(q8[0]) * n0[0] + bf_hi(q8[0]) * n0[1] + bf_lo(q8[1]) * n0[2] + bf_hi(q8[1]) * n0[3] + bf_lo(q8[2]) * n1[0] + bf_hi(q8[2]) * n1[1] + bf_lo(q8[3]) * n1[2] + bf_hi(q8[3]) * n1[3]; }
                    part *= DBG_NO_STATE ? 0.f : sc_wi[prow];
#pragma unroll
                    for (int ss = 0; ss < 16; ss += 8) { const u32x4 s8 = *(const LAS u32x4*)(L + oS + prow * 144 + (16 * fq + ss) * 2);
#pragma unroll
                        for (int e = 0; e < 4; ++e) part += bf_lo(s8[e]) + bf_hi(s8[e]); }
                    part += __shfl_xor(part, 16); part += __shfl_xor(part, 32);
                    part = __builtin_amdgcn_rcpf(fmaxf(fabsf(part), sc_fl[prow]));
                }
                float invr[4];
#pragma unroll
                for (int rg = 0; rg < 4; ++rg) invr[rg] = __shfl(part, 4 * fq + rg);
#pragma unroll
                for (int vi = 0; vi < 2; ++vi) { const int vt = c0 + vi;
                    f32x4 acc = (f32x4){0.f, 0.f, 0.f, 0.f};
#pragma unroll
                    for (int ks = 0; ks < 4; ++ks) {
                        const bf16x8 bc = *(const LAS bf16x8*)(sCTp + (16 * vt + r) * 272 + (32 * ks + 8 * fq) * 2);
                        acc = __builtin_amdgcn_mfma_f32_16x16x32_bf16(qa[ks], bc, acc, 0, 0, 0); }
#pragma unroll
                    for (int rg = 0; rg < 4; ++rg) acc[rg] *= DBG_NO_STATE ? 0.f : sc_wi[16 * pt + 4 * fq + rg];
#pragma unroll
                    for (int ks = 0; ks < 2; ++ks) { const bf16x8 a = *(const LAS bf16x8*)(L + oS + (16 * pt + r) * 144 + (32 * ks + 8 * fq) * 2);
                        const bf16x8 bv = *(const LAS bf16x8*)(L + oVT + (16 * vt + r) * 144 + (32 * ks + 8 * fq) * 2);
                        acc = __builtin_amdgcn_mfma_f32_16x16x32_bf16(a, bv, acc, 0, 0, 0); }
#pragma unroll
                    for (int rg = 0; rg < 4; ++rg) { const int p = 16 * pt + 4 * fq + rg; const int row = rowof(j, p);
                        HFB[((size_t)dir * T + row) * 2048 + h * 256 + vs * 64 + 16 * vt + r] = (bf16_t)(pk_bf16(acc[rg] * invr[rg], 0.f) & 0xffffu); }
                }
            }
            {
                const int kt = w;
#pragma unroll
                for (int vt = 0; vt < 4; ++vt) accC[vt] *= wcs;
#pragma unroll
                for (int ks = 0; ks < 2; ++ks) { const bf16x8 a = *(const LAS bf16x8*)(L + oKT + (16 * kt + r) * 144 + (32 * ks + 8 * fq) * 2);
#pragma unroll
                    for (int vt = 0; vt < 4; ++vt) { const bf16x8 bv = *(const LAS bf16x8*)(L + oVT + (16 * vt + r) * 144 + (32 * ks + 8 * fq) * 2);
                        accC[vt] = __builtin_amdgcn_mfma_f32_16x16x32_bf16(a, bv, accC[vt], 0, 0, 0); } }
#pragma unroll
                for (int vt = 0; vt < 4; ++vt) { u32x2 o; o[0] = pk_bf16(accC[vt][0], accC[vt][1]); o[1] = pk_bf16(accC[vt][2], accC[vt][3]);
                    *(LAS u32x2*)(sCTn + (16 * vt + r) * 272 + (16 * kt + 4 * fq) * 2) = o; }
                if (t < 128) { float sum = 0.f;
#pragma unroll
                    for (int ss = 0; ss < 64; ss += 8) { const u32x4 k8 = *(const LAS u32x4*)(L + oKT + t * 144 + ss * 2);
#pragma unroll
                        for (int e = 0; e < 4; ++e) sum += bf_lo(k8[e]) + bf_hi(k8[e]); }
                    sNn[t] = wcs * sNp[t] + sum; }
            }
        }
#undef ML_LOAD
    }
    __syncthreads();
}

__device__ __forceinline__ void p3_attn(const Frame& F) {
    const bf16_t* QA = WSP(bf16_t, WS_QA); const bf16_t* KA = WSP(bf16_t, WS_KA); const bf16_t* VAT = WSP(bf16_t, WS_VAT);
    bf16_t* AO = WSP(bf16_t, WS_AO); const float* sink = F.in[10];
    LAS unsigned char* L = F.lds;
    constexpr int KB = 17408, VB = 18432, BUF = KB + VB;
    constexpr float SC = 0.12751743074602542f;
    const int t = F.tid, lane = F.lane, w = F.wave, r = lane & 15, fq = lane >> 4;
    for (int item = F.bid; item < 512; item += F.nb) {
        const int n = item & 15, hp = (item >> 4) & 7, b = item >> 7;
        const int kvh = hp >> 1, head = 2 * hp + (w >> 2), qlo = 128 * n + 32 * (w & 3);
        bf16x8 qf[2][4];
#pragma unroll
        for (int qt = 0; qt < 2; ++qt)
#pragma unroll
            for (int ks = 0; ks < 4; ++ks) qf[qt][ks] = *(const bf16x8*)(QA + (size_t)(b * SEQ + qlo + 16 * qt + r) * 2048 + head * 128 + 32 * ks + 8 * fq);
        const int tlo = (n == 0) ? 2 : 0, thi = (n == 15) ? 4 : 6, ntiles = 4 + thi - tlo;
        f32x4 oacc[8][2];
#pragma unroll
        for (int dt = 0; dt < 8; ++dt) { oacc[dt][0] = (f32x4){0.f, 0.f, 0.f, 0.f}; oacc[dt][1] = (f32x4){0.f, 0.f, 0.f, 0.f}; }
        float mrun[2] = {-1e30f, -1e30f}, lsum[2] = {0.f, 0.f};
        u32x4 kr[2], vr[2];
#define AT_ROW0(i) (((i) < 4) ? (T + b * CTXL + 64 * (i)) : (b * SEQ + 128 * (n - 1) + 64 * (tlo + (i) - 4)))
#define AT_LOAD(i) do { const int row0_ = AT_ROW0(i); \
            _Pragma("unroll") for (int ii_ = 0; ii_ < 2; ++ii_) { const int id_ = t + 512 * ii_; \
                kr[ii_] = *(const u32x4*)(KA + (size_t)(row0_ + (id_ >> 4)) * 512 + kvh * 128 + (id_ & 15) * 8); \
                vr[ii_] = *(const u32x4*)(VAT + (size_t)(kvh * 128 + (id_ >> 3)) * TR + row0_ + (id_ & 7) * 8); } } while (0)
        const int vst = (t >> 3) * 144 + 64 * ((t >> 2) & 1) + 32 * (t & 1) + 8 * ((t >> 1) & 1);
#define AT_STORE(buf) do { _Pragma("unroll") for (int ii_ = 0; ii_ < 2; ++ii_) { const int id_ = t + 512 * ii_; \
                *(LAS u32x4*)(L + (buf) * BUF + (id_ >> 4) * 272 + (id_ & 15) * 16) = kr[ii_]; \
                { LAS unsigned char* vp_ = L + (buf) * BUF + KB + vst + ii_ * (64 * 144);     \
                  *(LAS u32x2*)vp_ = (u32x2){vr[ii_][0], vr[ii_][1]}; *(LAS u32x2*)(vp_ + 16) = (u32x2){vr[ii_][2], vr[ii_][3]}; } } } while (0)
        __syncthreads();
        AT_LOAD(0); AT_STORE(0);
        __syncthreads();
        for (int i = 0; i < ntiles; ++i) {
            if (i + 1 < ntiles) AT_LOAD(i + 1);
            const bool local = i >= 4;
            const int kp0 = 128 * (n - 1) + 64 * (tlo + i - 4);
            const bool active = !local || (kp0 + 63 >= qlo - 128 && kp0 <= qlo + 31 + 128);
            const bool need_mask = local && !(qlo + 31 - kp0 <= 128 && kp0 + 63 - qlo <= 128);
            if (active) {
                LAS unsigned char* sK = L + (i & 1) * BUF; LAS unsigned char* sV = sK + KB;
                f32x4 sacc[4][2];
#pragma unroll
                for (int kt = 0; kt < 4; ++kt) { sacc[kt][0] = (f32x4){0.f, 0.f, 0.f, 0.f}; sacc[kt][1] = (f32x4){0.f, 0.f, 0.f, 0.f}; }
#pragma unroll
                for (int ks = 0; ks < 4; ++ks)
#pragma unroll
                    for (int kt = 0; kt < 4; ++kt) { const bf16x8 a = *(const LAS bf16x8*)(sK + (16 * kt + r) * 272 + (32 * ks + 8 * fq) * 2);
                        sacc[kt][0] = __builtin_amdgcn_mfma_f32_16x16x32_bf16(a, qf[0][ks], sacc[kt][0], 0, 0, 0);
                        sacc[kt][1] = __builtin_amdgcn_mfma_f32_16x16x32_bf16(a, qf[1][ks], sacc[kt][1], 0, 0, 0); }
                bf16x8 pf[2][2];
#pragma unroll
                for (int qt = 0; qt < 2; ++qt) {
                    const int qp = qlo + 16 * qt + r;
                    float mt = -1e30f;
                    if (need_mask) {
#pragma unroll
                        for (int kt = 0; kt < 4; ++kt)
#pragma unroll
                            for (int rg = 0; rg < 4; ++rg) { float s = sacc[kt][qt][rg];
                                const int dd = qp - (kp0 + 16 * kt + 4 * fq + rg); if (dd > 128 || dd < -128) s = -1e30f;
                                sacc[kt][qt][rg] = s; mt = fmaxf(mt, s); }
                    } else {
#pragma unroll
                        for (int kt = 0; kt < 4; ++kt)
#pragma unroll
                            for (int rg = 0; rg < 4; ++rg) mt = fmaxf(mt, sacc[kt][qt][rg]);
                    }
                    mt = fmaxf(mt, __shfl_xor(mt, 16)); mt = fmaxf(mt, __shfl_xor(mt, 32));
                    const float mnew = fmaxf(mrun[qt], mt * SC), alpha = __builtin_amdgcn_exp2f(mrun[qt] - mnew);
                    mrun[qt] = mnew;
                    float ps = 0.f;
#pragma unroll
                    for (int kt = 0; kt < 4; ++kt)
#pragma unroll
                        for (int rg = 0; rg < 4; ++rg) { const float p = __builtin_amdgcn_exp2f(fmaf(sacc[kt][qt][rg], SC, -mnew)); sacc[kt][qt][rg] = p; ps += p; }
                    lsum[qt] = lsum[qt] * alpha + ps;
#pragma unroll
                    for (int dt = 0; dt < 8; ++dt) oacc[dt][qt] *= alpha;
#pragma unroll
                    for (int k2 = 0; k2 < 2; ++k2) { u32x4 o;
                        o[0] = pk_bf16(sacc[2 * k2][qt][0], sacc[2 * k2][qt][1]); o[1] = pk_bf16(sacc[2 * k2][qt][2], sacc[2 * k2][qt][3]);
                        o[2] = pk_bf16(sacc[2 * k2 + 1][qt][0], sacc[2 * k2 + 1][qt][1]); o[3] = pk_bf16(sacc[2 * k2 + 1][qt][2], sacc[2 * k2 + 1][qt][3]);
                        pf[qt][k2] = __builtin_bit_cast(bf16x8, o); }
                }
#pragma unroll
                for (int k2 = 0; k2 < 2; ++k2)
#pragma unroll
                    for (int dh = 0; dh < 2; ++dh) { bf16x8 a[4];
#pragma unroll
                        for (int d4 = 0; d4 < 4; ++d4) a[d4] = *(const LAS bf16x8*)(sV + (16 * (4 * dh + d4) + r) * 144 + 64 * k2 + 16 * fq);
#pragma unroll
                        for (int d4 = 0; d4 < 4; ++d4) { const int dt = 4 * dh + d4;
                            oacc[dt][0] = __builtin_amdgcn_mfma_f32_16x16x32_bf16(a[d4], pf[0][k2], oacc[dt][0], 0, 0, 0);
                            oacc[dt][1] = __builtin_amdgcn_mfma_f32_16x16x32_bf16(a[d4], pf[1][k2], oacc[dt][1], 0, 0, 0); }
                        __builtin_amdgcn_sched_barrier(0); }
            }
            if (i + 1 < ntiles) AT_STORE((i + 1) & 1);
            __syncthreads();
        }
#undef AT_ROW0
#undef AT_LOAD
#undef AT_STORE
        LAS unsigned char* sO = L + w * 8704;
        const float sk = sink[head] * 1.4426950408889634f;
#pragma unroll
        for (int qt = 0; qt < 2; ++qt) {
            float l = lsum[qt]; l += __shfl_xor(l, 16); l += __shfl_xor(l, 32); l += exp2f(sk - mrun[qt]);
            const float inv = __builtin_amdgcn_rcpf(l);
#pragma unroll
#if MK_FP8_MIX
            for (int dt = 0; dt < 8; ++dt) *(LAS unsigned*)(sO + (16 * qt + r) * 144 + 16 * dt + 4 * fq) = pk_fp8x4(oacc[dt][qt][0] * inv, oacc[dt][qt][1] * inv, oacc[dt][qt][2] * inv, oacc[dt][qt][3] * inv);
        }
#pragma unroll
        for (int i = 0; i < 4; ++i) { const int id = i * 64 + lane, row = id >> 3, cc = id & 7;
            const u32x4 v = *(const LAS u32x4*)(sO + row * 144 + cc * 16);
            *(u32x4*)((unsigned char*)AO + (size_t)(b * SEQ + qlo + row) * 2048 + head * 128 + cc * 16) = v; }
#else
            for (int dt = 0; dt < 8; ++dt) { u32x2 o; o[0] = pk_bf16(oacc[dt][qt][0] * inv, oacc[dt][qt][1] * inv); o[1] = pk_bf16(oacc[dt][qt][2] * inv, oacc[dt][qt][3] * inv);
                *(LAS u32x2*)(sO + (16 * qt + r) * 272 + (16 * dt + 4 * fq) * 2) = o; }
        }
#pragma unroll
        for (int i = 0; i < 8; ++i) { const int id = i * 64 + lane, row = id >> 4, cc = id & 15;
            const u32x4 v = *(const LAS u32x4*)(sO + row * 272 + cc * 16);
            *(u32x4*)(AO + (size_t)(b * SEQ + qlo + row) * 2048 + head * 128 + cc * 8) = v; }
#endif
    }
    __syncthreads();
}

__device__ __forceinline__ void p4_postmix(const Frame& F) {
    const bf16_t* HF = WSP(bf16_t, WS_HFB); const bf16_t* HB = HF + (size_t)T * 2048; const bf16_t* OMS = WSP(bf16_t, WS_OMS);
    const float* ng = F.in[9]; bf16_t* AM = WSP(bf16_t, WS_AM);
    for (int row = F.bid * 8 + F.wave; row < T; row += F.nb * 8) {
#pragma unroll
        for (int i = 0; i < 4; ++i) {
            const int col = i * 512 + F.lane * 8;
            const u32x4 a = *(const u32x4*)(HF + (size_t)row * 2048 + col), bq = *(const u32x4*)(HB + (size_t)row * 2048 + col), o8 = *(const u32x4*)(OMS + (size_t)row * 2048 + col);
            float hs[8]; float ss = 0.f;
#pragma unroll
            for (int e = 0; e < 4; ++e) { hs[2 * e] = bf_lo(a[e]) + bf_lo(bq[e]); hs[2 * e + 1] = bf_hi(a[e]) + bf_hi(bq[e]); ss += hs[2 * e] * hs[2 * e] + hs[2 * e + 1] * hs[2 * e + 1]; }
#pragma unroll
            for (int d = 16; d >= 1; d >>= 1) ss += __shfl_xor(ss, d);
            const float rs = rsqrtf(ss * (1.f / 256.f) + EPS);
            const f32x4 g0 = *(const f32x4*)(ng + col), g1 = *(const f32x4*)(ng + col + 4);
            u32x4 o;
            o[0] = pk_bf16(hs[0] * rs * g0[0] * bf_lo(o8[0]), hs[1] * rs * g0[1] * bf_hi(o8[0]));
            o[1] = pk_bf16(hs[2] * rs * g0[2] * bf_lo(o8[1]), hs[3] * rs * g0[3] * bf_hi(o8[1]));
            o[2] = pk_bf16(hs[4] * rs * g1[0] * bf_lo(o8[2]), hs[5] * rs * g1[1] * bf_hi(o8[2]));
            o[3] = pk_bf16(hs[6] * rs * g1[2] * bf_lo(o8[3]), hs[7] * rs * g1[3] * bf_hi(o8[3]));
#if MK_FP8_MIX
            { u32x2 o8v; o8v[0] = pk_fp8x4(bf_lo(o[0]), bf_hi(o[0]), bf_lo(o[1]), bf_hi(o[1])); o8v[1] = pk_fp8x4(bf_lo(o[2]), bf_hi(o[2]), bf_lo(o[3]), bf_hi(o[3]));
              *(u32x2*)((unsigned char*)AM + (size_t)row * 2048 + col) = o8v; }
#else
            *(u32x4*)(AM + (size_t)row * 2048 + col) = o;
#endif
        }
    }
}

struct EpiBr1 {
    float* TMP; const bf16_t* GBRS;
    __device__ __forceinline__ void operator()(const f32x4 (&acc)[2][2][4][2], const Unit& u, int wr, int wc, int fr, int fq) const {
        const int row0 = u.pm * 256 + wr * 64 + fr, col0 = u.pn * 256 + wc * 32 + 8 * fq;
#pragma unroll
        for (int ai = 0; ai < 2; ++ai)
#pragma unroll
            for (int m = 0; m < 4; ++m) { const int row = row0 + ai * 128 + m * 16;
#pragma unroll
                for (int bj = 0; bj < 2; ++bj) { const int col = col0 + bj * 128; const f32x4 v0 = acc[ai][bj][m][0] * (MK_FP8_MIX ? 0.015625f : 1.f), v1 = acc[ai][bj][m][1] * (MK_FP8_MIX ? 0.015625f : 1.f);
                    const u32x4 g = *(const u32x4*)(GBRS + (size_t)row * 4096 + col);
                    u32x4 o; o[0] = pk_bf16(v0[0] * bf_lo(g[0]), v0[1] * bf_hi(g[0])); o[1] = pk_bf16(v0[2] * bf_lo(g[1]), v0[3] * bf_hi(g[1]));
                    o[2] = pk_bf16(v1[0] * bf_lo(g[2]), v1[1] * bf_hi(g[2])); o[3] = pk_bf16(v1[2] * bf_lo(g[3]), v1[3] * bf_hi(g[3]));
                    *(u32x4*)((bf16_t*)TMP + (size_t)row * 2048 + col) = o; } }
    }
};
struct EpiBr2 {
    const float* TMP; const bf16_t* GBRS; bf16_t* AOUT;
    __device__ __forceinline__ void operator()(const f32x4 (&acc)[2][2][4][2], const Unit& u, int wr, int wc, int fr, int fq) const {
        const int row0 = u.pm * 256 + wr * 64 + fr, col0 = u.pn * 256 + wc * 32 + 8 * fq;
#pragma unroll
        for (int ai = 0; ai < 2; ++ai)
#pragma unroll
            for (int m = 0; m < 4; ++m) { const int row = row0 + ai * 128 + m * 16;
#pragma unroll
                for (int bj = 0; bj < 2; ++bj) { const int col = col0 + bj * 128; const f32x4 v0 = acc[ai][bj][m][0] * (MK_FP8_MIX ? 0.015625f : 1.f), v1 = acc[ai][bj][m][1] * (MK_FP8_MIX ? 0.015625f : 1.f);
                    const u32x4 g = *(const u32x4*)(GBRS + (size_t)row * 4096 + 2048 + col);
                    const u32x4 tmb = *(const u32x4*)((const bf16_t*)TMP + (size_t)row * 2048 + col);
                    const float zz = DBG_NO_ATTN ? 0.f : 1.f;
                    u32x4 o; o[0] = pk_bf16(bf_lo(tmb[0]) + zz * v0[0] * bf_lo(g[0]), bf_hi(tmb[0]) + zz * v0[1] * bf_hi(g[0])); o[1] = pk_bf16(bf_lo(tmb[1]) + zz * v0[2] * bf_lo(g[1]), bf_hi(tmb[1]) + zz * v0[3] * bf_hi(g[1]));
                    o[2] = pk_bf16(bf_lo(tmb[2]) + zz * v1[0] * bf_lo(g[2]), bf_hi(tmb[2]) + zz * v1[1] * bf_hi(g[2])); o[3] = pk_bf16(bf_lo(tmb[3]) + zz * v1[2] * bf_lo(g[3]), bf_hi(tmb[3]) + zz * v1[3] * bf_hi(g[3]));
#if MK_FP8_MIX
                    { u32x2 o8; o8[0] = pk_fp8x4(bf_lo(o[0]), bf_hi(o[0]), bf_lo(o[1]), bf_hi(o[1])); o8[1] = pk_fp8x4(bf_lo(o[2]), bf_hi(o[2]), bf_lo(o[3]), bf_hi(o[3]));
                      *(u32x2*)((unsigned char*)AOUT + (size_t)row * 2048 + col) = o8; } } }
#else
                    *(u32x4*)(AOUT + (size_t)row * 2048 + col) = o; } }
#endif
    }
};
struct EpiOut {
    const float* X; const float* MOD; float* X1; float* RSS;
    __device__ __forceinline__ void operator()(const f32x4 (&acc)[2][2][4][2], const Unit& u, int wr, int wc, int fr, int fq) const {
        const int row0 = u.pm * 256 + wr * 64 + fr, col0 = u.pn * 256 + wc * 32 + 8 * fq;
        const float* g1 = MOD + (size_t)((u.pm * 256) / SEQ) * 12288 + 2 * 2048;
        float ssq[2][4];
#pragma unroll
        for (int ai = 0; ai < 2; ++ai)
#pragma unroll
            for (int m = 0; m < 4; ++m) ssq[ai][m] = 0.f;
#pragma unroll
        for (int bj = 0; bj < 2; ++bj)
#pragma unroll
            for (int n = 0; n < 2; ++n) { const int col = col0 + bj * 128 + n * 4; const f32x4 gv = *(const f32x4*)(g1 + col);
#pragma unroll
                for (int ai = 0; ai < 2; ++ai)
#pragma unroll
                    for (int m = 0; m < 4; ++m) { const int row = row0 + ai * 128 + m * 16; const f32x4 v = acc[ai][bj][m][n] * (MK_FP8_MIX ? 0.015625f : 1.f);
                        const f32x4 xv = *(const f32x4*)(X + (size_t)row * 2048 + col);
                        const f32x4 o = xv + gv * v; ssq[ai][m] += (o[0] * o[0] + o[1] * o[1]) + (o[2] * o[2] + o[3] * o[3]);
                        *(f32x4*)(X1 + (size_t)row * 2048 + col) = o; } }
#pragma unroll
        for (int ai = 0; ai < 2; ++ai)
#pragma unroll
            for (int m = 0; m < 4; ++m) { float q = ssq[ai][m]; q += __shfl_xor(q, 16); q += __shfl_xor(q, 32);
                if (fq == 0) RSS[(size_t)(row0 + ai * 128 + m * 16) * 32 + u.pn * 4 + wc] = q; }
    }
};

template <bool DUMMY = false>
__device__ __forceinline__ void p7_norm2_router(const Frame& F) {
    const float* X1 = WSP(float, WS_X1); const float* mod = WSP(float, WS_MOD); const float* g2n = F.in[14]; const float* rss = WSP(float, WS_RSS);
    const float* brg = F.in[16]; const float* bre = F.in[18]; const bf16_t* wrh = WSP(bf16_t, WS_WRT); const bf16_t* wrl = WSP(bf16_t, WS_WRL);
    bf16_t* H2 = WSP(bf16_t, DUMMY ? WS_XG : WS_H2); int* EID = WSP(int, DUMMY ? WS_XG + (64u << 20) : WS_EID); float* WTOP = WSP(float, DUMMY ? WS_XG + (65u << 20) : WS_WTOP); int* POS = WSP(int, DUMMY ? WS_XG + (66u << 20) : WS_POS);
    unsigned* cnt = DUMMY ? (unsigned*)(F.ws + WS_XG + (67u << 20)) : (unsigned*)(F.ws + WS_CTL + CTL_CNT);
    LAS float* Asc = (LAS float*)(F.lds); LAS float* Bsh = (LAS float*)(F.lds + 8192);
    LAS float* lss = (LAS float*)(F.lds + 16384);
    LAS float* lpart = (LAS float*)(F.lds + 16384 + 1024);
    LAS float* lfin = (LAS float*)(F.lds + 16384 + 1024 + 81920);
    const int t = F.tid, lane = F.lane, w = F.wave, r = lane & 15, fq = lane >> 4;
    int cur_mr = -1;
    for (int rg = F.bid; rg < T / 32; rg += F.nb) {
        const int mr = (rg * 32) / SEQ;
        __syncthreads();
        if (mr != cur_mr) {
#pragma unroll
            for (int ci = 0; ci < 2048 / NT; ++ci) { const int col = t + ci * NT; Asc[col] = g2n[col] * (1.f + mod[(size_t)mr * 12288 + 4 * 2048 + col]); Bsh[col] = mod[(size_t)mr * 12288 + 3 * 2048 + col]; }
            cur_mr = mr;
        }
        const float* src = X1 + (size_t)(rg * 32 + r) * D + w * 256 + 8 * fq;
        float rs2[2];
#pragma unroll
        for (int tl = 0; tl < 2; ++tl) {
            const float* rp = rss + (size_t)(rg * 32 + tl * 16 + r) * 32 + fq * 8;
            const f32x4 p0 = *(const f32x4*)rp, p1 = *(const f32x4*)(rp + 4);
            float tot = ((p0[0] + p0[1]) + (p0[2] + p0[3])) + ((p1[0] + p1[1]) + (p1[2] + p1[3]));
            tot += __shfl_xor(tot, 16); tot += __shfl_xor(tot, 32);
            rs2[tl] = rsqrtf(tot * (1.f / D) + EPS);
        }
        __syncthreads();
        f32x4 acc[2][5];
#pragma unroll
        for (int tl = 0; tl < 2; ++tl)
#pragma unroll
            for (int ct = 0; ct < 5; ++ct) acc[tl][ct] = (f32x4){0.f, 0.f, 0.f, 0.f};
#pragma unroll 2
        for (int s0_ = 0; s0_ < 8; ++s0_) {
            const int s_ = (s0_ + F.bid) & 7;
            const int kk = w * 256 + s_ * 32 + 8 * fq;
            bf16x8 bh[5], bl[5];
#pragma unroll
            for (int ct = 0; ct < 5; ++ct) { bh[ct] = *(const bf16x8*)(wrh + (size_t)(16 * ct + r) * WRLD + kk); bl[ct] = *(const bf16x8*)(wrl + (size_t)(16 * ct + r) * WRLD + kk); }
            const f32x4 a0 = *(const LAS f32x4*)(Asc + kk), a1 = *(const LAS f32x4*)(Asc + kk + 4), b0 = *(const LAS f32x4*)(Bsh + kk), b1 = *(const LAS f32x4*)(Bsh + kk + 4);
#pragma unroll
            for (int tl = 0; tl < 2; ++tl) {
                const int row = rg * 32 + tl * 16 + r; const float rs = rs2[tl];
                const f32x4 v0 = *(const f32x4*)(src + (size_t)tl * 16 * D + s_ * 32), v1 = *(const f32x4*)(src + (size_t)tl * 16 * D + s_ * 32 + 4);
                float hv[8];
#pragma unroll
                for (int e = 0; e < 4; ++e) { hv[e] = v0[e] * rs * a0[e] + b0[e]; hv[4 + e] = v1[e] * rs * a1[e] + b1[e]; }
                u32x4 hi, lo;
#pragma unroll
                for (int e = 0; e < 4; ++e) { hi[e] = pk_bf16(hv[2 * e], hv[2 * e + 1]); lo[e] = pk_bf16(hv[2 * e] - bf_lo(hi[e]), hv[2 * e + 1] - bf_hi(hi[e])); }
#if MK_FP8_MOE
                { u32x2 h8; h8[0] = pk_fp8x4(hv[0], hv[1], hv[2], hv[3]); h8[1] = pk_fp8x4(hv[4], hv[5], hv[6], hv[7]); *(u32x2*)((unsigned char*)H2 + (size_t)row * D + kk) = h8; }
#else
                *(u32x4*)(H2 + (size_t)row * D + kk) = hi;
#endif
                const bf16x8 ah = __builtin_bit_cast(bf16x8, hi), al = __builtin_bit_cast(bf16x8, lo);
#pragma unroll
                for (int ct = 0; ct < 5; ++ct) {
                    acc[tl][ct] = __builtin_amdgcn_mfma_f32_16x16x32_bf16(ah, bh[ct], acc[tl][ct], 0, 0, 0);
                    acc[tl][ct] = __builtin_amdgcn_mfma_f32_16x16x32_bf16(ah, bl[ct], acc[tl][ct], 0, 0, 0);
                    acc[tl][ct] = __builtin_amdgcn_mfma_f32_16x16x32_bf16(al, bh[ct], acc[tl][ct], 0, 0, 0);
                }
            }
        }
#pragma unroll
        for (int tl = 0; tl < 2; ++tl)
#pragma unroll
            for (int ct = 0; ct < 5; ++ct)
#pragma unroll
                for (int rg_ = 0; rg_ < 4; ++rg_) lpart[((w * 2 + tl) * 16 + 4 * fq + rg_) * 80 + 16 * ct + r] = acc[tl][ct][rg_];
        __syncthreads();
        for (int idx = t; idx < 32 * 72; idx += NT) {
            const int tk = idx / 72, c_ = idx - tk * 72, tl = tk >> 4, rr = tk & 15;
            float v = (c_ < 8) ? brg[c_] : bre[c_ - 8];
#pragma unroll
            for (int q = 0; q < 8; ++q) v += lpart[((q * 2 + tl) * 16 + rr) * 80 + c_];
            lfin[idx] = v;
        }
        __syncthreads();
        if (t < 32) {
            const int tok = rg * 32 + t;
            float gl[8]; float gmax = -3.0e38f; int gs = 0;
#pragma unroll
            for (int i = 0; i < 8; ++i) { gl[i] = lfin[t * 72 + i]; if (gl[i] > gmax) { gmax = gl[i]; gs = i; } }
            float den = 0.f;
#pragma unroll
            for (int i = 0; i < 8; ++i) den += __expf(gl[i] - gmax);
            const float pg = 1.f / den;
            float v1 = -3.0e38f, v2 = -3.0e38f; int i1 = 0, i2 = 0;
#pragma unroll
            for (int i = 0; i < 8; ++i) { const float ev = lfin[t * 72 + 8 + gs * 8 + i];
                if (ev > v1) { v2 = v1; i2 = i1; v1 = ev; i1 = i; } else if (ev > v2) { v2 = ev; i2 = i; } }
            const float w1 = 1.f / (1.f + __expf(v2 - v1)), w2 = 1.f - w1;
            const int e1 = gs * 8 + i1, e2 = gs * 8 + i2;
            const unsigned p1 = atomicAdd(&cnt[e1], 1u), p2 = atomicAdd(&cnt[e2], 1u);
            EID[2 * tok] = e1; EID[2 * tok + 1] = e2; WTOP[2 * tok] = w1 * pg; WTOP[2 * tok + 1] = w2 * pg; POS[2 * tok] = (int)p1; POS[2 * tok + 1] = (int)p2;
        }
    }
    __syncthreads();
}

__device__ __forceinline__ void p8_lists(const Frame& F) {
    const unsigned* cnt = (const unsigned*)(F.ws + WS_CTL + CTL_CNT);
    const int* EID = WSP(int, WS_EID); const float* WTOP = WSP(float, WS_WTOP); const int* POS = WSP(int, WS_POS);
    int* ROWMAP = WSP(int, WS_ROWMAP); float* ROWW = WSP(float, WS_ROWW); int* ROWTOK = WSP(int, WS_ROWTOK); int* PST = WSP(int, WS_PANEL);
    LAS int* pstart = (LAS int*)(F.lds + LDS_TAB_OFF);
    __syncthreads();
    if (F.tid == 0) {
        int acc = 0;
        for (int e = 0; e < NEXP; ++e) { pstart[e] = acc; if (F.bid == 0) PST[e] = acc; acc += (int)cnt[e]; }
        pstart[NEXP] = acc; if (F.bid == 0) PST[NEXP] = acc;
    }
    __syncthreads();
    for (int a = F.bid * NT + F.tid; a < 2 * T; a += F.nb * NT) {
        const int pos = pstart[EID[a]] + POS[a];
        ROWMAP[pos] = a; ROWW[pos] = WTOP[a]; ROWTOK[pos] = a >> 1;
    }
}

__device__ __forceinline__ int moe_phys(int s) { return s ^ ((s >> 3) & 3); }
template <bool GU, int VAR = 0>
__device__ __forceinline__ void moe_gemm(const Frame& F) {
    constexpr int K = GU ? 2048 : 1024, NT2 = K / 64, LDB = GU ? 1024 : 2048, LDA = GU ? 2048 : 1024;
    constexpr int STG = 65536, BOFF = 49152;
    const int* PST = WSP(int, WS_PANEL); const int* ROWTOK = WSP(int, WS_ROWTOK); const int* ROWMAP = WSP(int, WS_ROWMAP); const float* ROWW = WSP(float, WS_ROWW);
    const bf16_t* H2 = WSP(bf16_t, WS_H2); bf16_t* HBUF = WSP(bf16_t, VAR ? WS_XG : WS_HBUF); bf16_t* YBUF = WSP(bf16_t, WS_YBUF);
    LAS unsigned char* L = F.lds;
    const int nrounds = (NEXP * 16 + F.nb - 1) / F.nb;
    for (int rnd = 0; rnd < nrounds; ++rnd) {
        int unit;
        if ((F.nb & 127) == 0) { const int xcd = F.bid & 7, j = F.bid >> 3, epx = F.nb >> 7;
            unit = ((rnd * 8 + xcd) * epx + (j >> 4)) * 16 + (j & 15); }
        else unit = rnd * F.nb + F.bid;
        if (unit >= NEXP * 16) continue;
        const int e = unit >> 4, nti = unit & 15;
        const int ps = PST[e], Me = PST[e + 1] - ps;
        for (int m0 = 0; m0 < Me; m0 += 320) {
            const int rows = (Me - m0) < 320 ? (Me - m0) : 320;
            int tz = threadIdx.x; asm volatile("" : "+v"(tz));
            const int t = tz, w = __builtin_amdgcn_readfirstlane(tz >> 6), lane = tz & 63, fr = lane & 15, fq = lane >> 4, wr4 = (w >> 1) & 3, wc2 = w & 1;
            const bool bwave = w < 4;
            f32x4 acc[5][4];
#pragma unroll
            for (int m = 0; m < 5; ++m)
#pragma unroll
                for (int ns = 0; ns < 4; ++ns) acc[m][ns] = (f32x4){0.f, 0.f, 0.f, 0.f};
            int boffr[4];
#pragma unroll
            for (int ns = 0; ns < 4; ++ns) boffr[ns] = BOFF + (fq * 128 + moe_phys(64 * wc2 + 16 * ns + fr)) * 16;
            const int arow0 = 80 * wr4 + fr;
            const bool ga = (80 * wr4) < rows, gb = (80 * wr4 + 48) < rows;
#define MOE_LDA(dst_, h_, n_, sb_, ks_) do { _Pragma("unroll") for (int q_ = 0; q_ < (n_); ++q_) { const int r_ = arow0 + 16 * ((h_) * 3 + q_); \
                dst_[q_] = *(const LAS bf16x8*)((sb_) + r_ * 128 + (((4 * (ks_) + fq) ^ ((r_ >> 1) & 7)) * 16)); } } while (0)
#define MOE_LDB(dst_, sb_, ks_) do { _Pragma("unroll") for (int ns_ = 0; ns_ < 4; ++ns_) dst_[ns_] = *(const LAS bf16x8*)((sb_) + boffr[ns_] + (ks_) * (4 * 128 * 16)); } while (0)
#define MOE_MM(bf_, af_, h_, n_) do { _Pragma("unroll") for (int q_ = 0; q_ < (n_); ++q_) _Pragma("unroll") for (int ns_ = 0; ns_ < 4; ++ns_) \
                acc[(h_) * 3 + q_][ns_] = __builtin_amdgcn_mfma_f32_16x16x32_bf16(bf_[ns_], af_[q_], acc[(h_) * 3 + q_][ns_], 0, 0, 0); } while (0)
#define MOE_COMPUTE(st_) do { LAS unsigned char* sb_ = L + (st_) * STG; if (ga) { bf16x8 b0_[4], b1_[4], a0_[3], a1_[2], a2_[3], a3_[2]; \
            MOE_LDB(b0_, sb_, 0); MOE_LDA(a0_, 0, 3, sb_, 0); MOE_LDA(a1_, 1, 2, sb_, 0); __builtin_amdgcn_sched_barrier(0); \
            MOE_MM(b0_, a0_, 0, 3); MOE_LDB(b1_, sb_, 1); MOE_LDA(a2_, 0, 3, sb_, 1); __builtin_amdgcn_sched_barrier(0); \
            if (gb) MOE_MM(b0_, a1_, 1, 2); MOE_LDA(a3_, 1, 2, sb_, 1); __builtin_amdgcn_sched_barrier(0); \
            MOE_MM(b1_, a2_, 0, 3); if (gb) MOE_MM(b1_, a3_, 1, 2); } } while (0)
            if (bwave) {
                int boff[4]; u32x4 stg[16]; const char* bbase; unsigned blane;
                {
                    int n4, kp, scol, isup = 0;
                    if (GU) { const int tg = t & 127; n4 = tg & 15; kp = tg >> 4; isup = w >> 1; scol = 64 * nti; bbase = (const char*)(F.in[isup ? 20 : 19] + (size_t)e * 2048 * 1024 + scol); }
                    else    { n4 = t & 31; kp = t >> 5; scol = 128 * nti; bbase = (const char*)(F.in[21] + (size_t)e * 1024 * 2048 + scol); }
                    blane = (unsigned)(((8 * kp) * LDB + 4 * n4) * 4);
#pragma unroll
                    for (int j = 0; j < 4; ++j) { const int g = 4 * n4 + j; const int s0 = GU ? (64 * (g >> 5) + (g & 31) + 32 * isup) : g;
                        boff[j] = BOFF + (kp * 128 + moe_phys(s0)) * 16; }
                }
#define MOE_LOADB(slot, tile) do { _Pragma("unroll") for (int i_ = 0; i_ < 8; ++i_) stg[(slot) * 8 + i_] = *(const u32x4*)(bbase + ((size_t)(tile) * 64 + i_) * (LDB * 4) + blane); } while (0)
                MOE_LOADB(0, 0); __builtin_amdgcn_sched_barrier(0); MOE_LOADB(1, 1); __builtin_amdgcn_sched_barrier(0);
#define MOE_BSTEP(s) do { LAS unsigned char* sw_ = L + (s) * STG; \
                { f32x4 b_[8]; _Pragma("unroll") for (int i_ = 0; i_ < 8; ++i_) b_[i_] = __builtin_bit_cast(f32x4, stg[(s) * 8 + i_]); \
                  _Pragma("unroll") for (int j_ = 0; j_ < 4; ++j_) { u32x4 o_; o_[0] = pk_bf16(b_[0][j_], b_[1][j_]); o_[1] = pk_bf16(b_[2][j_], b_[3][j_]); o_[2] = pk_bf16(b_[4][j_], b_[5][j_]); o_[3] = pk_bf16(b_[6][j_], b_[7][j_]); \
                      *(LAS u32x4*)(sw_ + boff[j_]) = o_; } } \
                __builtin_amdgcn_sched_barrier(0); \
                if (VAR != 4 && VAR != 5) { const int tn_ = (tt + (s) + 2) < NT2 ? (tt + (s) + 2) : (NT2 - 1); MOE_LOADB((s), tn_); } \
                __syncthreads(); if (VAR != 2) MOE_COMPUTE(s); } while (0)
                for (int tt = 0; tt < NT2; tt += 2) { MOE_BSTEP(0); MOE_BSTEP(1); }
#undef MOE_BSTEP
#undef MOE_LOADB
            } else {
                unsigned arow[10]; const char* abase = (const char*)(GU ? H2 : WSP(bf16_t, WS_HBUF)); int ldst0;
                {
                    const int ta = t - 256, r0 = ta >> 3, p = ta & 7;
#pragma unroll
                    for (int i = 0; i < 10; ++i) { const int r = r0 + 32 * i, rr = r < rows ? r : rows - 1;
                        arow[i] = (unsigned)(GU ? ROWTOK[ps + m0 + rr] : (ps + m0 + rr)) * (unsigned)(LDA * 2) + (unsigned)((p ^ ((r0 >> 1) & 7)) * 16); }
                    ldst0 = (w - 4) * 8 * 128;
                }
#define MOE_GLDSA(st_, tile) do { _Pragma("unroll") for (int i_ = 0; i_ < 10; ++i_) \
                    __builtin_amdgcn_global_load_lds((const unsigned*)(abase + (size_t)((tile) * 128) + arow[i_]), (LAS unsigned*)(L + (st_) * STG + ldst0 + i_ * 4096), 16, 0, 0); } while (0)
                MOE_GLDSA(0, 0);
#define MOE_ASTEP(s) do { asm volatile("s_waitcnt vmcnt(0)" ::: "memory"); __syncthreads(); \
                if (VAR != 3 && VAR != 5) { const int tn_ = (tt + (s) + 1) < NT2 ? (tt + (s) + 1) : (NT2 - 1); MOE_GLDSA((s) ^ 1, tn_); } \
                if (VAR != 2) MOE_COMPUTE(s); } while (0)
                for (int tt = 0; tt < NT2; tt += 2) { MOE_ASTEP(0); MOE_ASTEP(1); }
                asm volatile("s_waitcnt vmcnt(0)" ::: "memory");
#undef MOE_ASTEP
#undef MOE_GLDSA
            }
#undef MOE_COMPUTE
#undef MOE_MM
#undef MOE_LDB
#undef MOE_LDA
            int te = threadIdx.x; asm volatile("" : "+v"(te));
            const int fr_e = te & 15, fq_e = (te >> 4) & 3, wr4_e = (te >> 7) & 3, wc2_e = (te >> 6) & 1;
#pragma unroll
            for (int m = 0; m < 5; ++m) {
                const int row = 80 * wr4_e + 16 * m + fr_e;
                if (row < rows) {
                    const int gpos = ps + m0 + row;
                    if (GU) {
#pragma unroll
                        for (int ns = 0; ns < 2; ++ns) { const f32x4 g = acc[m][ns], up = acc[m][ns + 2];
                            u32x2 o; o[0] = pk_bf16(g[0] * sigmoidf_(g[0]) * up[0], g[1] * sigmoidf_(g[1]) * up[1]); o[1] = pk_bf16(g[2] * sigmoidf_(g[2]) * up[2], g[3] * sigmoidf_(g[3]) * up[3]);
                            *(u32x2*)(HBUF + (size_t)gpos * 1024 + 64 * nti + 32 * wc2_e + 16 * ns + 4 * fq_e) = o; }
                    } else {
                        const int a = ROWMAP[gpos]; const float wt = ROWW[gpos];
#pragma unroll
                        for (int ns = 0; ns < 4; ++ns) { const f32x4 v = acc[m][ns];
                            u32x2 o; o[0] = pk_bf16(v[0] * wt, v[1] * wt); o[1] = pk_bf16(v[2] * wt, v[3] * wt);
                            *(u32x2*)(YBUF + (size_t)a * 2048 + 128 * nti + 64 * wc2_e + 16 * ns + 4 * fq_e) = o; }
                    }
                }
            }
        }
    }
    __syncthreads();
}

template <bool GU>
__device__ __forceinline__ void moe_gemm8(const Frame& F) {
    constexpr int K = GU ? 2048 : 1024, NT = K / 128, LDB = GU ? 1024 : 2048, LDAB = GU ? 2048 : 1024;
    constexpr int STG = 65536, BOFF = 49152;
    const int* PST = WSP(int, WS_PANEL); const int* ROWTOK = WSP(int, WS_ROWTOK); const int* ROWMAP = WSP(int, WS_ROWMAP); const float* ROWW = WSP(float, WS_ROWW);
    const unsigned char* H2 = WSP(unsigned char, WS_H2); unsigned char* HBUF = WSP(unsigned char, WS_HBUF); bf16_t* YBUF = WSP(bf16_t, WS_YBUF);
    LAS unsigned char* L = F.lds;
    const int nrounds = (NEXP * 16 + F.nb - 1) / F.nb;
    for (int rnd = 0; rnd < nrounds; ++rnd) {
        int unit;
        if ((F.nb & 127) == 0) { const int xcd = F.bid & 7, j = F.bid >> 3, epx = F.nb >> 7;
            unit = ((rnd * 8 + xcd) * epx + (j >> 4)) * 16 + (j & 15); }
        else unit = rnd * F.nb + F.bid;
        if (unit >= NEXP * 16) continue;
        const int e = unit >> 4, nti = unit & 15;
        const int ps = PST[e], Me = PST[e + 1] - ps;
        for (int m0 = 0; m0 < Me; m0 += 320) {
            const int rows = (Me - m0) < 320 ? (Me - m0) : 320;
            int tz = threadIdx.x; asm volatile("" : "+v"(tz));
            const int t = tz, w = __builtin_amdgcn_readfirstlane(tz >> 6), lane = tz & 63, fr = lane & 15, fq = lane >> 4, wr4 = (w >> 1) & 3, wc2 = w & 1;
            const bool bwave = w < 4;
            f32x4 acc[5][4];
#pragma unroll
            for (int m = 0; m < 5; ++m)
#pragma unroll
                for (int ns = 0; ns < 4; ++ns) acc[m][ns] = (f32x4){0.f, 0.f, 0.f, 0.f};
            int boffr[4];
#pragma unroll
            for (int ns = 0; ns < 4; ++ns) boffr[ns] = BOFF + (fq * 128 + moe_phys(64 * wc2 + 16 * ns + fr)) * 16;
            const int arow0 = 80 * wr4 + fr;
            const bool ga = (80 * wr4) < rows, gb = (80 * wr4 + 48) < rows;
#define M8_LDA(dst_, h_, n_, sb_, ks_) do { _Pragma("unroll") for (int q_ = 0; q_ < (n_); ++q_) { const int r_ = arow0 + 16 * ((h_) * 3 + q_); \
                dst_[q_] = *(const LAS v4i_t*)((sb_) + r_ * 128 + (((4 * (ks_) + fq) ^ ((r_ >> 1) & 7)) * 16)); } } while (0)
#define M8_LDB(dst_, sb_, ks_) do { _Pragma("unroll") for (int ns_ = 0; ns_ < 4; ++ns_) dst_[ns_] = *(const LAS v4i_t*)((sb_) + boffr[ns_] + (ks_) * (4 * 128 * 16)); } while (0)
#define M8_MM(bl_, bh_, al_, ah_, h_, n_) do { _Pragma("unroll") for (int q_ = 0; q_ < (n_); ++q_) _Pragma("unroll") for (int ns_ = 0; ns_ < 4; ++ns_) \
                acc[(h_) * 3 + q_][ns_] = __builtin_amdgcn_mfma_scale_f32_16x16x128_f8f6f4(__builtin_shufflevector(bl_[ns_], bh_[ns_], 0, 1, 2, 3, 4, 5, 6, 7), \
                    __builtin_shufflevector(al_[q_], ah_[q_], 0, 1, 2, 3, 4, 5, 6, 7), acc[(h_) * 3 + q_][ns_], 0, 0, 0, 0, 0, 0); } while (0)
#define M8_COMPUTE(st_) do { LAS unsigned char* sb_ = L + (st_) * STG; if (ga) { v4i_t b0_[4], b1_[4], a0_[3], a1_[3], c0_[2], c1_[2]; \
            M8_LDB(b0_, sb_, 0); M8_LDB(b1_, sb_, 1); M8_LDA(a0_, 0, 3, sb_, 0); M8_LDA(a1_, 0, 3, sb_, 1); __builtin_amdgcn_sched_barrier(0); \
            M8_LDA(c0_, 1, 2, sb_, 0); M8_LDA(c1_, 1, 2, sb_, 1); M8_MM(b0_, b1_, a0_, a1_, 0, 3); __builtin_amdgcn_sched_barrier(0); \
            if (gb) M8_MM(b0_, b1_, c0_, c1_, 1, 2); } } while (0)
#if MK_WSTREAM
            {
                (void)bwave;
                unsigned arow[5]; const char* abase = (const char*)(GU ? H2 : (const unsigned char*)HBUF);
                const unsigned char* wbase = (GU ? WSP(unsigned char, WS_W8GU) + (size_t)e * 4194304 + (size_t)nti * 262144 : WSP(unsigned char, WS_W8D) + (size_t)e * 2097152 + (size_t)nti * 131072) + w * 2048 + lane * 16;
                {
                    const int r0 = w * 8 + (lane >> 3), p = lane & 7;
#pragma unroll
                    for (int i = 0; i < 5; ++i) { const int r = r0 + 64 * i, rr = r < rows ? r : rows - 1;
                        arow[i] = (unsigned)(GU ? ROWTOK[ps + m0 + rr] : (ps + m0 + rr)) * (unsigned)LDAB + (unsigned)((p ^ ((r0 >> 1) & 7)) * 16); }
                }
#define M8_GLDS(st_, tile) do { _Pragma("unroll") for (int i_ = 0; i_ < 5; ++i_) \
                    __builtin_amdgcn_global_load_lds((const unsigned*)(abase + (size_t)((tile) * 128) + arow[i_]), (LAS unsigned*)(L + (st_) * STG + w * 1024 + i_ * 8192), 16, 0, 0); \
                _Pragma("unroll") for (int j_ = 0; j_ < 2; ++j_) \
                    __builtin_amdgcn_global_load_lds((const unsigned*)(wbase + (size_t)(tile) * 16384 + j_ * 1024), (LAS unsigned*)(L + (st_) * STG + BOFF + w * 2048 + j_ * 1024), 16, 0, 0); } while (0)
                M8_GLDS(0, 0);
#define M8_STEP(s) do { asm volatile("s_waitcnt vmcnt(0)" ::: "memory"); __syncthreads(); \
                { const int tn_ = (tt + (s) + 1) < NT ? (tt + (s) + 1) : (NT - 1); M8_GLDS((s) ^ 1, tn_); } \
                M8_COMPUTE(s); } while (0)
                for (int tt = 0; tt < NT; tt += 2) { M8_STEP(0); M8_STEP(1); }
                asm volatile("s_waitcnt vmcnt(0)" ::: "memory");
#undef M8_STEP
#undef M8_GLDS
            }
#else
            if (bwave) {
                int boff[4]; u32x4 stg[16]; const char* bbase; unsigned blane;
                {
                    int n4, kp, scol, isup = 0;
                    if (GU) { const int tg = t & 127; n4 = tg & 15; kp = tg >> 4; isup = w >> 1; scol = 64 * nti; bbase = (const char*)(F.in[isup ? 20 : 19] + (size_t)e * 2048 * 1024 + scol); }
                    else    { n4 = t & 31; kp = t >> 5; scol = 128 * nti; bbase = (const char*)(F.in[21] + (size_t)e * 1024 * 2048 + scol); }
                    blane = (unsigned)(((8 * kp) * LDB + 4 * n4) * 4);
#pragma unroll
                    for (int j = 0; j < 4; ++j) { const int g = 4 * n4 + j; const int s0 = GU ? (64 * (g >> 5) + (g & 31) + 32 * isup) : g;
                        boff[j] = BOFF + ((kp >> 1) * 128 + moe_phys(s0)) * 16 + 8 * (kp & 1); }
                }
#define M8_LOADB(tile) do { _Pragma("unroll") for (int h_ = 0; h_ < 2; ++h_) _Pragma("unroll") for (int i_ = 0; i_ < 8; ++i_) \
                    stg[h_ * 8 + i_] = *(const u32x4*)(bbase + ((size_t)(tile) * 128 + 64 * h_ + i_) * (LDB * 4) + blane); } while (0)
                M8_LOADB(0); __builtin_amdgcn_sched_barrier(0);
#define M8_BSTEP(s) do { LAS unsigned char* sw_ = L + (s) * STG; \
                _Pragma("unroll") for (int h_ = 0; h_ < 2; ++h_) { f32x4 b_[8]; _Pragma("unroll") for (int i_ = 0; i_ < 8; ++i_) b_[i_] = __builtin_bit_cast(f32x4, stg[h_ * 8 + i_]) * 64.f; \
                  _Pragma("unroll") for (int j_ = 0; j_ < 4; ++j_) { u32x2 o_; o_[0] = pk_fp8x4(b_[0][j_], b_[1][j_], b_[2][j_], b_[3][j_]); o_[1] = pk_fp8x4(b_[4][j_], b_[5][j_], b_[6][j_], b_[7][j_]); \
                      *(LAS u32x2*)(sw_ + boff[j_] + h_ * 8192) = o_; } } \
                __builtin_amdgcn_sched_barrier(0); \
                { const int tn_ = (tt + (s) + 1) < NT ? (tt + (s) + 1) : (NT - 1); M8_LOADB(tn_); } \
                __syncthreads(); M8_COMPUTE(s); } while (0)
                for (int tt = 0; tt < NT; tt += 2) { M8_BSTEP(0); M8_BSTEP(1); }
#undef M8_BSTEP
#undef M8_LOADB
            } else {
                unsigned arow[10]; const char* abase = (const char*)(GU ? H2 : (const unsigned char*)HBUF); int ldst0;
                {
                    const int ta = t - 256, r0 = ta >> 3, p = ta & 7;
#pragma unroll
                    for (int i = 0; i < 10; ++i) { const int r = r0 + 32 * i, rr = r < rows ? r : rows - 1;
                        arow[i] = (unsigned)(GU ? ROWTOK[ps + m0 + rr] : (ps + m0 + rr)) * (unsigned)LDAB + (unsigned)((p ^ ((r0 >> 1) & 7)) * 16); }
                    ldst0 = (w - 4) * 8 * 128;
                }
#define M8_GLDSA(st_, tile) do { _Pragma("unroll") for (int i_ = 0; i_ < 10; ++i_) \
                    __builtin_amdgcn_global_load_lds((const unsigned*)(abase + (size_t)((tile) * 128) + arow[i_]), (LAS unsigned*)(L + (st_) * STG + ldst0 + i_ * 4096), 16, 0, 0); } while (0)
                M8_GLDSA(0, 0);
#define M8_ASTEP(s) do { asm volatile("s_waitcnt vmcnt(0)" ::: "memory"); __syncthreads(); \
                { const int tn_ = (tt + (s) + 1) < NT ? (tt + (s) + 1) : (NT - 1); M8_GLDSA((s) ^ 1, tn_); } \
                M8_COMPUTE(s); } while (0)
                for (int tt = 0; tt < NT; tt += 2) { M8_ASTEP(0); M8_ASTEP(1); }
                asm volatile("s_waitcnt vmcnt(0)" ::: "memory");
#undef M8_ASTEP
#undef M8_GLDSA
            }
#endif
#undef M8_COMPUTE
#undef M8_MM
#undef M8_LDB
#undef M8_LDA
            int te = threadIdx.x; asm volatile("" : "+v"(te));
            const int fr_e = te & 15, fq_e = (te >> 4) & 3, wr4_e = (te >> 7) & 3, wc2_e = (te >> 6) & 1;
#pragma unroll
            for (int m = 0; m < 5; ++m) {
                const int row = 80 * wr4_e + 16 * m + fr_e;
                if (row < rows) {
                    const int gpos = ps + m0 + row;
                    if (GU) {
#pragma unroll
                        for (int ns = 0; ns < 2; ++ns) { const f32x4 g = acc[m][ns] * 0.015625f, up = acc[m][ns + 2] * 0.0625f;
                            *(unsigned*)(HBUF + (size_t)gpos * 1024 + 64 * nti + 32 * wc2_e + 16 * ns + 4 * fq_e) =
                                pk_fp8x4(g[0] * sigmoidf_(g[0]) * up[0], g[1] * sigmoidf_(g[1]) * up[1], g[2] * sigmoidf_(g[2]) * up[2], g[3] * sigmoidf_(g[3]) * up[3]); }
                    } else {
                        const int a = ROWMAP[gpos]; const float wt = ROWW[gpos] * 0.00390625f;
#pragma unroll
                        for (int ns = 0; ns < 4; ++ns) { const f32x4 v = acc[m][ns];
                            u32x2 o; o[0] = pk_bf16(v[0] * wt, v[1] * wt); o[1] = pk_bf16(v[2] * wt, v[3] * wt);
                            *(u32x2*)(YBUF + (size_t)a * 2048 + 128 * nti + 64 * wc2_e + 16 * ns + 4 * fq_e) = o; }
                    }
                }
            }
        }
    }
    __syncthreads();
}

template <bool GU>
__device__ __forceinline__ void moe_gemm8w(const Frame& F) {
    constexpr int K = GU ? 2048 : 1024, NT = K / 128, LDAB = GU ? 2048 : 1024;
    constexpr int STG = 65536, BOFF = 49152;
    const int* PST = WSP(int, WS_PANEL); const int* ROWTOK = WSP(int, WS_ROWTOK); const int* ROWMAP = WSP(int, WS_ROWMAP); const float* ROWW = WSP(float, WS_ROWW);
    const unsigned char* H2 = WSP(unsigned char, WS_H2); unsigned char* HBUF = WSP(unsigned char, WS_HBUF); bf16_t* YBUF = WSP(bf16_t, WS_YBUF);
    LAS unsigned char* L = F.lds;
    const int nrounds = (NEXP * 16 + F.nb - 1) / F.nb;
    const char* abase = (const char*)(GU ? H2 : (const unsigned char*)HBUF);
    int c_rnd = 0, c_m0 = 0;
#define M8_GET(ok_, e_, nti_, ps_, m0_, rows_) do { ok_ = false; for (;;) { if (c_rnd >= nrounds) break; int unit_; \
        if ((F.nb & 127) == 0) { const int xcd_ = F.bid & 7, j_ = F.bid >> 3, epx_ = F.nb >> 7; unit_ = ((c_rnd * 8 + xcd_) * epx_ + (j_ >> 4)) * 16 + (j_ & 15); } else unit_ = c_rnd * F.nb + F.bid; \
        if (unit_ >= NEXP * 16) { ++c_rnd; c_m0 = 0; continue; } \
        const int pe_ = PST[unit_ >> 4], me_ = PST[(unit_ >> 4) + 1] - pe_; if (c_m0 >= me_) { ++c_rnd; c_m0 = 0; continue; } \
        e_ = unit_ >> 4; nti_ = unit_ & 15; ps_ = pe_; m0_ = c_m0; rows_ = (me_ - c_m0) < 320 ? (me_ - c_m0) : 320; c_m0 += 320; ok_ = true; break; } } while (0)
#define M8_AROW(dst_, ps_, m0_, rows_) do { int tq_ = threadIdx.x; asm volatile("" : "+v"(tq_)); const int wq_ = __builtin_amdgcn_readfirstlane(tq_ >> 6), r0_ = wq_ * 8 + ((tq_ & 63) >> 3), p_ = tq_ & 7; \
        _Pragma("unroll") for (int i_ = 0; i_ < 5; ++i_) { const int r_ = r0_ + 64 * i_, rr_ = r_ < (rows_) ? r_ : (rows_) - 1; \
            dst_[i_] = (unsigned)(GU ? ROWTOK[(ps_) + (m0_) + rr_] : ((ps_) + (m0_) + rr_)) * (unsigned)LDAB + (unsigned)((p_ ^ ((r0_ >> 1) & 7)) * 16); } } while (0)
#define M8_WBASE(e_, nti_) ((GU ? WSP(unsigned char, WS_W8GU) + (size_t)(e_) * 4194304 + (size_t)(nti_) * 262144 : WSP(unsigned char, WS_W8D) + (size_t)(e_) * 2097152 + (size_t)(nti_) * 131072))
#define M8_GLDS(ar_, wb_, st_, tile) do { int tq_ = threadIdx.x; asm volatile("" : "+v"(tq_)); const int wq_ = __builtin_amdgcn_readfirstlane(tq_ >> 6); \
        _Pragma("unroll") for (int i_ = 0; i_ < 5; ++i_) \
            __builtin_amdgcn_global_load_lds((const unsigned*)(abase + (size_t)((tile) * 128) + ar_[i_]), (LAS unsigned*)(L + (st_) * STG + wq_ * 1024 + i_ * 8192), 16, 0, 0); \
        _Pragma("unroll") for (int j_ = 0; j_ < 2; ++j_) \
            __builtin_amdgcn_global_load_lds((const unsigned*)((wb_) + wq_ * 2048 + (tq_ & 63) * 16 + (size_t)(tile) * 16384 + j_ * 1024), (LAS unsigned*)(L + (st_) * STG + BOFF + wq_ * 2048 + j_ * 1024), 16, 0, 0); } while (0)
    bool hc; int e = 0, nti = 0, ps = 0, m0 = 0, rows = 1;
    M8_GET(hc, e, nti, ps, m0, rows);
    unsigned arow[5]; const unsigned char* wbase = nullptr;
    if (hc) { M8_AROW(arow, ps, m0, rows); wbase = M8_WBASE(e, nti); __syncthreads(); M8_GLDS(arow, wbase, 0, 0); }
    while (hc) {
        bool hn; int en = 0, ntin = 0, psn = 0, m0n = 0, rowsn = 1;
        M8_GET(hn, en, ntin, psn, m0n, rowsn);
        unsigned arown[5]; const unsigned char* wbasen = nullptr;
        if (hn) { M8_AROW(arown, psn, m0n, rowsn); wbasen = M8_WBASE(en, ntin); }
        {
            int tz = threadIdx.x; asm volatile("" : "+v"(tz));
            const int w = __builtin_amdgcn_readfirstlane(tz >> 6), lane = tz & 63, fr = lane & 15, fq = lane >> 4, wr4 = (w >> 1) & 3, wc2 = w & 1;
            f32x4 acc[5][4];
#pragma unroll
            for (int m = 0; m < 5; ++m)
#pragma unroll
                for (int ns = 0; ns < 4; ++ns) acc[m][ns] = (f32x4){0.f, 0.f, 0.f, 0.f};
            int boffr[4];
#pragma unroll
            for (int ns = 0; ns < 4; ++ns) boffr[ns] = BOFF + (fq * 128 + moe_phys(64 * wc2 + 16 * ns + fr)) * 16;
            const int arow0 = 80 * wr4 + fr;
            const bool ga = (80 * wr4) < rows, gb = (80 * wr4 + 48) < rows;
#define M8_LDA(dst_, h_, n_, sb_, ks_) do { _Pragma("unroll") for (int q_ = 0; q_ < (n_); ++q_) { const int r_ = arow0 + 16 * ((h_) * 3 + q_); \
                dst_[q_] = *(const LAS v4i_t*)((sb_) + r_ * 128 + (((4 * (ks_) + fq) ^ ((r_ >> 1) & 7)) * 16)); } } while (0)
#define M8_LDB(dst_, sb_, ks_) do { _Pragma("unroll") for (int ns_ = 0; ns_ < 4; ++ns_) dst_[ns_] = *(const LAS v4i_t*)((sb_) + boffr[ns_] + (ks_) * (4 * 128 * 16)); } while (0)
#define M8_MM(bl_, bh_, al_, ah_, h_, n_) do { _Pragma("unroll") for (int q_ = 0; q_ < (n_); ++q_) _Pragma("unroll") for (int ns_ = 0; ns_ < 4; ++ns_) \
                acc[(h_) * 3 + q_][ns_] = __builtin_amdgcn_mfma_scale_f32_16x16x128_f8f6f4(__builtin_shufflevector(bl_[ns_], bh_[ns_], 0, 1, 2, 3, 4, 5, 6, 7), \
                    __builtin_shufflevector(al_[q_], ah_[q_], 0, 1, 2, 3, 4, 5, 6, 7), acc[(h_) * 3 + q_][ns_], 0, 0, 0, 0, 0, 0); } while (0)
#define M8_COMPUTE(st_) do { LAS unsigned char* sb_ = L + (st_) * STG; if (ga) { v4i_t b0_[4], b1_[4], a0_[3], a1_[3], c0_[2], c1_[2]; \
            M8_LDB(b0_, sb_, 0); M8_LDB(b1_, sb_, 1); M8_LDA(a0_, 0, 3, sb_, 0); M8_LDA(a1_, 0, 3, sb_, 1); __builtin_amdgcn_sched_barrier(0); \
            M8_LDA(c0_, 1, 2, sb_, 0); M8_LDA(c1_, 1, 2, sb_, 1); M8_MM(b0_, b1_, a0_, a1_, 0, 3); __builtin_amdgcn_sched_barrier(0); \
            if (gb) M8_MM(b0_, b1_, c0_, c1_, 1, 2); } } while (0)
#define M8_STEP(s) do { asm volatile("s_waitcnt vmcnt(0)" ::: "memory"); __syncthreads(); \
            { const int tn_ = (tt + (s) + 1) < NT ? (tt + (s) + 1) : (NT - 1); M8_GLDS(arow, wbase, (s) ^ 1, tn_); } \
            M8_COMPUTE(s); } while (0)
            for (int tt = 0; tt < NT; tt += 2) { M8_STEP(0); M8_STEP(1); }
            asm volatile("s_waitcnt vmcnt(0)" ::: "memory");
#undef M8_STEP
#undef M8_COMPUTE
#undef M8_MM
#undef M8_LDB
#undef M8_LDA
            if (hn) { __builtin_amdgcn_sched_barrier(0); M8_GLDS(arown, wbasen, 0, 0); __builtin_amdgcn_sched_barrier(0); }
            int te = threadIdx.x; asm volatile("" : "+v"(te));
            const int fr_e = te & 15, fq_e = (te >> 4) & 3, wr4_e = (te >> 7) & 3, wc2_e = (te >> 6) & 1;
#pragma unroll
            for (int m = 0; m < 5; ++m) {
                const int row = 80 * wr4_e + 16 * m + fr_e;
                if (row < rows) {
                    const int gpos = ps + m0 + row;
                    if (GU) {
                        u32x2 o8;
#pragma unroll
                        for (int ns = 0; ns < 2; ++ns) { const f32x4 g = acc[m][ns] * 0.015625f, up = acc[m][ns + 2] * 0.0625f;
                            o8[ns] = pk_fp8x4(g[0] * sigmoidf_(g[0]) * up[0], g[1] * sigmoidf_(g[1]) * up[1], g[2] * sigmoidf_(g[2]) * up[2], g[3] * sigmoidf_(g[3]) * up[3]); }
                        *(u32x2*)(HBUF + (size_t)gpos * 1024 + 64 * nti + 32 * wc2_e + 8 * fq_e) = o8;
                    } else {
                        const int a = ROWMAP[gpos]; const float wt = ROWW[gpos] * 0.00390625f;
#pragma unroll
                        for (int nh = 0; nh < 2; ++nh) { const f32x4 v0 = acc[m][2 * nh], v1 = acc[m][2 * nh + 1];
                            u32x4 o; o[0] = pk_bf16(v0[0] * wt, v0[1] * wt); o[1] = pk_bf16(v0[2] * wt, v0[3] * wt); o[2] = pk_bf16(v1[0] * wt, v1[1] * wt); o[3] = pk_bf16(v1[2] * wt, v1[3] * wt);
                            *(u32x4*)(YBUF + (size_t)a * 2048 + 128 * nti + 64 * wc2_e + 32 * nh + 8 * fq_e) = o; }
                    }
                }
            }
        }
        hc = hn; e = en; nti = ntin; ps = psn; m0 = m0n; rows = rowsn; wbase = wbasen;
#pragma unroll
        for (int i = 0; i < 5; ++i) arow[i] = arown[i];
    }
#undef M8_GLDS
#undef M8_WBASE
#undef M8_AROW
#undef M8_GET
    __syncthreads();
}

__device__ __forceinline__ void p11_final(const Frame& F) {
    const float* X1 = DBG_ONLY_X ? F.in[0] : WSP(float, WS_X1); const float* mod = WSP(float, WS_MOD); const bf16_t* Y = WSP(bf16_t, WS_YBUF); const float* fg = F.in[22];
    for (int row = F.bid * 8 + F.wave; row < T; row += F.nb * 8) {
        const float* g2 = mod + (size_t)(row / SEQ) * 12288 + 5 * 2048;
        f32x4 v[8]; float ss = 0.f;
#pragma unroll
        for (int i = 0; i < 8; ++i) { const int col = (i * 64 + F.lane) * 4;
            const f32x4 xv = *(const f32x4*)(X1 + (size_t)row * D + col), gv = *(const f32x4*)(g2 + col);
#if DBG_NO_MOE
            const u32x2 y0 = (u32x2){0u, 0u}, y1 = y0; (void)Y;
#else
            const u32x2 y0 = *(const u32x2*)(Y + (size_t)(2 * row) * D + col), y1 = *(const u32x2*)(Y + (size_t)(2 * row + 1) * D + col);
#endif
            v[i] = (f32x4){xv[0] + gv[0] * (bf_lo(y0[0]) + bf_lo(y1[0])), xv[1] + gv[1] * (bf_hi(y0[0]) + bf_hi(y1[0])), xv[2] + gv[2] * (bf_lo(y0[1]) + bf_lo(y1[1])), xv[3] + gv[3] * (bf_hi(y0[1]) + bf_hi(y1[1]))};
            ss += v[i][0] * v[i][0] + v[i][1] * v[i][1] + v[i][2] * v[i][2] + v[i][3] * v[i][3]; }
        ss = wave_sum(ss);
        const float rs = rsqrtf(ss * (1.f / D) + EPS);
#pragma unroll
        for (int i = 0; i < 8; ++i) { const int col = (i * 64 + F.lane) * 4; const f32x4 g = *(const f32x4*)(fg + col);
            *(f32x4*)(F.out + (size_t)row * D + col) = (f32x4){v[i][0] * rs * g[0], v[i][1] * rs * g[1], v[i][2] * rs * g[2], v[i][3] * rs * g[3]}; }
    }
}

constexpr int N_PHASES = 12;
__global__ __launch_bounds__(512, 2) void mk_fwd(Args a) {
    extern __shared__ __attribute__((aligned(16))) unsigned char lds_raw[];
    Frame F;
    F.in = a.in; F.out = a.out; F.ws = a.ws; F.lds = (LAS unsigned char*)lds_raw;
    F.tid = threadIdx.x; F.lane = F.tid & 63; F.wave = __builtin_amdgcn_readfirstlane(F.tid >> 6); F.bid = blockIdx.x; F.nb = gridDim.x;
    const int lo = a.ph_lo, hi = a.ph_hi;
    XcdBarrier bar; bar.bar = (unsigned*)(a.ws + WS_CTL); bar.x = 0; bar.st = nullptr;
    if (hi - lo > 1) {
        if (F.tid == 0) *(LAS u32x4*)(F.lds + LDS_BAR_OFF) = (u32x4){0u, 0u, 0u, 0u};
        __syncthreads();
        bar = xcd_barrier_post((unsigned*)(a.ws + WS_CTL), (volatile LAS unsigned*)(F.lds + LDS_BAR_OFF));
    }
#define IN(k) (lo <= (k) && (k) < hi)
#define SEAM(k) do { if (IN(k) && IN((k) + 1)) xcd_barrier(bar); { int tz_ = threadIdx.x; asm volatile("" : "+v"(tz_)); F.tid = tz_; F.lane = tz_ & 63; } } while (0)
    pg8::WStream W{F.in[19], F.in[20], F.in[21], WSP(unsigned char, WS_W8GU), WSP(unsigned char, WS_W8D), 0, 0, 0};
    { const int per = (pg8::WS_STEPS + F.nb - 1) / F.nb; W.gs0 = F.bid * per; W.n = per; if (W.gs0 + W.n > pg8::WS_STEPS) W.n = pg8::WS_STEPS - W.gs0; if (W.n < 0) W.n = 0; if (!MK_WSTREAM) W.n = 0; W.n0 = W.n; }
#define WS_ADV(d_) do { int d__ = (d_); if (d__ > W.n) d__ = W.n; W.gs0 += d__; W.n -= d__; } while (0)
#define WS_CATCHUP(rem_) do { while (W.n > (rem_)) { f32x4 r_[4]; pg8::ws_issue(W, 0, r_); pg8::ws_flush(W, 0, r_); WS_ADV(1); } } while (0)
    if (IN(0)) { p0_mod_partials(F); p0_tables(F); p0_convert(F); if (DBG_DBL == 0) { p0_mod_partials(F); p0_tables(F); p0_convert(F); } }
    SEAM(0);
    if (IN(1)) { p1_norm1(F); if (DBG_DBL == 1) p1_norm1(F); }
    SEAM(1);
    if (IN(2)) {
        pg8::Gemm g{WSP(bf16_t, WS_ABF), WSP(bf16_t, WS_BTIN), MK_FP8_INPROJ ? 1024 : 2048};
        InProjOrder S; S.init(F.nb, F.bid);
        EpiInProj E{WSP(bf16_t, WS_QM), WSP(bf16_t, WS_OMS), WSP(bf16_t, WS_QA), WSP(bf16_t, WS_GBRS), WSP(bf16_t, WS_KM), WSP(bf16_t, WS_VM), WSP(bf16_t, WS_KA), WSP(bf16_t, WS_VAT), WSP(float, WS_GM), WSP(float, WS_ROPE), MK_FP8_INPROJ ? 0.015625f : 1.f};
#if MK_FP8_GATES && !MK_FP8_INPROJ
        { MaskOrder S2; S2.init(~MK_F8MASK & ((1ull << 53) - 1), ~MK_F8CTX & ((1ull << 53) - 1), F.nb, F.bid); const int d_ = pg8::gemm_phase<EpiInProj, MaskOrder, false, MK_WSTREAM != 0>(F.lds, g, S2, E, W); WS_ADV(d_); }
        { pg8::Gemm g8{WSP(bf16_t, WS_ABF8), WSP(bf16_t, WS_BTIN8), 1024}; MaskOrder S8; S8.init(MK_F8MASK, MK_F8CTX, F.nb, F.bid); EpiInProj E8 = E; E8.fs = 0.015625f;
          const int d_ = pg8::gemm_phase<EpiInProj, MaskOrder, true, MK_WSTREAM != 0>(F.lds, g8, S8, E8, W); WS_ADV(d_); }
        WS_CATCHUP(W.n0 / 4);
#else
        pg8::gemm_phase<EpiInProj, InProjOrder, MK_FP8_INPROJ != 0>(F.lds, g, S, E);
#endif
        if (DBG_DBL == 2) pg8::gemm_phase<EpiInProj, InProjOrder, MK_FP8_INPROJ != 0>(F.lds, g, S, E);
    }
    SEAM(2);
    if (IN(3)) { p3_mlstm(F); if (DBG_DBL == 30) p3_mlstm(F); p3_attn(F); if (DBG_DBL == 31) p3_attn(F); }
    SEAM(3);
    if (IN(4)) { p4_postmix(F); if (DBG_DBL == 4) p4_postmix(F); }
    SEAM(4);
    if (IN(5)) {
        pg8::StaticOrder S; S.init(T, 2048, F.nb, F.bid);
        { pg8::Gemm g{WSP(bf16_t, WS_AM), WSP(bf16_t, WS_BTBRM), MK_FP8_MIX ? 1024 : 2048}; EpiBr1 E{WSP(float, WS_TMP), WSP(bf16_t, WS_GBRS)}; const int d_ = pg8::gemm_phase<EpiBr1, pg8::StaticOrder, MK_FP8_MIX != 0, MK_WSTREAM != 0>(F.lds, g, S, E, W); WS_ADV(d_); }
        { pg8::Gemm g{WSP(bf16_t, WS_AO), WSP(bf16_t, WS_BTBRA), MK_FP8_MIX ? 1024 : 2048}; EpiBr2 E{WSP(float, WS_TMP), WSP(bf16_t, WS_GBRS), WSP(bf16_t, WS_AOUT)}; const int d_ = pg8::gemm_phase<EpiBr2, pg8::StaticOrder, MK_FP8_MIX != 0, MK_WSTREAM != 0>(F.lds, g, S, E, W); WS_ADV(d_); }
        if (DBG_DBL == 5) { { pg8::Gemm g{WSP(bf16_t, WS_AM), WSP(bf16_t, WS_BTBRM), MK_FP8_MIX ? 1024 : 2048}; EpiBr1 E{WSP(float, WS_TMP), WSP(bf16_t, WS_GBRS)}; pg8::gemm_phase<EpiBr1, pg8::StaticOrder, MK_FP8_MIX != 0>(F.lds, g, S, E); }
            { pg8::Gemm g{WSP(bf16_t, WS_AO), WSP(bf16_t, WS_BTBRA), MK_FP8_MIX ? 1024 : 2048}; EpiBr2 E{WSP(float, WS_TMP), WSP(bf16_t, WS_GBRS), WSP(bf16_t, WS_AOUT)}; pg8::gemm_phase<EpiBr2, pg8::StaticOrder, MK_FP8_MIX != 0>(F.lds, g, S, E); } }
    }
    SEAM(5);
    if (IN(6)) {
        pg8::StaticOrder S; S.init(T, 2048, F.nb, F.bid);
        pg8::Gemm g{WSP(bf16_t, WS_AOUT), WSP(bf16_t, WS_BTOUT), MK_FP8_MIX ? 1024 : 2048}; EpiOut E{F.in[0], WSP(float, WS_MOD), WSP(float, WS_X1), WSP(float, WS_RSS)}; { const int d_ = pg8::gemm_phase<EpiOut, pg8::StaticOrder, MK_FP8_MIX != 0, MK_WSTREAM != 0>(F.lds, g, S, E, W); WS_ADV(d_); }
        WS_CATCHUP(0);
        if (DBG_DBL == 6) pg8::gemm_phase<EpiOut, pg8::StaticOrder, MK_FP8_MIX != 0>(F.lds, g, S, E);
    }
    SEAM(6);
    if (IN(7)) { p7_norm2_router(F); if (DBG_DBL == 7) { for (int rep_ = 0; rep_ < 4; ++rep_) p7_norm2_router<true>(F); } }
    SEAM(7);
    if (IN(8)) { p8_lists(F); }
    SEAM(8);
    if (IN(9)) { if (MK_FP8_MOE && MK_WSTREAM) moe_gemm8w<true>(F); else if (MK_FP8_MOE) moe_gemm8<true>(F); else moe_gemm<true>(F); if (DBG_DBL == 9) moe_gemm<true>(F); if (DBG_DBL >= 92 && DBG_DBL <= 96) moe_gemm<true, DBG_DBL - 90>(F); }
    SEAM(9);
    if (IN(10)) { if (MK_FP8_MOE && MK_WSTREAM) moe_gemm8w<false>(F); else if (MK_FP8_MOE) moe_gemm8<false>(F); else moe_gemm<false>(F); if (DBG_DBL == 10) moe_gemm<false>(F); }
    SEAM(10);
    if (IN(11)) { p11_final(F); if (DBG_DBL == 11) p11_final(F); }
#undef IN
#undef SEAM
#undef WS_ADV
#undef WS_CATCHUP
}

extern "C" void kernel_launch(void* const* d_in, const int* in_sizes, int n_in, void* d_out, int out_size, void* d_ws, size_t ws_size, hipStream_t stream) {
    static int grid = 0;
    if (grid == 0) {
        if (n_in != 23 || out_size != T * D || ws_size < WS_END) { fprintf(stderr, "kernel_launch: unexpected problem (n_in %d, out %d, ws %zu < %zu)\n", n_in, out_size, ws_size, (size_t)WS_END); grid = -1; return; }
        int dev = 0, cus = 0, per_cu = 0;
        if (hipGetDevice(&dev) != hipSuccess || hipDeviceGetAttribute(&cus, hipDeviceAttributeMultiprocessorCount, dev) != hipSuccess) { grid = -1; return; }
        if (hipFuncSetAttribute((const void*)mk_fwd, hipFuncAttributeMaxDynamicSharedMemorySize, LDS_BYTES) != hipSuccess) { fprintf(stderr, "kernel_launch: hipFuncSetAttribute failed\n"); grid = -1; return; }
        if (hipOccupancyMaxActiveBlocksPerMultiprocessor(&per_cu, (const void*)mk_fwd, NT, LDS_BYTES) != hipSuccess || per_cu < 1) fprintf(stderr, "kernel_launch: occupancy query reports %d\n", per_cu);
        (void)hipGetLastError();
        grid = cus;
    }
    if (grid < 0) return;
    (void)hipMemsetAsync((char*)d_ws + WS_CTL, 0, CTL_BYTES, stream);
    Args a{};
    for (int i = 0; i < 23; ++i) a.in[i] = (const float*)d_in[i];
    a.out = (float*)d_out; a.ws = (unsigned char*)d_ws;
#if MK_ONE_LAUNCH
    a.ph_lo = 0; a.ph_hi = N_PHASES;
    hipLaunchKernelGGL(mk_fwd, dim3(grid), dim3(NT), LDS_BYTES, stream, a);
#else
    for (int p = 0; p < N_PHASES; ++p) { if (DBG_NO_MOE && p >= 7 && p <= 10) continue; if (DBG_ONLY_X && p != 1 && p != 0 && p != 11) continue; a.ph_lo = p; a.ph_hi = p + 1; hipLaunchKernelGGL(mk_fwd, dim3(grid), dim3(NT), LDS_BYTES, stream, a); }
#endif
}
```

```cpp
#include <hip/hip_runtime.h>
#include <stdint.h>
#include <stdio.h>

#define DBG_NO_MOE 0
#ifndef DBG_DBL
#define DBG_DBL -1
#endif
#define DBG_NO_ATTN 0
#define DBG_NO_STATE 0
#define DBG_ONLY_X 0
#ifndef MK_FP8_INPROJ
#define MK_FP8_INPROJ 0
#endif
#ifndef MK_FP8_MIX
#define MK_FP8_MIX 1
#endif
#ifndef MK_FP8_MOE
#define MK_FP8_MOE 1
#ifndef MK_WSTREAM
#define MK_WSTREAM 1
#endif
#ifndef MK_FP8_GATES
#define MK_FP8_GATES 1
#endif
#ifndef MK_F8MASK
#define MK_F8MASK 0x0000FF0FFFFFFFF0ull
#endif
#define MK_F8CTX 0ull
#endif
#ifndef MK_ONE_LAUNCH
#define MK_ONE_LAUNCH 1
#endif

#define LAS __attribute__((address_space(3)))
typedef unsigned short bf16_t;
typedef short bf16x8 __attribute__((ext_vector_type(8)));
typedef short bf16x4 __attribute__((ext_vector_type(4)));
typedef float f32x4 __attribute__((ext_vector_type(4)));
typedef unsigned u32x4 __attribute__((ext_vector_type(4)));
typedef unsigned u32x2 __attribute__((ext_vector_type(2)));

constexpr int D = 2048, NB = 4, SEQ = 2048, CTXL = 256, T = NB * SEQ, TC = NB * CTXL, TR = T + TC;
constexpr int MH = 8, MDQK = 128, MDV = 256;
constexpr int AH = 16, AKV = 4, ADH = 128;
constexpr int NEXP = 64, DEXP = 1024;
constexpr int INW = 13344, INWP = 13568;
constexpr float EPS = 1e-6f;
constexpr int NT = 512;

constexpr size_t al256(size_t x) { return (x + 255) & ~(size_t)255; }
constexpr size_t CTL_BYTES = 65536;
constexpr size_t WS_CTL = 0;
constexpr size_t CTL_CNT = 16384;
constexpr size_t WS_MODP = WS_CTL + CTL_BYTES;
constexpr size_t WS_MOD = WS_MODP + al256((size_t)32 * 5 * 12288 * 4);
constexpr size_t WS_ROPE = WS_MOD + al256((size_t)5 * 12288 * 4);
constexpr size_t WS_WRT = WS_ROPE + al256((size_t)2048 * 2 * 32 * 2 * 4);
constexpr int WRLD = 2048 + 64;
constexpr size_t WS_WRL = WS_WRT + (size_t)80 * WRLD * 2;
constexpr size_t WS_BTIN = WS_WRT + al256((size_t)2 * 80 * WRLD * 2);
constexpr size_t WS_BTBRM = WS_BTIN + al256((size_t)INWP * 2048 * 2);
constexpr size_t WS_BTBRA = WS_BTBRM + al256((size_t)2048 * 2048 * 2);
constexpr size_t WS_BTOUT = WS_BTBRA + al256((size_t)2048 * 2048 * 2);
constexpr size_t WS_BTGU = WS_BTOUT + al256((size_t)2048 * 2048 * 2);
constexpr size_t WS_ABF8 = WS_BTGU;
constexpr size_t WS_BTIN8 = WS_BTGU + al256((size_t)TR * 2048);
constexpr size_t WS_W8GU = WS_BTGU + ((size_t)64 << 20);
constexpr size_t WS_BTD = WS_BTGU + al256((size_t)NEXP * 2048 * 2048 * 2);
constexpr size_t WS_W8D = WS_BTD;
constexpr size_t WS_ABF = WS_BTD + al256((size_t)NEXP * 2048 * 1024 * 2);
constexpr size_t WS_QM = WS_ABF + al256((size_t)TR * 2048 * 2);
constexpr size_t WS_OMS = WS_QM + al256((size_t)T * 1024 * 2);
constexpr size_t WS_QA = WS_OMS + al256((size_t)T * 2048 * 2);
constexpr size_t WS_GBRS = WS_QA + al256((size_t)T * 2048 * 2);
constexpr size_t WS_KM = WS_GBRS + al256((size_t)T * 4096 * 2);
constexpr size_t WS_VM = WS_KM + al256((size_t)TR * 1024 * 2);
constexpr size_t WS_KA = WS_VM + al256((size_t)TR * 2048 * 2);
constexpr size_t WS_VAT = WS_KA + al256((size_t)TR * 512 * 2);
constexpr size_t WS_GM = WS_VAT + al256((size_t)512 * TR * 2);
constexpr size_t WS_HFB = WS_GM + al256((size_t)TR * 32 * 4);
constexpr size_t WS_AO = WS_HFB + al256((size_t)2 * T * 2048 * 2);
constexpr size_t WS_AM = WS_AO + al256((size_t)T * 2048 * 2);
constexpr size_t WS_TMP = WS_AM + al256((size_t)T * 2048 * 2);
constexpr size_t WS_AOUT = WS_TMP + al256((size_t)T * 2048 * 4);
constexpr size_t WS_X1 = WS_AOUT + al256((size_t)T * 2048 * 2);
constexpr size_t WS_H2 = WS_X1 + al256((size_t)T * 2048 * 4);
constexpr size_t WS_EID = WS_H2 + al256((size_t)T * 2048 * 2);
constexpr size_t WS_WTOP = WS_EID + al256((size_t)T * 2 * 4);
constexpr size_t WS_POS = WS_WTOP + al256((size_t)T * 2 * 4);
constexpr int XGROWS = 32768;
constexpr size_t WS_ROWMAP = WS_POS + al256((size_t)T * 2 * 4);
constexpr size_t WS_ROWW = WS_ROWMAP + al256((size_t)XGROWS * 4);
constexpr size_t WS_PANEL = WS_ROWW + al256((size_t)XGROWS * 4);
constexpr size_t WS_ROWTOK = WS_PANEL + al256(1024);
constexpr size_t WS_XG = WS_ROWTOK + al256((size_t)XGROWS * 4);
constexpr size_t WS_RSS = WS_XG + ((size_t)100 << 20);
constexpr size_t WS_HBUF = WS_XG + al256((size_t)XGROWS * 2048 * 2);
constexpr size_t WS_YBUF = WS_HBUF + al256((size_t)XGROWS * 1024 * 2);
constexpr size_t WS_END = WS_YBUF + al256((size_t)2 * T * 2048 * 2);

constexpr int LDS_STAGE = 131072;
constexpr int LDS_BAR_OFF = LDS_STAGE;
constexpr int LDS_TAB_OFF = LDS_STAGE + 64;
constexpr int LDS_PRE_OFF = LDS_STAGE + 4096;
constexpr int LDS_BYTES = LDS_PRE_OFF + 27648;

typedef float f32x2 __attribute__((ext_vector_type(2)));
typedef __bf16 bf16x2_t __attribute__((ext_vector_type(2)));
__device__ __forceinline__ unsigned pk_bf16(float lo, float hi) { const bf16x2_t v = __builtin_convertvector((f32x2){lo, hi}, bf16x2_t); return __builtin_bit_cast(unsigned, v); }
__device__ __forceinline__ unsigned pk_fp8x4(float a, float b, float c, float d) { int p = __builtin_amdgcn_cvt_pk_fp8_f32(a, b, 0, false); p = __builtin_amdgcn_cvt_pk_fp8_f32(c, d, p, true); return (unsigned)p; }
__device__ __forceinline__ float bf_lo(unsigned u) { return __uint_as_float(u << 16); }
__device__ __forceinline__ float bf_hi(unsigned u) { return __uint_as_float(u & 0xffff0000u); }
__device__ __forceinline__ float bf1(unsigned short h) { return __uint_as_float(((unsigned)h) << 16); }
__device__ __forceinline__ float sigmoidf_(float x) { return __builtin_amdgcn_rcpf(1.f + __expf(-x)); }
__device__ __forceinline__ float wave_sum(float v) {
#pragma unroll
    for (int d = 32; d >= 1; d >>= 1) v += __shfl_xor(v, d);
    return v;
}

#define XB_TMO      128
#define XB_XCNT(j)  (256  + 64 * (j))
#define XB_XSUB(j)  (1280 + 64 * (j))
#define XB_XGEN(j)  (2304 + 64 * (j))
#define XB_TOP      3328
#define XB_TOPGEN   3392
#define XCD_BAR_WORDS 3456
#define XB_SPIN_CAP (1u << 18)

__device__ __forceinline__ unsigned xb_ld(unsigned* p)              { return __hip_atomic_load(p, __ATOMIC_RELAXED, __HIP_MEMORY_SCOPE_AGENT); }
__device__ __forceinline__ unsigned xb_add(unsigned* p, unsigned v) { return __hip_atomic_fetch_add(p, v, __ATOMIC_RELAXED, __HIP_MEMORY_SCOPE_AGENT); }
__device__ __forceinline__ unsigned xb_xcc_id() { return (unsigned)__builtin_amdgcn_s_getreg((3 << 11) | 20) & 0xFu; }
#define XB_SPIN(cond, bar) do { unsigned _sp = 0; while (cond) { __builtin_amdgcn_s_sleep(1); \
    if ((++_sp & 255u) == 0u) { if (xb_ld(&(bar)[XB_TMO])) break; if (_sp > XB_SPIN_CAP) { atomicAdd(&(bar)[XB_TMO], 1u); break; } } } } while (0)

struct XcdBarrier { unsigned* bar; unsigned x; volatile LAS unsigned* st; };

__device__ __forceinline__ XcdBarrier xcd_barrier_post(unsigned* bar, volatile LAS unsigned* st) {
    XcdBarrier b; b.bar = bar; b.x = xb_xcc_id(); b.st = st;
    if (threadIdx.x == 0) (void)xb_add(&bar[XB_XCNT(b.x)], 1u);
    return b;
}
__device__ __forceinline__ void xcd_barrier_complete(unsigned* bar, unsigned x, unsigned& nloc, unsigned& nx) {
    const unsigned G = gridDim.x * gridDim.y * gridDim.z;
    unsigned sum, cnt, mine, sp = 0u;
    for (;;) {
        sum = 0u; cnt = 0u; mine = 0u;
#pragma unroll
        for (unsigned j = 0; j < 16; ++j) { const unsigned c = xb_ld(&bar[XB_XCNT(j)]); sum += c; cnt += (c > 0u) ? 1u : 0u; mine = (j == x) ? c : mine; }
        if (sum == G) break;
        __builtin_amdgcn_s_sleep(1);
        if ((++sp & 255u) == 0u) { if (xb_ld(&bar[XB_TMO])) break; if (sp > XB_SPIN_CAP) { atomicAdd(&bar[XB_TMO], 1u); break; } }
    }
    nloc = mine > 0u ? mine : 1u; nx = cnt > 0u ? cnt : 1u;
}
__device__ __forceinline__ void xcd_barrier(const XcdBarrier& b) {
    asm volatile("s_waitcnt vmcnt(0)" ::: "memory");
    __syncthreads();
    if (threadIdx.x == 0) {
        unsigned* bar = b.bar;
        __builtin_amdgcn_s_waitcnt(0);
        unsigned nloc = b.st[0], nx = b.st[1];
        if (nloc == 0u) { xcd_barrier_complete(bar, b.x, nloc, nx); b.st[0] = nloc; b.st[1] = nx; }
        const unsigned old = xb_add(&bar[XB_XSUB(b.x)], 1u);
        const unsigned gen = old / nloc;
        if (old + 1u == (gen + 1u) * nloc) {
            __builtin_amdgcn_fence(__ATOMIC_RELEASE, "agent");
            asm volatile("s_waitcnt vmcnt(0)" ::: "memory");
            const unsigned og = xb_add(&bar[XB_TOP], 1u);
            const unsigned tg = og / nx;
            if (og + 1u == (tg + 1u) * nx) xb_add(&bar[XB_TOPGEN], 1u);
            else XB_SPIN(xb_ld(&bar[XB_TOPGEN]) == tg, bar);
            __builtin_amdgcn_fence(__ATOMIC_ACQUIRE, "agent");
            xb_add(&bar[XB_XGEN(b.x)], 1u);
            asm volatile("s_waitcnt vmcnt(0)" ::: "memory");
        } else {
            XB_SPIN(xb_ld(&bar[XB_XGEN(b.x)]) == gen, bar);
            __builtin_amdgcn_fence(__ATOMIC_ACQUIRE, "agent");
            asm volatile("s_waitcnt vmcnt(0)" ::: "memory");
        }
    }
    __syncthreads();
}

namespace pg8 {
constexpr int BM = 256, BK = 64, HALF = 128, HTB = HALF * BK * 2, STAGE_BYTES = 8 * HTB, NXCD = 8, WGM = 8;
__device__ __forceinline__ int lds_byte(int r, int c) { const int st = (r >> 4) * 2 + (c >> 5), rr = r & 15, cc = c & 31, ob = rr * 64 + cc * 2; return st * 1024 + (ob ^ (((ob >> 9) & 1) << 5)); }
__device__ __forceinline__ void stage_rc(int b, int& R, int& C) { const int st = b / 1024, sb = b % 1024, swz = sb ^ (((sb >> 9) & 1) << 5); R = (st >> 1) * 16 + swz / 64; C = (st & 1) * 32 + (swz % 64) / 2; }
struct Unit { int pm, pn; };
struct Gemm { const bf16_t* A; const bf16_t* Bt; int K; };

typedef int v8i_t __attribute__((ext_vector_type(8)));
typedef int v4i_t __attribute__((ext_vector_type(4)));

constexpr int WS_STEPS = 3 * 16384;
struct WStream { const float* src0; const float* src1; const float* src2; unsigned char* dgu; unsigned char* dd; int gs0, n, n0; };
__device__ __forceinline__ int ws_gs(const WStream& W, int s) { int g = W.gs0 + (s < W.n ? s : W.n - 1); g = g < WS_STEPS ? g : WS_STEPS - 1; return g > 0 ? g : 0; }
__device__ __forceinline__ void ws_issue(const WStream& W, int s, f32x4 (&r)[4]) {
    int tz = threadIdx.x; asm volatile("" : "+v"(tz));
    const int gs = ws_gs(W, s), mat = gs >> 14, q = gs & 16383, e = q >> 8;
    const int sh = (mat == 2) ? 13 : 12;
    const int rg = (mat == 2) ? ((q >> 2) & 63) : ((q >> 1) & 127), part = (mat == 2) ? (q & 3) : (q & 1);
    const float* base = mat == 0 ? W.src0 : (mat == 1 ? W.src1 : W.src2);
    const char* ub = (const char*)base + (size_t)e * 8388608 + ((size_t)(rg * 16) << sh) + (size_t)(part * 2048);
    const unsigned voff = ((unsigned)((tz >> 4) & 3) << (sh + 2)) + (unsigned)(tz >> 6) * 256u + (unsigned)(tz & 15) * 16u;
#pragma unroll
    for (int i = 0; i < 4; ++i) r[i] = *(const f32x4*)(ub + voff + ((size_t)i << sh));
}
__device__ __forceinline__ void ws_flush(const WStream& W, int s, const f32x4 (&r)[4]) {
    int tz = threadIdx.x; asm volatile("" : "+v"(tz));
    const int gs = ws_gs(W, s), mat = gs >> 14, q = gs & 16383, e = q >> 8;
    const int rg = (mat == 2) ? ((q >> 2) & 63) : ((q >> 1) & 127), part = (mat == 2) ? (q & 3) : (q & 1);
    unsigned d[4];
#pragma unroll
    for (int j = 0; j < 4; ++j) d[j] = pk_fp8x4(r[0][j] * 64.f, r[1][j] * 64.f, r[2][j] * 64.f, r[3][j] * 64.f);
    const auto a = __builtin_amdgcn_permlane32_swap(d[0], d[2], false, false); const auto b = __builtin_amdgcn_permlane32_swap(d[1], d[3], false, false);
    const auto c = __builtin_amdgcn_permlane16_swap(a[0], b[0], false, false); const auto f = __builtin_amdgcn_permlane16_swap(a[1], b[1], false, false);
    const u32x4 o = (u32x4){c[0], c[1], f[0], f[1]};
    const int w = tz >> 6, g = 4 * (tz & 15) + ((tz >> 4) & 3);
    unsigned char* ub; int slot;
    const int gp = (g & 32) + 16 * ((g >> 2) & 1) + 4 * ((g & 31) >> 3) + (g & 3);
    if (mat == 2) { ub = W.dd + (size_t)e * 2097152 + (size_t)((part * 4) * 131072 + rg * 2048); slot = (w & 1) * 64 + gp; ub += (size_t)(w >> 1) * 131072; }
    else          { ub = W.dgu + (size_t)e * 4194304 + (size_t)((part * 8) * 262144 + rg * 2048); slot = 64 * (gp >> 5) + (gp & 31) + 32 * mat; ub += (size_t)w * 262144; }
    *(u32x4*)(ub + (unsigned)((slot ^ ((slot >> 3) & 3)) * 16)) = o;
}
template <class Epi, class Sched, bool FP8 = false, bool STRM = false>
__device__ __forceinline__ int gemm_phase(LAS unsigned char* lds, const Gemm g, const Sched& S, const Epi& E, const WStream W = WStream{}) {
    const int tid = threadIdx.x, wid = __builtin_amdgcn_readfirstlane(tid >> 6), lane = tid & 63, wr = wid >> 2, wc = wid & 3, fr = lane & 15, fq = lane >> 4;
    const int K = g.K, nt = K / BK;
    unsigned voffA[2];
#pragma unroll
    for (int i = 0; i < 2; ++i) { int R, C; stage_rc(tid * 16 + i * 8192, R, C); voffA[i] = (unsigned)(R * K + C) * 2u; }
    const size_t kstep = (size_t)(BK * 2);
    const size_t hstep = (size_t)HALF * K * 2;
    const size_t tstep = 2 * hstep;
    const unsigned ldsw = (unsigned)wid * 1024u;
    const int aoff = lds_byte(wr * 64 + fr, fq * 8), boff = lds_byte(wc * 32 + fr, fq * 8);
    const __amdgpu_buffer_rsrc_t rsA = __builtin_amdgcn_make_buffer_rsrc((void*)g.A, 0, 0x7fffffff, 0x00020000), rsB = __builtin_amdgcn_make_buffer_rsrc((void*)g.Bt, 0, 0x7fffffff, 0x00020000);
#define PG8_SA(b, h) (((b) * 2 + (h)) * HTB)
#define PG8_SB(b, h) ((4 + (b) * 2 + (h)) * HTB)
#define PG8_STAGE_X(rs_, base_, bufoff, gbase, voff) do { const unsigned so_ = (unsigned)((const char*)(gbase) - (const char*)(base_)); _Pragma("unroll") for (int _i = 0; _i < 2; ++_i) \
        __builtin_amdgcn_raw_ptr_buffer_load_lds(rs_, (LAS void*)(lds + (bufoff) + ldsw + _i * 8192), 16, (int)(voff)[_i], (int)so_, 0, 0); } while (0)
#define PG8_STAGE(bufoff, gbase, voff) do { if ((bufoff) >= 4 * HTB) PG8_STAGE_X(rsB, g.Bt, bufoff, gbase, voff); else PG8_STAGE_X(rsA, g.A, bufoff, gbase, voff); } while (0)
#define PG8_LDA(dst, b, h) do { _Pragma("unroll") for (int m = 0; m < 4; ++m) _Pragma("unroll") for (int k = 0; k < 2; ++k) dst[m][k] = *(const LAS bf16x8*)(lds + PG8_SA(b, h) + aoff + m * 2048 + k * 1024); } while (0)
#define PG8_LDB(dst, b, h) do { _Pragma("unroll") for (int n = 0; n < 2; ++n) _Pragma("unroll") for (int k = 0; k < 2; ++k) dst[n][k] = *(const LAS bf16x8*)(lds + PG8_SB(b, h) + boff + n * 2048 + k * 1024); } while (0)
#define PG8_MMA(ai, bj, At, Bt) do { __builtin_amdgcn_s_setprio(1); _Pragma("unroll") for (int m = 0; m < 4; ++m) _Pragma("unroll") for (int n = 0; n < 2; ++n) { \
        if (FP8) { const v8i_t bb_ = __builtin_shufflevector(__builtin_bit_cast(v4i_t, Bt[n][0]), __builtin_bit_cast(v4i_t, Bt[n][1]), 0, 1, 2, 3, 4, 5, 6, 7); \
            const v8i_t aa_ = __builtin_shufflevector(__builtin_bit_cast(v4i_t, At[m][0]), __builtin_bit_cast(v4i_t, At[m][1]), 0, 1, 2, 3, 4, 5, 6, 7); \
            acc[ai][bj][m][n] = __builtin_amdgcn_mfma_scale_f32_16x16x128_f8f6f4(bb_, aa_, acc[ai][bj][m][n], 0, 0, 0, 0, 0, 0); } \
        else { _Pragma("unroll") for (int k = 0; k < 2; ++k) acc[ai][bj][m][n] = __builtin_amdgcn_mfma_f32_16x16x32_bf16(Bt[n][k], At[m][k], acc[ai][bj][m][n], 0, 0, 0); } } \
        __builtin_amdgcn_s_setprio(0); } while (0)
#define PG8_WAIT_V(n) asm volatile("s_waitcnt vmcnt(" #n ")" ::: "memory")
#define PG8_WAIT_L(n) asm volatile("s_waitcnt lgkmcnt(" #n ")" ::: "memory")
#define PG8_BAR __builtin_amdgcn_s_barrier()
#define PG8_SCHED __builtin_amdgcn_sched_barrier(0)
    Unit cur, nxt; int ui = 0;
    if (!S.next(0, cur)) return 0;
    f32x4 acc[2][2][4][2];
#pragma unroll
    for (int a = 0; a < 2; ++a)
#pragma unroll
        for (int b = 0; b < 2; ++b)
#pragma unroll
            for (int m = 0; m < 4; ++m)
#pragma unroll
                for (int n = 0; n < 2; ++n) acc[a][b][m][n] = (f32x4){0.f, 0.f, 0.f, 0.f};
    bf16x8 At[4][2], B0[2][2], B1[2][2];
    f32x4 wsA[4], wsB[4]; int sstep = 0;
    if (STRM) { ws_issue(W, 0, wsB); PG8_SCHED; }
    const char* cA = (const char*)g.A + (size_t)cur.pm * tstep; const char* cB = (const char*)g.Bt + (size_t)cur.pn * tstep;
    PG8_STAGE(PG8_SB(0, 0), cB, voffA); PG8_STAGE(PG8_SA(0, 0), cA, voffA); PG8_STAGE(PG8_SB(0, 1), cB + hstep, voffA); PG8_STAGE(PG8_SA(0, 1), cA + hstep, voffA);
    if (wr == 1) PG8_BAR;
    PG8_WAIT_V(4); PG8_BAR;
    PG8_STAGE(PG8_SB(1, 0), cB + kstep, voffA); PG8_STAGE(PG8_SA(1, 0), cA + kstep, voffA); PG8_STAGE(PG8_SB(1, 1), cB + hstep + kstep, voffA);
    PG8_WAIT_V(6); PG8_BAR;
    for (;;) {
        const bool has_next = S.next(ui + 1, nxt);
        const char* nA = has_next ? (const char*)g.A + (size_t)nxt.pm * tstep : cA; const char* nB = has_next ? (const char*)g.Bt + (size_t)nxt.pn * tstep : cB;
        for (int t = 0; t < nt; t += 2) {
            const bool last = (t == nt - 2);
            const char* a1 = cA + (size_t)(t + 1) * kstep;
            const char* a2 = last ? nA : cA + (size_t)(t + 2) * kstep; const char* b2 = last ? nB : cB + (size_t)(t + 2) * kstep;
            const char* a3 = a2 + kstep; const char* b3 = b2 + kstep;
            PG8_LDB(B0, 0, 0); PG8_SCHED; PG8_LDA(At, 0, 0); PG8_STAGE(PG8_SA(1, 1), a1 + hstep, voffA);
            if (STRM) { PG8_SCHED; ws_issue(W, sstep + 1, wsA); PG8_SCHED; }
            PG8_WAIT_L(8); PG8_BAR; PG8_WAIT_L(0); PG8_MMA(0, 0, At, B0); PG8_BAR; PG8_SCHED;
            PG8_LDB(B1, 0, 1); PG8_STAGE(PG8_SB(0, 0), b2, voffA);
            PG8_BAR; PG8_WAIT_L(0); PG8_MMA(0, 1, At, B1); PG8_BAR;
            PG8_LDA(At, 0, 1); PG8_STAGE(PG8_SA(0, 0), a2, voffA);
            PG8_BAR; PG8_WAIT_L(0); PG8_MMA(1, 0, At, B0); PG8_BAR; PG8_SCHED;
            PG8_STAGE(PG8_SB(0, 1), b2 + hstep, voffA);
            if (STRM) PG8_WAIT_V(10); else PG8_WAIT_V(6);
            PG8_BAR; PG8_MMA(1, 1, At, B1); if (STRM) { ws_flush(W, sstep, wsB); PG8_SCHED; } PG8_BAR;
            PG8_LDB(B0, 1, 0); PG8_SCHED; PG8_LDA(At, 1, 0); PG8_STAGE(PG8_SA(0, 1), a2 + hstep, voffA);
            if (STRM) { PG8_SCHED; ws_issue(W, sstep + 2, wsB); PG8_SCHED; }
            PG8_WAIT_L(8); PG8_BAR; PG8_WAIT_L(0); PG8_MMA(0, 0, At, B0); PG8_BAR; PG8_SCHED;
            PG8_LDB(B1, 1, 1); PG8_STAGE(PG8_SB(1, 0), b3, voffA);
            PG8_BAR; PG8_WAIT_L(0); PG8_MMA(0, 1, At, B1); PG8_BAR;
            PG8_LDA(At, 1, 1); PG8_STAGE(PG8_SA(1, 0), a3, voffA);
            PG8_BAR; PG8_WAIT_L(0); PG8_MMA(1, 0, At, B0); PG8_BAR; PG8_SCHED;
            PG8_STAGE(PG8_SB(1, 1), b3 + hstep, voffA);
            if (STRM) PG8_WAIT_V(10); else PG8_WAIT_V(6);
            PG8_BAR; PG8_MMA(1, 1, At, B1); if (STRM) { ws_flush(W, sstep + 1, wsA); PG8_SCHED; sstep += 2; } PG8_BAR;
        }
        { int tz = threadIdx.x; asm volatile("" : "+v"(tz));
          const int wid2 = __builtin_amdgcn_readfirstlane(tz >> 6), lane2 = tz & 63; E(acc, cur, wid2 >> 2, wid2 & 3, lane2 & 15, lane2 >> 4); }
        if (!has_next) break;
#pragma unroll
        for (int a = 0; a < 2; ++a)
#pragma unroll
            for (int b = 0; b < 2; ++b)
#pragma unroll
                for (int m = 0; m < 4; ++m)
#pragma unroll
                    for (int n = 0; n < 2; ++n) acc[a][b][m][n] = (f32x4){0.f, 0.f, 0.f, 0.f};
        cur = nxt; cA = nA; cB = nB; ++ui;
    }
    PG8_WAIT_V(0);
    if (wr == 0) PG8_BAR;
    PG8_BAR;
    if (STRM) { ws_flush(W, sstep, wsB); ++sstep; }
#undef PG8_SA
#undef PG8_SB
#undef PG8_STAGE
#undef PG8_LDA
#undef PG8_LDB
#undef PG8_MMA
#undef PG8_WAIT_V
#undef PG8_WAIT_L
#undef PG8_BAR
#undef PG8_SCHED
    return sstep;
}

struct StaticOrder {
    int nM, nN, nwg, G, c;
    __device__ void init(int M, int N, int G_, int c_) { nM = M / BM; nN = N / BM; nwg = nM * nN; G = G_; c = c_; }
    __device__ bool map(long L, Unit& u) const {
        if (L >= nwg) return false;
        int wgid = (int)L; { const int q = nwg / NXCD, r = nwg % NXCD, xcd = wgid % NXCD, off = wgid / NXCD; wgid = (xcd < r ? xcd * (q + 1) : r * (q + 1) + (xcd - r) * q) + off; }
        const int nig = WGM * nN, gid = wgid / nig, fm = gid * WGM, gsz = (nM - fm) < WGM ? (nM - fm) : WGM;
        u.pm = fm + ((wgid % nig) % gsz); u.pn = (wgid % nig) / gsz; return true;
    }
    __device__ bool next(int i, Unit& u) const { return map((long)i * G + c, u); }
};
}
using pg8::Unit; using pg8::v4i_t; using pg8::v8i_t;

struct Args {
    const float* in[23];
    float* out;
    unsigned char* ws;
    int ph_lo, ph_hi;
};
struct Frame {
    const float* const* in;
    float* out; unsigned char* ws;
    LAS unsigned char* lds;
    int tid, lane, wave, bid, nb;
};
#define WSP(T_, off) ((T_*)(F.ws + (off)))

__device__ __forceinline__ void p0_mod_partials(const Frame& F) {
    const float* c = F.in[1]; const float* c_ctx = F.in[3]; const float* w_mod = F.in[4];
    float* modp = WSP(float, WS_MODP);
    LAS float* s = (LAS float*)(F.lds);
    LAS float* red = (LAS float*)(F.lds + 8192);
    const int t = F.tid, cg = t % 96, kq = t / 96;
    for (int idx = F.bid; idx < 32 * 8; idx += F.nb) {
        const int ct = idx & 31, ks = idx >> 5;
        __syncthreads();
        for (int i = t; i < 1280; i += NT) { const int r = i >> 8, kk = i & 255; const float cv = (r < 4) ? c[r * D + ks * 256 + kk] : c_ctx[ks * 256 + kk]; s[i] = cv / (1.f + __expf(-cv)); }
        __syncthreads();
        if (kq < 4) {
            float acc[5][4];
#pragma unroll
            for (int r = 0; r < 5; ++r)
#pragma unroll
                for (int e = 0; e < 4; ++e) acc[r][e] = 0.f;
            const float* wp = w_mod + (size_t)(ks * 256 + kq * 64) * 12288 + ct * 384 + cg * 4;
#pragma unroll 16
            for (int i = 0; i < 64; ++i) {
                const f32x4 w = *(const f32x4*)(wp + (size_t)i * 12288);
#pragma unroll
                for (int r = 0; r < 5; ++r) { const float sv = s[r * 256 + kq * 64 + i];
#pragma unroll
                    for (int e = 0; e < 4; ++e) acc[r][e] += sv * w[e]; }
            }
#pragma unroll
            for (int r = 0; r < 5; ++r) *(LAS f32x4*)(red + (kq * 5 + r) * 384 + cg * 4) = (f32x4){acc[r][0], acc[r][1], acc[r][2], acc[r][3]};
        }
        __syncthreads();
        if (t < 384) {
#pragma unroll
            for (int r = 0; r < 5; ++r) { float v = 0.f;
#pragma unroll
                for (int q = 0; q < 4; ++q) v += red[(q * 5 + r) * 384 + t];
                modp[((size_t)ks * 5 + r) * 12288 + ct * 384 + t] = v; }
        }
    }
    __syncthreads();
}

__device__ __forceinline__ void cvt_tile(const Frame& F, const float* src, int ld, int width, int perm, bf16_t* dst, int Kd) {
    constexpr int LDT = 136;
    LAS unsigned char* Tt = F.lds;
    const int t = F.tid, n4 = t & 31, kp = t >> 5;
    const bool valid = (4 * n4) < width;
#pragma unroll
    for (int pass = 0; pass < 4; ++pass) {
        const int k = pass * 32 + 2 * kp;
        f32x4 a = (f32x4){0.f, 0.f, 0.f, 0.f}, b = a;
        if (valid) { a = *(const f32x4*)(src + (size_t)k * ld + 4 * n4); b = *(const f32x4*)(src + (size_t)(k + 1) * ld + 4 * n4); }
#pragma unroll
        for (int e = 0; e < 4; ++e) {
            const int nl = 4 * n4 + e;
            const int p1_ = (perm & 1) ? (64 * (nl >> 6) + 2 * (nl & 31) + ((nl >> 5) & 1)) : nl;
            const int prow = (perm & 2) ? ((p1_ & ~31) + 16 * ((p1_ >> 2) & 1) + 4 * ((p1_ & 31) >> 3) + (p1_ & 3)) : p1_;
            const int pc = (k >> 3) ^ ((prow >> 2) & 15);
            *(LAS unsigned*)(Tt + prow * (LDT * 2) + pc * 16 + (k & 7) * 2) = pk_bf16(a[e], b[e]);
        }
    }
    __syncthreads();
#pragma unroll
    for (int i = 0; i < 4; ++i) {
        const int id = t + 512 * i, row = id >> 4, pc = id & 15;
        const u32x4 v = *(const LAS u32x4*)(Tt + row * (LDT * 2) + ((pc ^ ((row >> 2) & 15)) * 16));
        *(u32x4*)(dst + (size_t)row * Kd + pc * 8) = v;
    }
    __syncthreads();
}

__device__ __forceinline__ void cvt_tile8(const Frame& F, const float* src, int ld, int width, int perm, unsigned char* dst, int Kd) {
    constexpr int LDT = 144;
    LAS unsigned char* Tt = F.lds;
    const int t = F.tid, n4 = t & 31, kp = t >> 5;
    const bool valid = (4 * n4) < width;
#pragma unroll
    for (int pass = 0; pass < 4; ++pass) {
        const int k = pass * 32 + 2 * kp;
        f32x4 a = (f32x4){0.f, 0.f, 0.f, 0.f}, b = a;
        if (valid) { a = *(const f32x4*)(src + (size_t)k * ld + 4 * n4); b = *(const f32x4*)(src + (size_t)(k + 1) * ld + 4 * n4); }
#pragma unroll
        for (int e = 0; e < 4; ++e) {
            const int nl = 4 * n4 + e;
            const int p1_ = (perm & 1) ? (64 * (nl >> 6) + 2 * (nl & 31) + ((nl >> 5) & 1)) : nl;
            const int prow = (perm & 2) ? ((p1_ & ~31) + 16 * ((p1_ >> 2) & 1) + 4 * ((p1_ & 31) >> 3) + (p1_ & 3)) : p1_;
            const int pc = (k >> 4) ^ ((prow >> 2) & 7);
            *(LAS unsigned short*)(Tt + prow * LDT + pc * 16 + (k & 15)) = (unsigned short)(__builtin_amdgcn_cvt_pk_fp8_f32(a[e] * 64.f, b[e] * 64.f, 0, false) & 0xffff);
        }
    }
    __syncthreads();
#pragma unroll
    for (int i = 0; i < 2; ++i) {
        const int id = t + 512 * i, row = id >> 3, pc = id & 7;
        const u32x4 v = *(const LAS u32x4*)(Tt + row * LDT + ((pc ^ ((row >> 2) & 7)) * 16));
        *(u32x4*)(dst + (size_t)row * Kd + pc * 16) = v;
    }
    __syncthreads();
}

__device__ __forceinline__ void p0_convert(const Frame& F) {
    const float* w_in = F.in[7];
    bf16_t* btin = WSP(bf16_t, WS_BTIN);
    const int J0 = 106 * 16, J1 = J0 + 3 * 256;
    for (int job = F.bid; job < J1; job += F.nb) {
        if (job < J0) {
            const int nt = job >> 4, kt = job & 15;
            const int drow = nt * 128;
            int scol, width = 128, perm = 0;
            if (drow < 1024) { scol = drow; perm = 2; }
            else if (drow < 3072) { scol = 4096 + (drow - 1024); perm = 2; }
            else if (drow < 5120) { scol = 6176 + (drow - 3072); perm = 3; }
            else if (drow < 9216) { scol = 9248 + (drow - 5120); perm = 2; }
            else if (drow < 10240) { scol = 1024 + (drow - 9216); perm = 2; }
            else if (drow < 12288) { scol = 2048 + (drow - 10240); perm = 2; }
            else if (drow < 12800) { scol = 8224 + (drow - 12288); perm = 3; }
            else if (drow < 13312) scol = 8736 + (drow - 12800);
            else if (drow < 13440) { scol = 6144; width = 32; }
            else { scol = 0; width = 0; }
#if MK_FP8_INPROJ
            cvt_tile8(F, w_in + (size_t)(kt * 128) * INW + scol, INW, width, perm, (unsigned char*)btin + (size_t)drow * 2048 + kt * 128, 2048);
#else
            const int pn_ = drow >> 8;
            const bool lat8 = MK_FP8_GATES && ((MK_F8MASK >> pn_) & 1ull), ctx8 = MK_FP8_GATES && ((MK_F8CTX >> pn_) & 1ull);
            if (lat8 || ctx8) cvt_tile8(F, w_in + (size_t)(kt * 128) * INW + scol, INW, width, perm, WSP(unsigned char, WS_BTIN8) + (size_t)drow * 2048 + kt * 128, 2048);
            if (!lat8 || (pn_ >= 36 && !ctx8)) cvt_tile(F, w_in + (size_t)(kt * 128) * INW + scol, INW, width, perm, btin + (size_t)drow * 2048 + kt * 128, 2048);
#endif
        } else {
            const int j = job - J0, which = j >> 8, nt = (j >> 4) & 15, kt = j & 15;
            const float* src = F.in[11 + which];
            bf16_t* dst = WSP(bf16_t, which == 0 ? WS_BTBRM : (which == 1 ? WS_BTBRA : WS_BTOUT));
#if MK_FP8_MIX
            cvt_tile8(F, src + (size_t)(kt * 128) * 2048 + nt * 128, 2048, 128, 2, (unsigned char*)dst + (size_t)(nt * 128) * 2048 + kt * 128, 2048);
#else
            cvt_tile(F, src + (size_t)(kt * 128) * 2048 + nt * 128, 2048, 128, 2, dst + (size_t)(nt * 128) * 2048 + kt * 128, 2048);
#endif
        }
    }
}

__device__ __forceinline__ void p0_tables(const Frame& F) {
    float* rope = WSP(float, WS_ROPE);
    const int gt = F.bid * NT + F.tid, gn = F.nb * NT;
    for (int idx = gt; idx < 2048 * 2 * 32; idx += gn) {
        const int i = idx & 31, axis = (idx >> 5) & 1, t = idx >> 6;
        const float pos = (float)(axis ? (t & 63) : (t >> 6));
        const float inv_freq = exp2f(-(float)i * (13.287712379549449f / 32.f));
        float rev = pos * inv_freq * 0.15915494309189535f;
        rev -= floorf(rev + 0.5f);
        rope[2 * idx] = __builtin_amdgcn_cosf(rev); rope[2 * idx + 1] = __builtin_amdgcn_sinf(rev);
    }
    bf16_t* wrh = WSP(bf16_t, WS_WRT); bf16_t* wrl = WSP(bf16_t, WS_WRL);
    const float* wrg = F.in[15]; const float* wre = F.in[17];
    for (int idx = gt; idx < 80 * 2048; idx += gn) {
        const int cc = idx >> 11, k = idx & 2047;
        const float wv = (cc < 8) ? wrg[k * 8 + cc] : ((cc < 72) ? wre[k * 64 + (cc - 8)] : 0.f);
        const unsigned hi = pk_bf16(wv, 0.f) & 0xffffu; const float hf = __uint_as_float(hi << 16);
        wrh[cc * WRLD + k] = (bf16_t)hi; wrl[cc * WRLD + k] = (bf16_t)(pk_bf16(wv - hf, 0.f) & 0xffffu);
    }
}

__device__ __forceinline__ void p1_norm1(const Frame& F) {
    const float* x = F.in[0]; const float* ctx = F.in[2]; const float* b_mod = F.in[5]; const float* g1n = F.in[6];
    const float* modp = WSP(float, WS_MODP); float* mod = WSP(float, WS_MOD); bf16_t* abf = WSP(bf16_t, WS_ABF);
    const int t = F.tid;
    for (int idx = F.bid * NT + t; idx < 5 * 12288; idx += F.nb * NT) {
        const int r = idx / 12288, col = idx % 12288; float v = b_mod[col];
#pragma unroll
        for (int ks = 0; ks < 8; ++ks) v += modp[((size_t)ks * 5 + r) * 12288 + col];
        mod[idx] = v;
    }
    LAS float* Asc = (LAS float*)(F.lds);
    LAS float* Bsh = (LAS float*)(F.lds + 8192);
    for (int tr = F.bid; tr < 512; tr += F.nb) {
        const bool isctx = tr >= 256;
        const int mr = isctx ? 4 : (tr * 32) / SEQ, row0 = isctx ? T + 4 * (tr - 256) : 32 * tr, nrows = isctx ? 4 : 32;
        __syncthreads();
        for (int col = t; col < 2048; col += NT) {
            float sh = b_mod[col], sc = b_mod[2048 + col];
#pragma unroll
            for (int ks = 0; ks < 8; ++ks) { sh += modp[((size_t)ks * 5 + mr) * 12288 + col]; sc += modp[((size_t)ks * 5 + mr) * 12288 + 2048 + col]; }
            Asc[col] = g1n[col] * (1.f + sc); Bsh[col] = sh;
        }
        __syncthreads();
        for (int rr = F.wave; rr < nrows; rr += 8) {
            const int row = row0 + rr;
            const float* src = (row < T) ? (x + (size_t)row * D) : (ctx + (size_t)(row - T) * D);
            f32x4 v[8]; float ss = 0.f;
#pragma unroll
            for (int i = 0; i < 8; ++i) { v[i] = *(const f32x4*)(src + (i * 64 + F.lane) * 4); ss += v[i][0] * v[i][0] + v[i][1] * v[i][1] + v[i][2] * v[i][2] + v[i][3] * v[i][3]; }
            ss = wave_sum(ss);
            const float rs = rsqrtf(ss * (1.f / D) + EPS);
#pragma unroll
            for (int i = 0; i < 8; ++i) {
                const int col = (i * 64 + F.lane) * 4;
                const f32x4 a = *(const LAS f32x4*)(Asc + col), b = *(const LAS f32x4*)(Bsh + col);
#if MK_FP8_INPROJ
                *(unsigned*)((unsigned char*)abf + (size_t)row * D + col) = pk_fp8x4(v[i][0] * rs * a[0] + b[0], v[i][1] * rs * a[1] + b[1], v[i][2] * rs * a[2] + b[2], v[i][3] * rs * a[3] + b[3]);
#else
                u32x2 o; o[0] = pk_bf16(v[i][0] * rs * a[0] + b[0], v[i][1] * rs * a[1] + b[1]); o[1] = pk_bf16(v[i][2] * rs * a[2] + b[2], v[i][3] * rs * a[3] + b[3]);
                *(u32x2*)(abf + (size_t)row * D + col) = o;
                if (MK_FP8_GATES) *(unsigned*)(WSP(unsigned char, WS_ABF8) + (size_t)row * D + col) = pk_fp8x4(v[i][0] * rs * a[0] + b[0], v[i][1] * rs * a[1] + b[1], v[i][2] * rs * a[2] + b[2], v[i][3] * rs * a[3] + b[3]);
#endif
            }
        }
    }
    __syncthreads();
}

struct InProjOrder {
    pg8::StaticOrder so; int G, c;
    __device__ void init(int G_, int c_) { so.init(T, INWP, G_, c_); G = G_; c = c_; }
    __device__ bool next(int i, Unit& u) const {
        const long L = (long)i * G + c;
        if (L < 32 * 53) return so.map(L, u);
        const int j = (int)(L - 32 * 53);
        if (j >= 4 * 17) return false;
        u.pm = 32 + (j & 3); u.pn = 36 + (j >> 2); return true;
    }
};
struct MaskOrder {
    pg8::StaticOrder so; unsigned long long mask, cmask; int G, c, nl, nc;
    __device__ static int sel(unsigned long long m, int k) { int p = 0; for (;;) { if (m & 1ull) { if (k == 0) break; --k; } m >>= 1; ++p; } return p; }
    __device__ void init(unsigned long long m, unsigned long long mctx, int G_, int c_) { mask = m; cmask = mctx >> 36; nl = __builtin_popcountll(m); nc = __builtin_popcountll(mctx >> 36); so.init(T, (nl > 0 ? nl : 1) * 256, G_, c_); G = G_; c = c_; }
    __device__ bool next(int i, Unit& u) const {
        const long L = (long)i * G + c;
        if (L < 32 * nl) { so.map(L, u); u.pn = sel(mask, u.pn); return true; }
        const int j = (int)(L - 32 * nl);
        if (j >= 4 * nc) return false;
        u.pm = 32 + (j & 3); u.pn = 36 + sel(cmask, j >> 2); return true;
    }
};
struct EpiInProj {
    bf16_t *QM, *OMS, *QA, *GBRS, *KM, *VM, *KA, *VAT; float* GM; const float* ROPE; float fs;
    __device__ __forceinline__ void operator()(const f32x4 (&acc)[2][2][4][2], const Unit& u, int wr, int wc, int fr, int fq) const {
        const int pn = u.pn; const float FS = fs;
        const int row0 = u.pm * 256 + wr * 64 + fr;
        const int cw = wc * 32 + 4 * fq;
        if (pn >= 52) {
            if (wc == 0) {
#pragma unroll
                for (int ai = 0; ai < 2; ++ai)
#pragma unroll
                    for (int m = 0; m < 4; ++m) { const int row = row0 + ai * 128 + m * 16;
#pragma unroll
                        for (int n = 0; n < 2; ++n) *(f32x4*)(GM + (size_t)row * 32 + n * 16 + 4 * fq) = acc[ai][0][m][n] * FS; }
            }
            return;
        }
        if (pn >= 50) {
            const int lc0 = (pn - 50) * 256;
#pragma unroll
            for (int ai = 0; ai < 2; ++ai)
#pragma unroll
                for (int m = 0; m < 4; ++m) { const int row = row0 + ai * 128 + m * 16;
#pragma unroll
                    for (int bj = 0; bj < 2; ++bj)
#pragma unroll
                        for (int n = 0; n < 2; ++n) { const int col = lc0 + bj * 128 + n * 16 + cw; const f32x4 v = acc[ai][bj][m][n] * FS;
                            const int t_ = fr & 3; const bool b0_ = t_ & 1, b1_ = t_ & 2;
                            int x0 = __float_as_int(v[0]), x1 = __float_as_int(v[1]), x2 = __float_as_int(v[2]), x3 = __float_as_int(v[3]);
                            { const int sa = b0_ ? x0 : x1, sb = b0_ ? x2 : x3; const int ra = __builtin_amdgcn_mov_dpp(sa, 0xB1, 0xF, 0xF, true), rb = __builtin_amdgcn_mov_dpp(sb, 0xB1, 0xF, 0xF, true);
                              if (b0_) { x0 = ra; x2 = rb; } else { x1 = ra; x3 = rb; } }
                            { const int sa = b1_ ? x0 : x2, sb = b1_ ? x1 : x3; const int ra = __builtin_amdgcn_mov_dpp(sa, 0x4E, 0xF, 0xF, true), rb = __builtin_amdgcn_mov_dpp(sb, 0x4E, 0xF, 0xF, true);
                              if (b1_) { x0 = ra; x1 = rb; } else { x2 = ra; x3 = rb; } }
                            u32x2 o; o[0] = pk_bf16(__int_as_float(x0), __int_as_float(x1)); o[1] = pk_bf16(__int_as_float(x2), __int_as_float(x3));
                            *(u32x2*)(VAT + (size_t)(col + t_) * TR + (row - t_)) = o; } }
            return;
        }
        int kind, lc0, ld; bf16_t* base;
        if (pn < 4)       { kind = 0; base = QM;   ld = 1024; lc0 = pn * 256; }
        else if (pn < 12) { kind = 1; base = OMS;  ld = 2048; lc0 = (pn - 4) * 256; }
        else if (pn < 20) { kind = 2; base = QA;   ld = 2048; lc0 = (pn - 12) * 256; }
        else if (pn < 36) { kind = 1; base = GBRS; ld = 4096; lc0 = (pn - 20) * 256; }
        else if (pn < 40) { kind = 3; base = KM;   ld = 1024; lc0 = (pn - 36) * 256; }
        else if (pn < 48) { kind = 0; base = VM;   ld = 2048; lc0 = (pn - 40) * 256; }
        else              { kind = (u.pm < 32) ? 2 : 0; base = KA; ld = 512; lc0 = (pn - 48) * 256; }
        if (kind == 2) {
#pragma unroll
            for (int ai = 0; ai < 2; ++ai)
#pragma unroll
                for (int m = 0; m < 4; ++m) { const int row = row0 + ai * 128 + m * 16; const int tpos = row & (SEQ - 1);
#pragma unroll
                    for (int bj = 0; bj < 2; ++bj) { const int col = lc0 + bj * 128 + wc * 32 + 8 * fq; const f32x4 v0 = acc[ai][bj][m][0] * FS, v1 = acc[ai][bj][m][1] * FS;
                        const int p = col & 127, axis = p >> 6, i0 = (p & 63) >> 1;
                        const float* cp = ROPE + ((size_t)(tpos * 2 + axis) * 32 + i0) * 2; const f32x4 c0 = *(const f32x4*)cp, c1 = *(const f32x4*)(cp + 4);
                        u32x4 o; o[0] = pk_bf16(v0[0] * c0[0] - v0[1] * c0[1], v0[1] * c0[0] + v0[0] * c0[1]); o[1] = pk_bf16(v0[2] * c0[2] - v0[3] * c0[3], v0[3] * c0[2] + v0[2] * c0[3]);
                        o[2] = pk_bf16(v1[0] * c1[0] - v1[1] * c1[1], v1[1] * c1[0] + v1[0] * c1[1]); o[3] = pk_bf16(v1[2] * c1[2] - v1[3] * c1[3], v1[3] * c1[2] + v1[2] * c1[3]);
                        *(u32x4*)(base + (size_t)row * ld + col) = o; } }
        } else if (kind == 1) {
#pragma unroll
            for (int ai = 0; ai < 2; ++ai)
#pragma unroll
                for (int m = 0; m < 4; ++m) { const int row = row0 + ai * 128 + m * 16;
#pragma unroll
                    for (int bj = 0; bj < 2; ++bj) { const int col = lc0 + bj * 128 + wc * 32 + 8 * fq; const f32x4 v0 = acc[ai][bj][m][0] * FS, v1 = acc[ai][bj][m][1] * FS;
                        u32x4 o; o[0] = pk_bf16(sigmoidf_(v0[0]), sigmoidf_(v0[1])); o[1] = pk_bf16(sigmoidf_(v0[2]), sigmoidf_(v0[3])); o[2] = pk_bf16(sigmoidf_(v1[0]), sigmoidf_(v1[1])); o[3] = pk_bf16(sigmoidf_(v1[2]), sigmoidf_(v1[3]));
                        *(u32x4*)(base + (size_t)row * ld + col) = o; } }
        } else {
            int oz = 0; asm volatile("" : "+v"(oz));
            const float sc = oz ? 2.f : ((kind == 3) ? 0.08838834764831845f : 1.f);
#pragma unroll
            for (int ai = 0; ai < 2; ++ai)
#pragma unroll
                for (int m = 0; m < 4; ++m) { const int row = row0 + ai * 128 + m * 16;
#pragma unroll
                    for (int bj = 0; bj < 2; ++bj) { const int col = lc0 + bj * 128 + wc * 32 + 8 * fq; const f32x4 v0 = acc[ai][bj][m][0] * FS, v1 = acc[ai][bj][m][1] * FS;
                        u32x4 o; o[0] = pk_bf16(v0[0] * sc, v0[1] * sc); o[1] = pk_bf16(v0[2] * sc, v0[3] * sc); o[2] = pk_bf16(v1[0] * sc, v1[1] * sc); o[3] = pk_bf16(v1[2] * sc, v1[3] * sc);
                        *(u32x4*)(base + (size_t)row * ld + col) = o; } }
        }
    }
};

__device__ __forceinline__ void p3_mlstm(const Frame& F) {
    const bf16_t* QM = WSP(bf16_t, WS_QM); const bf16_t* KM = WSP(bf16_t, WS_KM); const bf16_t* VM = WSP(bf16_t, WS_VM);
    const float* GM = WSP(float, WS_GM); const float* gate_b = F.in[8];
    bf16_t* HFB = WSP(bf16_t, WS_HFB);
    LAS unsigned char* L = F.lds;
    constexpr int oQ = 0, oK = 17408, oV = 34816, oKT = 44032, oVT = 62464, oS = 71680, oCT = 80896, oN = 98304, oSC = 98816, oCT2 = 102400, oN2 = 119808;
    const int t = F.tid, lane = F.lane, w = F.wave, r = lane & 15, fq = lane >> 4;
    for (int item = F.bid; item < 256; item += F.nb) {
        const int vs = item & 3, dir = (item >> 2) & 1, h = (item >> 3) & 7, b = item >> 6;
        __syncthreads();
        for (int i = t; i < 17408 / 4; i += NT) ((LAS unsigned*)(L + oCT))[i] = 0u;
        if (t < 128) ((LAS float*)(L + oN))[t] = 0.f;
        f32x4 accC[4];
#pragma unroll
        for (int vt = 0; vt < 4; ++vt) accC[vt] = (f32x4){0.f, 0.f, 0.f, 0.f};
        const float gbi = gate_b[(2 * dir) * 8 + h], gbf = gate_b[(2 * dir + 1) * 8 + h];
        u32x4 qreg[2], kreg[2], vreg;
        auto rowof = [&](int j, int p) -> int {
            if (j < 4) { const int tok = dir ? (CTXL - 1 - (64 * j + p)) : (64 * j + p); return T + b * CTXL + tok; }
            const int tok = dir ? (SEQ - 1 - (64 * (j - 4) + p)) : (64 * (j - 4) + p); return b * SEQ + tok;
        };
#define ML_LOAD(j) do { \
            _Pragma("unroll") for (int i_ = 0; i_ < 2; ++i_) { const int id_ = t + 512 * i_, p_ = id_ >> 4, c16_ = id_ & 15; const int row_ = rowof((j), p_); \
                if ((j) >= 4) qreg[i_] = *(const u32x4*)(QM + (size_t)row_ * 1024 + h * 128 + c16_ * 8); \
                kreg[i_] = *(const u32x4*)(KM + (size_t)row_ * 1024 + h * 128 + c16_ * 8); } \
            { const int p_ = t >> 3, c8_ = t & 7; const int row_ = rowof((j), p_); vreg = *(const u32x4*)(VM + (size_t)row_ * 2048 + h * 256 + vs * 64 + c8_ * 8); } } while (0)
        LAS float* preB = (LAS float*)(L + LDS_PRE_OFF), *preU = preB + 36 * 64, *preA = preU + 36 * 64;
        LAS float* preM = (LAS float*)(L + oSC + 3072);
        for (int jj = w; jj < 36; jj += 8) {
            const int row_ = rowof(jj, lane);
            const float ig = GM[(size_t)row_ * 32 + (2 * dir) * 8 + h] + gbi, f = GM[(size_t)row_ * 32 + (2 * dir + 1) * 8 + h] + gbf;
            const float lf = fminf(f, 0.f) - __logf(1.f + __expf(-fabsf(f)));
            float bs = lf;
#pragma unroll
            for (int d = 1; d < 64; d <<= 1) { const float o = __shfl_up(bs, d); if (lane >= d) bs += o; }
            const float uu = ig - bs;
            float a = uu;
#pragma unroll
            for (int d = 1; d < 64; d <<= 1) { const float o = __shfl_up(a, d); if (lane >= d) a = fmaxf(a, o); }
            preB[jj * 64 + lane] = bs; preU[jj * 64 + lane] = uu; preA[jj * 64 + lane] = a;
        }
        __syncthreads();
        if (t == 0) { float m = 0.f; for (int jj = 0; jj < 36; ++jj) { preM[jj] = m; m = preB[jj * 64 + 63] + fmaxf(m, preA[jj * 64 + 63]); } }
        ML_LOAD(0);
        for (int j = 0; j < 36; ++j) {
            const bool lat = j >= 4;
            const int par = j & 1;
            LAS float* sc_u = (LAS float*)(L + oSC + par * 1536), *sc_M = sc_u + 64, *sc_wi = sc_u + 128, *sc_fl = sc_u + 192, *sc_ws = sc_u + 256, *sc_wc = sc_u + 320;
            LAS unsigned char* sCTp = L + (par ? oCT2 : oCT); LAS unsigned char* sCTn = L + (par ? oCT : oCT2);
            LAS float* sNp = (LAS float*)(L + (par ? oN2 : oN)); LAS float* sNn = (LAS float*)(L + (par ? oN : oN2));
#pragma unroll
            for (int i = 0; i < 2; ++i) { const int id = t + 512 * i, p = id >> 4, c16 = id & 15;
                if (lat) *(LAS u32x4*)(L + oQ + p * 272 + c16 * 16) = qreg[i];
                *(LAS u32x4*)(L + oK + p * 272 + c16 * 16) = kreg[i]; }
            { const int p = t >> 3, c8 = t & 7; *(LAS u32x4*)(L + oV + p * 144 + c8 * 16) = vreg; }
            if (w == 0) {
                const float mj = preM[j], bs = preB[j * 64 + lane], uu = preU[j * 64 + lane], Mp = fmaxf(mj, preA[j * 64 + lane]), M63 = fmaxf(mj, preA[j * 64 + 63]);
                sc_u[lane] = uu; sc_M[lane] = Mp; sc_wi[lane] = __expf(mj - Mp); sc_fl[lane] = __expf(-(bs + Mp)); sc_ws[lane] = __expf(uu - M63);
                if (lane == 0) sc_wc[0] = __expf(mj - M63);
            }
            __syncthreads();
            const float wcs = sc_wc[0];
            if (j + 1 < 36) ML_LOAD(j + 1);
            { const int kp2 = t & 63, s0 = (t >> 6) * 8; float lo[8], hi[8];
#pragma unroll
                for (int e = 0; e < 8; ++e) { const unsigned x = *(const LAS unsigned*)(L + oK + (s0 + e) * 272 + kp2 * 4); const float ws = sc_ws[s0 + e]; lo[e] = bf_lo(x) * ws; hi[e] = bf_hi(x) * ws; }
                u32x4 o; o[0] = pk_bf16(lo[0], lo[1]); o[1] = pk_bf16(lo[2], lo[3]); o[2] = pk_bf16(lo[4], lo[5]); o[3] = pk_bf16(lo[6], lo[7]);
                *(LAS u32x4*)(L + oKT + (2 * kp2) * 144 + s0 * 2) = o;
                o[0] = pk_bf16(hi[0], hi[1]); o[1] = pk_bf16(hi[2], hi[3]); o[2] = pk_bf16(hi[4], hi[5]); o[3] = pk_bf16(hi[6], hi[7]);
                *(LAS u32x4*)(L + oKT + (2 * kp2 + 1) * 144 + s0 * 2) = o; }
            if (t < 256) { const int vp2 = t & 31, s0 = (t >> 5) * 8; unsigned xs[8];
#pragma unroll
                for (int e = 0; e < 8; ++e) xs[e] = *(const LAS unsigned*)(L + oV + (s0 + e) * 144 + vp2 * 4);
                u32x4 o; o[0] = (xs[0] & 0xffffu) | (xs[1] << 16); o[1] = (xs[2] & 0xffffu) | (xs[3] << 16); o[2] = (xs[4] & 0xffffu) | (xs[5] << 16); o[3] = (xs[6] & 0xffffu) | (xs[7] << 16);
                *(LAS u32x4*)(L + oVT + (2 * vp2) * 144 + s0 * 2) = o;
                o[0] = (xs[0] >> 16) | (xs[1] & 0xffff0000u); o[1] = (xs[2] >> 16) | (xs[3] & 0xffff0000u); o[2] = (xs[4] >> 16) | (xs[5] & 0xffff0000u); o[3] = (xs[6] >> 16) | (xs[7] & 0xffff0000u);
                *(LAS u32x4*)(L + oVT + (2 * vp2 + 1) * 144 + s0 * 2) = o; }
            const int pt = w >> 1, c0 = 2 * (w & 1);
            bf16x8 qa[4];
            if (lat) {
#pragma unroll
                for (int ks = 0; ks < 4; ++ks) qa[ks] = *(const LAS bf16x8*)(L + oQ + (16 * pt + r) * 272 + (32 * ks + 8 * fq) * 2);
#pragma unroll
                for (int si = 0; si < 2; ++si) { const int st = c0 + si;
                    f32x4 acc = (f32x4){0.f, 0.f, 0.f, 0.f};
                    if (st <= pt) {
#pragma unroll
                        for (int ks = 0; ks < 4; ++ks) {
                            const bf16x8 bk = *(const LAS bf16x8*)(L + oK + (16 * st + r) * 272 + (32 * ks + 8 * fq) * 2);
                            acc = __builtin_amdgcn_mfma_f32_16x16x32_bf16(qa[ks], bk, acc, 0, 0, 0); }
                    }
                    const int s = 16 * st + r; const float us = sc_u[s];
#pragma unroll
                    for (int rg = 0; rg < 4; ++rg) { const int p = 16 * pt + 4 * fq + rg;
                        const float val = (s <= p) ? acc[rg] * __expf(us - sc_M[p]) : 0.f;
                        *(LAS unsigned short*)(L + oS + p * 144 + s * 2) = (unsigned short)(pk_bf16(val, 0.f) & 0xffffu); }
                }
            }
            __syncthreads();
            if (lat) {
                float part = 0.f;
                { const int prow = 16 * pt + r;
#pragma unroll
                    for (int ks = 0; ks < 4; ++ks) { const u32x4 q8 = __builtin_bit_cast(u32x4, qa[ks]);
                        const f32x4 n0 = *(const LAS f32x4*)(sNp + 32 * ks + 8 * fq), n1 = *(const LAS f32x4*)(sNp + 32 * ks + 8 * fq + 4);
                        part += bf_lo(q8[0]) * n0[0] + bf_hi(q8[0]) * n0[1] + bf_lo(q8[1]) * n0[2] + bf_hi(q8[1]) * n0[3] + bf_lo(q8[2]) * n1[0] + bf_hi(q8[2]) * n1[1] + bf_lo(q8[3]) * n1[2] + bf_hi(q8[3]) * n1[3]; }
                    part *= DBG_NO_STATE ? 0.f : sc_wi[prow];
#pragma unroll
                    for (int ss = 0; ss < 16; ss += 8) { const u32x4 s8 = *(const LAS u32x4*)(L + oS + prow * 144 + (16 * fq + ss) * 2);
#pragma unroll
                        for (int e = 0; e < 4; ++e) part += bf_lo(s8[e]) + bf_hi(s8[e]); }
                    part += __shfl_xor(part, 16); part += __shfl_xor(part, 32);
                    part = __builtin_amdgcn_rcpf(fmaxf(fabsf(part), sc_fl[prow]));
                }
                const float inv_p = part, wi_p = DBG_NO_STATE ? 0.f : sc_wi[16 * pt + r];
                const int orow = rowof(j, 16 * pt + r);
#pragma unroll
                for (int vi = 0; vi < 2; ++vi) { const int vt = c0 + vi;
                    f32x4 acc = (f32x4){0.f, 0.f, 0.f, 0.f};
#pragma unroll
                    for (int ks = 0; ks < 4; ++ks) {
                        const bf16x8 bc = *(const LAS bf16x8*)(sCTp + (16 * vt + r) * 272 + (32 * ks + 8 * fq) * 2);
                        acc = __builtin_amdgcn_mfma_f32_16x16x32_bf16(bc, qa[ks], acc, 0, 0, 0); }
                    acc *= wi_p;
#pragma unroll
                    for (int ks = 0; ks < 2; ++ks) { const bf16x8 a = *(const LAS bf16x8*)(L + oS + (16 * pt + r) * 144 + (32 * ks + 8 * fq) * 2);
                        const bf16x8 bv = *(const LAS bf16x8*)(L + oVT + (16 * vt + r) * 144 + (32 * ks + 8 * fq) * 2);
                        acc = __builtin_amdgcn_mfma_f32_16x16x32_bf16(bv, a, acc, 0, 0, 0); }
                    u32x2 o; o[0] = pk_bf16(acc[0] * inv_p, acc[1] * inv_p); o[1] = pk_bf16(acc[2] * inv_p, acc[3] * inv_p);
                    *(u32x2*)(HFB + ((size_t)dir * T + orow) * 2048 + h * 256 + vs * 64 + 16 * vt + 4 * fq) = o;
                }
            }
            {
                const int kt = w;
#pragma unroll
                for (int vt = 0; vt < 4; ++vt) accC[vt] *= wcs;
#pragma unroll
                for (int ks = 0; ks < 2; ++ks) { const bf16x8 a = *(const LAS bf16x8*)(L + oKT + (16 * kt + r) * 144 + (32 * ks + 8 * fq) * 2);
#pragma unroll
                    for (int vt = 0; vt < 4; ++vt) { const bf16x8 bv = *(const LAS bf16x8*)(L + oVT + (16 * vt + r) * 144 + (32 * ks + 8 * fq) * 2);
                        accC[vt] = __builtin_amdgcn_mfma_f32_16x16x32_bf16(a, bv, accC[vt], 0, 0, 0); } }
#pragma unroll
                for (int vt = 0; vt < 4; ++vt) { u32x2 o; o[0] = pk_bf16(accC[vt][0], accC[vt][1]); o[1] = pk_bf16(accC[vt][2], accC[vt][3]);
                    *(LAS u32x2*)(sCTn + (16 * vt + r) * 272 + (16 * kt + 4 * fq) * 2) = o; }
                if (t < 128) { float sum = 0.f;
#pragma unroll
                    for (int ss = 0; ss < 64; ss += 8) { const u32x4 k8 = *(const LAS u32x4*)(L + oKT + t * 144 + ss * 2);
#pragma unroll
                        for (int e = 0; e < 4; ++e) sum += bf_lo(k8[e]) + bf_hi(k8[e]); }
                    sNn[t] = wcs * sNp[t] + sum; }
            }
        }
#undef ML_LOAD
    }
    __syncthreads();
}

__device__ __forceinline__ void p3_attn(const Frame& F) {
    const bf16_t* QA = WSP(bf16_t, WS_QA); const bf16_t* KA = WSP(bf16_t, WS_KA); const bf16_t* VAT = WSP(bf16_t, WS_VAT);
    bf16_t* AO = WSP(bf16_t, WS_AO); const float* sink = F.in[10];
    LAS unsigned char* L = F.lds;
    constexpr int KB = 17408, VB = 18432, BUF = KB + VB;
    constexpr float SC = 0.12751743074602542f;
    const int t = F.tid, lane = F.lane, w = F.wave, r = lane & 15, fq = lane >> 4;
    for (int item = F.bid; item < 512; item += F.nb) {
        const int n = item & 15, hp = (item >> 4) & 7, b = item >> 7;
        const int kvh = hp >> 1, head = 2 * hp + (w >> 2), qlo = 128 * n + 32 * (w & 3);
        bf16x8 qf[2][4];
#pragma unroll
        for (int qt = 0; qt < 2; ++qt)
#pragma unroll
            for (int ks = 0; ks < 4; ++ks) qf[qt][ks] = *(const bf16x8*)(QA + (size_t)(b * SEQ + qlo + 16 * qt + r) * 2048 + head * 128 + 32 * ks + 8 * fq);
        const int tlo = (n == 0) ? 2 : 0, thi = (n == 15) ? 4 : 6, ntiles = 4 + thi - tlo;
        f32x4 oacc[8][2];
#pragma unroll
        for (int dt = 0; dt < 8; ++dt) { oacc[dt][0] = (f32x4){0.f, 0.f, 0.f, 0.f}; oacc[dt][1] = (f32x4){0.f, 0.f, 0.f, 0.f}; }
        float mrun[2] = {-1e30f, -1e30f}, lsum[2] = {0.f, 0.f};
        u32x4 kr[2], vr[2];
#define AT_ROW0(i) (((i) < 4) ? (T + b * CTXL + 64 * (i)) : (b * SEQ + 128 * (n - 1) + 64 * (tlo + (i) - 4)))
#define AT_LOAD(i) do { const int row0_ = AT_ROW0(i); \
            _Pragma("unroll") for (int ii_ = 0; ii_ < 2; ++ii_) { const int id_ = t + 512 * ii_; \
                kr[ii_] = *(const u32x4*)(KA + (size_t)(row0_ + (id_ >> 4)) * 512 + kvh * 128 + (id_ & 15) * 8); \
                vr[ii_] = *(const u32x4*)(VAT + (size_t)(kvh * 128 + (id_ >> 3)) * TR + row0_ + (id_ & 7) * 8); } } while (0)
        const int vst = (t >> 3) * 144 + 64 * ((t >> 2) & 1) + 32 * (t & 1) + 8 * ((t >> 1) & 1);
#define AT_STORE(buf) do { _Pragma("unroll") for (int ii_ = 0; ii_ < 2; ++ii_) { const int id_ = t + 512 * ii_; \
                *(LAS u32x4*)(L + (buf) * BUF + (id_ >> 4) * 272 + (id_ & 15) * 16) = kr[ii_]; \
                { LAS unsigned char* vp_ = L + (buf) * BUF + KB + vst + ii_ * (64 * 144);     \
                  *(LAS u32x2*)vp_ = (u32x2){vr[ii_][0], vr[ii_][1]}; *(LAS u32x2*)(vp_ + 16) = (u32x2){vr[ii_][2], vr[ii_][3]}; } } } while (0)
        __syncthreads();
        AT_LOAD(0); AT_STORE(0);
        __syncthreads();
        for (int i = 0; i < ntiles; ++i) {
            if (i + 1 < ntiles) AT_LOAD(i + 1);
            const bool local = i >= 4;
            const int kp0 = 128 * (n - 1) + 64 * (tlo + i - 4);
            const bool active = !local || (kp0 + 63 >= qlo - 128 && kp0 <= qlo + 31 + 128);
            const bool need_mask = local && !(qlo + 31 - kp0 <= 128 && kp0 + 63 - qlo <= 128);
            if (active) {
                LAS unsigned char* sK = L + (i & 1) * BUF; LAS unsigned char* sV = sK + KB;
                f32x4 sacc[4][2];
#pragma unroll
                for (int kt = 0; kt < 4; ++kt) { sacc[kt][0] = (f32x4){0.f, 0.f, 0.f, 0.f}; sacc[kt][1] = (f32x4){0.f, 0.f, 0.f, 0.f}; }
#pragma unroll
                for (int ks = 0; ks < 4; ++ks)
#pragma unroll
                    for (int kt = 0; kt < 4; ++kt) { const bf16x8 a = *(const LAS bf16x8*)(sK + (16 * kt + r) * 272 + (32 * ks + 8 * fq) * 2);
                        sacc[kt][0] = __builtin_amdgcn_mfma_f32_16x16x32_bf16(a, qf[0][ks], sacc[kt][0], 0, 0, 0);
                        sacc[kt][1] = __builtin_amdgcn_mfma_f32_16x16x32_bf16(a, qf[1][ks], sacc[kt][1], 0, 0, 0); }
                bf16x8 pf[2][2];
#pragma unroll
                for (int qt = 0; qt < 2; ++qt) {
                    const int qp = qlo + 16 * qt + r;
                    float mt = -1e30f;
                    if (need_mask) {
#pragma unroll
                        for (int kt = 0; kt < 4; ++kt)
#pragma unroll
                            for (int rg = 0; rg < 4; ++rg) { float s = sacc[kt][qt][rg];
                                const int dd = qp - (kp0 + 16 * kt + 4 * fq + rg); if (dd > 128 || dd < -128) s = -1e30f;
                                sacc[kt][qt][rg] = s; mt = fmaxf(mt, s); }
                    } else {
#pragma unroll
                        for (int kt = 0; kt < 4; ++kt)
#pragma unroll
                            for (int rg = 0; rg < 4; ++rg) mt = fmaxf(mt, sacc[kt][qt][rg]);
                    }
                    mt = fmaxf(mt, __shfl_xor(mt, 16)); mt = fmaxf(mt, __shfl_xor(mt, 32));
                    const float mnew = fmaxf(mrun[qt], mt * SC), alpha = __builtin_amdgcn_exp2f(mrun[qt] - mnew);
                    mrun[qt] = mnew;
                    float ps = 0.f;
#pragma unroll
                    for (int kt = 0; kt < 4; ++kt)
#pragma unroll
                        for (int rg = 0; rg < 4; ++rg) { const float p = __builtin_amdgcn_exp2f(fmaf(sacc[kt][qt][rg], SC, -mnew)); sacc[kt][qt][rg] = p; ps += p; }
                    lsum[qt] = lsum[qt] * alpha + ps;
#pragma unroll
                    for (int dt = 0; dt < 8; ++dt) oacc[dt][qt] *= alpha;
#pragma unroll
                    for (int k2 = 0; k2 < 2; ++k2) { u32x4 o;
                        o[0] = pk_bf16(sacc[2 * k2][qt][0], sacc[2 * k2][qt][1]); o[1] = pk_bf16(sacc[2 * k2][qt][2], sacc[2 * k2][qt][3]);
                        o[2] = pk_bf16(sacc[2 * k2 + 1][qt][0], sacc[2 * k2 + 1][qt][1]); o[3] = pk_bf16(sacc[2 * k2 + 1][qt][2], sacc[2 * k2 + 1][qt][3]);
                        pf[qt][k2] = __builtin_bit_cast(bf16x8, o); }
                }
#pragma unroll
                for (int k2 = 0; k2 < 2; ++k2)
#pragma unroll
                    for (int dh = 0; dh < 2; ++dh) { bf16x8 a[4];
#pragma unroll
                        for (int d4 = 0; d4 < 4; ++d4) a[d4] = *(const LAS bf16x8*)(sV + (16 * (4 * dh + d4) + r) * 144 + 64 * k2 + 16 * fq);
#pragma unroll
                        for (int d4 = 0; d4 < 4; ++d4) { const int dt = 4 * dh + d4;
                            oacc[dt][0] = __builtin_amdgcn_mfma_f32_16x16x32_bf16(a[d4], pf[0][k2], oacc[dt][0], 0, 0, 0);
                            oacc[dt][1] = __builtin_amdgcn_mfma_f32_16x16x32_bf16(a[d4], pf[1][k2], oacc[dt][1], 0, 0, 0); }
                        __builtin_amdgcn_sched_barrier(0); }
            }
            if (i + 1 < ntiles) AT_STORE((i + 1) & 1);
            __syncthreads();
        }
#undef AT_ROW0
#undef AT_LOAD
#undef AT_STORE
        LAS unsigned char* sO = L + w * 8704;
        const float sk = sink[head] * 1.4426950408889634f;
#pragma unroll
        for (int qt = 0; qt < 2; ++qt) {
            float l = lsum[qt]; l += __shfl_xor(l, 16); l += __shfl_xor(l, 32); l += exp2f(sk - mrun[qt]);
            const float inv = __builtin_amdgcn_rcpf(l);
#pragma unroll
#if MK_FP8_MIX
            for (int dt = 0; dt < 8; ++dt) *(LAS unsigned*)(sO + (16 * qt + r) * 144 + 16 * dt + 4 * fq) = pk_fp8x4(oacc[dt][qt][0] * inv, oacc[dt][qt][1] * inv, oacc[dt][qt][2] * inv, oacc[dt][qt][3] * inv);
        }
#pragma unroll
        for (int i = 0; i < 4; ++i) { const int id = i * 64 + lane, row = id >> 3, cc = id & 7;
            const u32x4 v = *(const LAS u32x4*)(sO + row * 144 + cc * 16);
            *(u32x4*)((unsigned char*)AO + (size_t)(b * SEQ + qlo + row) * 2048 + head * 128 + cc * 16) = v; }
#else
            for (int dt = 0; dt < 8; ++dt) { u32x2 o; o[0] = pk_bf16(oacc[dt][qt][0] * inv, oacc[dt][qt][1] * inv); o[1] = pk_bf16(oacc[dt][qt][2] * inv, oacc[dt][qt][3] * inv);
                *(LAS u32x2*)(sO + (16 * qt + r) * 272 + (16 * dt + 4 * fq) * 2) = o; }
        }
#pragma unroll
        for (int i = 0; i < 8; ++i) { const int id = i * 64 + lane, row = id >> 4, cc = id & 15;
            const u32x4 v = *(const LAS u32x4*)(sO + row * 272 + cc * 16);
            *(u32x4*)(AO + (size_t)(b * SEQ + qlo + row) * 2048 + head * 128 + cc * 8) = v; }
#endif
    }
    __syncthreads();
}

__device__ __forceinline__ void p4_postmix(const Frame& F) {
    const bf16_t* HF = WSP(bf16_t, WS_HFB); const bf16_t* HB = HF + (size_t)T * 2048; const bf16_t* OMS = WSP(bf16_t, WS_OMS);
    const float* ng = F.in[9]; bf16_t* AM = WSP(bf16_t, WS_AM);
    for (int row = F.bid * 8 + F.wave; row < T; row += F.nb * 8) {
#pragma unroll
        for (int i = 0; i < 4; ++i) {
            const int col = i * 512 + F.lane * 8;
            const u32x4 a = *(const u32x4*)(HF + (size_t)row * 2048 + col), bq = *(const u32x4*)(HB + (size_t)row * 2048 + col), o8 = *(const u32x4*)(OMS + (size_t)row * 2048 + col);
            float hs[8]; float ss = 0.f;
#pragma unroll
            for (int e = 0; e < 4; ++e) { hs[2 * e] = bf_lo(a[e]) + bf_lo(bq[e]); hs[2 * e + 1] = bf_hi(a[e]) + bf_hi(bq[e]); ss += hs[2 * e] * hs[2 * e] + hs[2 * e + 1] * hs[2 * e + 1]; }
#pragma unroll
            for (int d = 16; d >= 1; d >>= 1) ss += __shfl_xor(ss, d);
            const float rs = rsqrtf(ss * (1.f / 256.f) + EPS);
            const f32x4 g0 = *(const f32x4*)(ng + col), g1 = *(const f32x4*)(ng + col + 4);
            u32x4 o;
            o[0] = pk_bf16(hs[0] * rs * g0[0] * bf_lo(o8[0]), hs[1] * rs * g0[1] * bf_hi(o8[0]));
            o[1] = pk_bf16(hs[2] * rs * g0[2] * bf_lo(o8[1]), hs[3] * rs * g0[3] * bf_hi(o8[1]));
            o[2] = pk_bf16(hs[4] * rs * g1[0] * bf_lo(o8[2]), hs[5] * rs * g1[1] * bf_hi(o8[2]));
            o[3] = pk_bf16(hs[6] * rs * g1[2] * bf_lo(o8[3]), hs[7] * rs * g1[3] * bf_hi(o8[3]));
#if MK_FP8_MIX
            { u32x2 o8v; o8v[0] = pk_fp8x4(bf_lo(o[0]), bf_hi(o[0]), bf_lo(o[1]), bf_hi(o[1])); o8v[1] = pk_fp8x4(bf_lo(o[2]), bf_hi(o[2]), bf_lo(o[3]), bf_hi(o[3]));
              *(u32x2*)((unsigned char*)AM + (size_t)row * 2048 + col) = o8v; }
#else
            *(u32x4*)(AM + (size_t)row * 2048 + col) = o;
#endif
        }
    }
}

struct EpiBr1 {
    float* TMP; const bf16_t* GBRS;
    __device__ __forceinline__ void operator()(const f32x4 (&acc)[2][2][4][2], const Unit& u, int wr, int wc, int fr, int fq) const {
        const int row0 = u.pm * 256 + wr * 64 + fr, col0 = u.pn * 256 + wc * 32 + 8 * fq;
#pragma unroll
        for (int ai = 0; ai < 2; ++ai)
#pragma unroll
            for (int m = 0; m < 4; ++m) { const int row = row0 + ai * 128 + m * 16;
#pragma unroll
                for (int bj = 0; bj < 2; ++bj) { const int col = col0 + bj * 128; const f32x4 v0 = acc[ai][bj][m][0] * (MK_FP8_MIX ? 0.015625f : 1.f), v1 = acc[ai][bj][m][1] * (MK_FP8_MIX ? 0.015625f : 1.f);
                    const u32x4 g = *(const u32x4*)(GBRS + (size_t)row * 4096 + col);
                    u32x4 o; o[0] = pk_bf16(v0[0] * bf_lo(g[0]), v0[1] * bf_hi(g[0])); o[1] = pk_bf16(v0[2] * bf_lo(g[1]), v0[3] * bf_hi(g[1]));
                    o[2] = pk_bf16(v1[0] * bf_lo(g[2]), v1[1] * bf_hi(g[2])); o[3] = pk_bf16(v1[2] * bf_lo(g[3]), v1[3] * bf_hi(g[3]));
                    *(u32x4*)((bf16_t*)TMP + (size_t)row * 2048 + col) = o; } }
    }
};
struct EpiBr2 {
    const float* TMP; const bf16_t* GBRS; bf16_t* AOUT;
    __device__ __forceinline__ void operator()(const f32x4 (&acc)[2][2][4][2], const Unit& u, int wr, int wc, int fr, int fq) const {
        const int row0 = u.pm * 256 + wr * 64 + fr, col0 = u.pn * 256 + wc * 32 + 8 * fq;
#pragma unroll
        for (int ai = 0; ai < 2; ++ai)
#pragma unroll
            for (int m = 0; m < 4; ++m) { const int row = row0 + ai * 128 + m * 16;
#pragma unroll
                for (int bj = 0; bj < 2; ++bj) { const int col = col0 + bj * 128; const f32x4 v0 = acc[ai][bj][m][0] * (MK_FP8_MIX ? 0.015625f : 1.f), v1 = acc[ai][bj][m][1] * (MK_FP8_MIX ? 0.015625f : 1.f);
                    const u32x4 g = *(const u32x4*)(GBRS + (size_t)row * 4096 + 2048 + col);
                    const u32x4 tmb = *(const u32x4*)((const bf16_t*)TMP + (size_t)row * 2048 + col);
                    const float zz = DBG_NO_ATTN ? 0.f : 1.f;
                    u32x4 o; o[0] = pk_bf16(bf_lo(tmb[0]) + zz * v0[0] * bf_lo(g[0]), bf_hi(tmb[0]) + zz * v0[1] * bf_hi(g[0])); o[1] = pk_bf16(bf_lo(tmb[1]) + zz * v0[2] * bf_lo(g[1]), bf_hi(tmb[1]) + zz * v0[3] * bf_hi(g[1]));
                    o[2] = pk_bf16(bf_lo(tmb[2]) + zz * v1[0] * bf_lo(g[2]), bf_hi(tmb[2]) + zz * v1[1] * bf_hi(g[2])); o[3] = pk_bf16(bf_lo(tmb[3]) + zz * v1[2] * bf_lo(g[3]), bf_hi(tmb[3]) + zz * v1[3] * bf_hi(g[3]));
#if MK_FP8_MIX
                    { u32x2 o8; o8[0] = pk_fp8x4(bf_lo(o[0]), bf_hi(o[0]), bf_lo(o[1]), bf_hi(o[1])); o8[1] = pk_fp8x4(bf_lo(o[2]), bf_hi(o[2]), bf_lo(o[3]), bf_hi(o[3]));
                      *(u32x2*)((unsigned char*)AOUT + (size_t)row * 2048 + col) = o8; } } }
#else
                    *(u32x4*)(AOUT + (size_t)row * 2048 + col) = o; } }
#endif
    }
};
struct EpiOut {
    const float* X; const float* MOD; float* X1; float* RSS;
    __device__ __forceinline__ void operator()(const f32x4 (&acc)[2][2][4][2], const Unit& u, int wr, int wc, int fr, int fq) const {
        const int row0 = u.pm * 256 + wr * 64 + fr, col0 = u.pn * 256 + wc * 32 + 8 * fq;
        const float* g1 = MOD + (size_t)((u.pm * 256) / SEQ) * 12288 + 2 * 2048;
        float ssq[2][4];
#pragma unroll
        for (int ai = 0; ai < 2; ++ai)
#pragma unroll
            for (int m = 0; m < 4; ++m) ssq[ai][m] = 0.f;
#pragma unroll
        for (int bj = 0; bj < 2; ++bj)
#pragma unroll
            for (int n = 0; n < 2; ++n) { const int col = col0 + bj * 128 + n * 4; const f32x4 gv = *(const f32x4*)(g1 + col);
#pragma unroll
                for (int ai = 0; ai < 2; ++ai)
#pragma unroll
                    for (int m = 0; m < 4; ++m) { const int row = row0 + ai * 128 + m * 16; const f32x4 v = acc[ai][bj][m][n] * (MK_FP8_MIX ? 0.015625f : 1.f);
                        const f32x4 xv = *(const f32x4*)(X + (size_t)row * 2048 + col);
                        const f32x4 o = xv + gv * v; ssq[ai][m] += (o[0] * o[0] + o[1] * o[1]) + (o[2] * o[2] + o[3] * o[3]);
                        *(f32x4*)(X1 + (size_t)row * 2048 + col) = o; } }
#pragma unroll
        for (int ai = 0; ai < 2; ++ai)
#pragma unroll
            for (int m = 0; m < 4; ++m) { float q = ssq[ai][m]; q += __shfl_xor(q, 16); q += __shfl_xor(q, 32);
                if (fq == 0) RSS[(size_t)(row0 + ai * 128 + m * 16) * 32 + u.pn * 4 + wc] = q; }
    }
};

template <bool DUMMY = false>
__device__ __forceinline__ void p7_norm2_router(const Frame& F) {
    const float* X1 = WSP(float, WS_X1); const float* mod = WSP(float, WS_MOD); const float* g2n = F.in[14]; const float* rss = WSP(float, WS_RSS);
    const float* brg = F.in[16]; const float* bre = F.in[18]; const bf16_t* wrh = WSP(bf16_t, WS_WRT); const bf16_t* wrl = WSP(bf16_t, WS_WRL);
    bf16_t* H2 = WSP(bf16_t, DUMMY ? WS_XG : WS_H2); int* EID = WSP(int, DUMMY ? WS_XG + (64u << 20) : WS_EID); float* WTOP = WSP(float, DUMMY ? WS_XG + (65u << 20) : WS_WTOP); int* POS = WSP(int, DUMMY ? WS_XG + (66u << 20) : WS_POS);
    unsigned* cnt = DUMMY ? (unsigned*)(F.ws + WS_XG + (67u << 20)) : (unsigned*)(F.ws + WS_CTL + CTL_CNT);
    LAS float* Asc = (LAS float*)(F.lds); LAS float* Bsh = (LAS float*)(F.lds + 8192);
    LAS float* lss = (LAS float*)(F.lds + 16384);
    LAS float* lpart = (LAS float*)(F.lds + 16384 + 1024);
    LAS float* lfin = (LAS float*)(F.lds + 16384 + 1024 + 81920);
    const int t = F.tid, lane = F.lane, w = F.wave, r = lane & 15, fq = lane >> 4;
    int cur_mr = -1;
    for (int rg = F.bid; rg < T / 32; rg += F.nb) {
        const int mr = (rg * 32) / SEQ;
        __syncthreads();
        if (mr != cur_mr) {
#pragma unroll
            for (int ci = 0; ci < 2048 / NT; ++ci) { const int col = t + ci * NT; Asc[col] = g2n[col] * (1.f + mod[(size_t)mr * 12288 + 4 * 2048 + col]); Bsh[col] = mod[(size_t)mr * 12288 + 3 * 2048 + col]; }
            cur_mr = mr;
        }
        const float* src = X1 + (size_t)(rg * 32 + r) * D + w * 256 + 8 * fq;
        float rs2[2];
#pragma unroll
        for (int tl = 0; tl < 2; ++tl) {
            const float* rp = rss + (size_t)(rg * 32 + tl * 16 + r) * 32 + fq * 8;
            const f32x4 p0 = *(const f32x4*)rp, p1 = *(const f32x4*)(rp + 4);
            float tot = ((p0[0] + p0[1]) + (p0[2] + p0[3])) + ((p1[0] + p1[1]) + (p1[2] + p1[3]));
            tot += __shfl_xor(tot, 16); tot += __shfl_xor(tot, 32);
            rs2[tl] = rsqrtf(tot * (1.f / D) + EPS);
        }
        __syncthreads();
        f32x4 acc[2][5];
#pragma unroll
        for (int tl = 0; tl < 2; ++tl)
#pragma unroll
            for (int ct = 0; ct < 5; ++ct) acc[tl][ct] = (f32x4){0.f, 0.f, 0.f, 0.f};
#pragma unroll 2
        for (int s0_ = 0; s0_ < 8; ++s0_) {
            const int s_ = (s0_ + F.bid) & 7;
            const int kk = w * 256 + s_ * 32 + 8 * fq;
            bf16x8 bh[5], bl[5];
#pragma unroll
            for (int ct = 0; ct < 5; ++ct) { bh[ct] = *(const bf16x8*)(wrh + (size_t)(16 * ct + r) * WRLD + kk); bl[ct] = *(const bf16x8*)(wrl + (size_t)(16 * ct + r) * WRLD + kk); }
            const f32x4 a0 = *(const LAS f32x4*)(Asc + kk), a1 = *(const LAS f32x4*)(Asc + kk + 4), b0 = *(const LAS f32x4*)(Bsh + kk), b1 = *(const LAS f32x4*)(Bsh + kk + 4);
#pragma unroll
            for (int tl = 0; tl < 2; ++tl) {
                const int row = rg * 32 + tl * 16 + r; const float rs = rs2[tl];
                const f32x4 v0 = *(const f32x4*)(src + (size_t)tl * 16 * D + s_ * 32), v1 = *(const f32x4*)(src + (size_t)tl * 16 * D + s_ * 32 + 4);
                float hv[8];
#pragma unroll
                for (int e = 0; e < 4; ++e) { hv[e] = v0[e] * rs * a0[e] + b0[e]; hv[4 + e] = v1[e] * rs * a1[e] + b1[e]; }
                u32x4 hi, lo;
#pragma unroll
                for (int e = 0; e < 4; ++e) { hi[e] = pk_bf16(hv[2 * e], hv[2 * e + 1]); lo[e] = pk_bf16(hv[2 * e] - bf_lo(hi[e]), hv[2 * e + 1] - bf_hi(hi[e])); }
#if MK_FP8_MOE
                { u32x2 h8; h8[0] = pk_fp8x4(hv[0], hv[1], hv[2], hv[3]); h8[1] = pk_fp8x4(hv[4], hv[5], hv[6], hv[7]); *(u32x2*)((unsigned char*)H2 + (size_t)row * D + kk) = h8; }
#else
                *(u32x4*)(H2 + (size_t)row * D + kk) = hi;
#endif
                const bf16x8 ah = __builtin_bit_cast(bf16x8, hi), al = __builtin_bit_cast(bf16x8, lo);
#pragma unroll
                for (int ct = 0; ct < 5; ++ct) {
                    acc[tl][ct] = __builtin_amdgcn_mfma_f32_16x16x32_bf16(ah, bh[ct], acc[tl][ct], 0, 0, 0);
                    acc[tl][ct] = __builtin_amdgcn_mfma_f32_16x16x32_bf16(ah, bl[ct], acc[tl][ct], 0, 0, 0);
                    acc[tl][ct] = __builtin_amdgcn_mfma_f32_16x16x32_bf16(al, bh[ct], acc[tl][ct], 0, 0, 0);
                }
            }
        }
#pragma unroll
        for (int tl = 0; tl < 2; ++tl)
#pragma unroll
            for (int ct = 0; ct < 5; ++ct)
#pragma unroll
                for (int rg_ = 0; rg_ < 4; ++rg_) lpart[((w * 2 + tl) * 16 + 4 * fq + rg_) * 80 + 16 * ct + r] = acc[tl][ct][rg_];
        __syncthreads();
        for (int idx = t; idx < 32 * 72; idx += NT) {
            const int tk = idx / 72, c_ = idx - tk * 72, tl = tk >> 4, rr = tk & 15;
            float v = (c_ < 8) ? brg[c_] : bre[c_ - 8];
#pragma unroll
            for (int q = 0; q < 8; ++q) v += lpart[((q * 2 + tl) * 16 + rr) * 80 + c_];
            lfin[idx] = v;
        }
        __syncthreads();
        if (t < 32) {
            const int tok = rg * 32 + t;
            float gl[8]; float gmax = -3.0e38f; int gs = 0;
#pragma unroll
            for (int i = 0; i < 8; ++i) { gl[i] = lfin[t * 72 + i]; if (gl[i] > gmax) { gmax = gl[i]; gs = i; } }
            float den = 0.f;
#pragma unroll
            for (int i = 0; i < 8; ++i) den += __expf(gl[i] - gmax);
            const float pg = 1.f / den;
            float v1 = -3.0e38f, v2 = -3.0e38f; int i1 = 0, i2 = 0;
#pragma unroll
            for (int i = 0; i < 8; ++i) { const float ev = lfin[t * 72 + 8 + gs * 8 + i];
                if (ev > v1) { v2 = v1; i2 = i1; v1 = ev; i1 = i; } else if (ev > v2) { v2 = ev; i2 = i; } }
            const float w1 = 1.f / (1.f + __expf(v2 - v1)), w2 = 1.f - w1;
            const int e1 = gs * 8 + i1, e2 = gs * 8 + i2;
            const unsigned p1 = atomicAdd(&cnt[e1], 1u), p2 = atomicAdd(&cnt[e2], 1u);
            EID[2 * tok] = e1; EID[2 * tok + 1] = e2; WTOP[2 * tok] = w1 * pg; WTOP[2 * tok + 1] = w2 * pg; POS[2 * tok] = (int)p1; POS[2 * tok + 1] = (int)p2;
        }
    }
    __syncthreads();
}

__device__ __forceinline__ void p8_lists(const Frame& F) {
    const unsigned* cnt = (const unsigned*)(F.ws + WS_CTL + CTL_CNT);
    const int* EID = WSP(int, WS_EID); const float* WTOP = WSP(float, WS_WTOP); const int* POS = WSP(int, WS_POS);
    int* ROWMAP = WSP(int, WS_ROWMAP); float* ROWW = WSP(float, WS_ROWW); int* ROWTOK = WSP(int, WS_ROWTOK); int* PST = WSP(int, WS_PANEL);
    LAS int* pstart = (LAS int*)(F.lds + LDS_TAB_OFF);
    __syncthreads();
    if (F.tid == 0) {
        int acc = 0;
        for (int e = 0; e < NEXP; ++e) { pstart[e] = acc; if (F.bid == 0) PST[e] = acc; acc += (int)cnt[e]; }
        pstart[NEXP] = acc; if (F.bid == 0) PST[NEXP] = acc;
    }
    __syncthreads();
    for (int a = F.bid * NT + F.tid; a < 2 * T; a += F.nb * NT) {
        const int pos = pstart[EID[a]] + POS[a];
        ROWMAP[pos] = a; ROWW[pos] = WTOP[a]; ROWTOK[pos] = a >> 1;
    }
}

__device__ __forceinline__ int moe_phys(int s) { return s ^ ((s >> 3) & 3); }
template <bool GU, int VAR = 0>
__device__ __forceinline__ void moe_gemm(const Frame& F) {
    constexpr int K = GU ? 2048 : 1024, NT2 = K / 64, LDB = GU ? 1024 : 2048, LDA = GU ? 2048 : 1024;
    constexpr int STG = 65536, BOFF = 49152;
    const int* PST = WSP(int, WS_PANEL); const int* ROWTOK = WSP(int, WS_ROWTOK); const int* ROWMAP = WSP(int, WS_ROWMAP); const float* ROWW = WSP(float, WS_ROWW);
    const bf16_t* H2 = WSP(bf16_t, WS_H2); bf16_t* HBUF = WSP(bf16_t, VAR ? WS_XG : WS_HBUF); bf16_t* YBUF = WSP(bf16_t, WS_YBUF);
    LAS unsigned char* L = F.lds;
    const int nrounds = (NEXP * 16 + F.nb - 1) / F.nb;
    for (int rnd = 0; rnd < nrounds; ++rnd) {
        int unit;
        if ((F.nb & 127) == 0) { const int xcd = F.bid & 7, j = F.bid >> 3, epx = F.nb >> 7;
            unit = ((rnd * 8 + xcd) * epx + (j >> 4)) * 16 + (j & 15); }
        else unit = rnd * F.nb + F.bid;
        if (unit >= NEXP * 16) continue;
        const int e = unit >> 4, nti = unit & 15;
        const int ps = PST[e], Me = PST[e + 1] - ps;
        for (int m0 = 0; m0 < Me; m0 += 320) {
            const int rows = (Me - m0) < 320 ? (Me - m0) : 320;
            int tz = threadIdx.x; asm volatile("" : "+v"(tz));
            const int t = tz, w = __builtin_amdgcn_readfirstlane(tz >> 6), lane = tz & 63, fr = lane & 15, fq = lane >> 4, wr4 = (w >> 1) & 3, wc2 = w & 1;
            const bool bwave = w < 4;
            f32x4 acc[5][4];
#pragma unroll
            for (int m = 0; m < 5; ++m)
#pragma unroll
                for (int ns = 0; ns < 4; ++ns) acc[m][ns] = (f32x4){0.f, 0.f, 0.f, 0.f};
            int boffr[4];
#pragma unroll
            for (int ns = 0; ns < 4; ++ns) boffr[ns] = BOFF + (fq * 128 + moe_phys(64 * wc2 + 16 * ns + fr)) * 16;
            const int arow0 = 80 * wr4 + fr;
            const bool ga = (80 * wr4) < rows, gb = (80 * wr4 + 48) < rows;
#define MOE_LDA(dst_, h_, n_, sb_, ks_) do { _Pragma("unroll") for (int q_ = 0; q_ < (n_); ++q_) { const int r_ = arow0 + 16 * ((h_) * 3 + q_); \
                dst_[q_] = *(const LAS bf16x8*)((sb_) + r_ * 128 + (((4 * (ks_) + fq) ^ ((r_ >> 1) & 7)) * 16)); } } while (0)
#define MOE_LDB(dst_, sb_, ks_) do { _Pragma("unroll") for (int ns_ = 0; ns_ < 4; ++ns_) dst_[ns_] = *(const LAS bf16x8*)((sb_) + boffr[ns_] + (ks_) * (4 * 128 * 16)); } while (0)
#define MOE_MM(bf_, af_, h_, n_) do { _Pragma("unroll") for (int q_ = 0; q_ < (n_); ++q_) _Pragma("unroll") for (int ns_ = 0; ns_ < 4; ++ns_) \
                acc[(h_) * 3 + q_][ns_] = __builtin_amdgcn_mfma_f32_16x16x32_bf16(bf_[ns_], af_[q_], acc[(h_) * 3 + q_][ns_], 0, 0, 0); } while (0)
#define MOE_COMPUTE(st_) do { LAS unsigned char* sb_ = L + (st_) * STG; if (ga) { bf16x8 b0_[4], b1_[4], a0_[3], a1_[2], a2_[3], a3_[2]; \
            MOE_LDB(b0_, sb_, 0); MOE_LDA(a0_, 0, 3, sb_, 0); MOE_LDA(a1_, 1, 2, sb_, 0); __builtin_amdgcn_sched_barrier(0); \
            MOE_MM(b0_, a0_, 0, 3); MOE_LDB(b1_, sb_, 1); MOE_LDA(a2_, 0, 3, sb_, 1); __builtin_amdgcn_sched_barrier(0); \
            if (gb) MOE_MM(b0_, a1_, 1, 2); MOE_LDA(a3_, 1, 2, sb_, 1); __builtin_amdgcn_sched_barrier(0); \
            MOE_MM(b1_, a2_, 0, 3); if (gb) MOE_MM(b1_, a3_, 1, 2); } } while (0)
            if (bwave) {
                int boff[4]; u32x4 stg[16]; const char* bbase; unsigned blane;
                {
                    int n4, kp, scol, isup = 0;
                    if (GU) { const int tg = t & 127; n4 = tg & 15; kp = tg >> 4; isup = w >> 1; scol = 64 * nti; bbase = (const char*)(F.in[isup ? 20 : 19] + (size_t)e * 2048 * 1024 + scol); }
                    else    { n4 = t & 31; kp = t >> 5; scol = 128 * nti; bbase = (const char*)(F.in[21] + (size_t)e * 1024 * 2048 + scol); }
                    blane = (unsigned)(((8 * kp) * LDB + 4 * n4) * 4);
#pragma unroll
                    for (int j = 0; j < 4; ++j) { const int g = 4 * n4 + j; const int s0 = GU ? (64 * (g >> 5) + (g & 31) + 32 * isup) : g;
                        boff[j] = BOFF + (kp * 128 + moe_phys(s0)) * 16; }
                }
#define MOE_LOADB(slot, tile) do { _Pragma("unroll") for (int i_ = 0; i_ < 8; ++i_) stg[(slot) * 8 + i_] = *(const u32x4*)(bbase + ((size_t)(tile) * 64 + i_) * (LDB * 4) + blane); } while (0)
                MOE_LOADB(0, 0); __builtin_amdgcn_sched_barrier(0); MOE_LOADB(1, 1); __builtin_amdgcn_sched_barrier(0);
#define MOE_BSTEP(s) do { LAS unsigned char* sw_ = L + (s) * STG; \
                { f32x4 b_[8]; _Pragma("unroll") for (int i_ = 0; i_ < 8; ++i_) b_[i_] = __builtin_bit_cast(f32x4, stg[(s) * 8 + i_]); \
                  _Pragma("unroll") for (int j_ = 0; j_ < 4; ++j_) { u32x4 o_; o_[0] = pk_bf16(b_[0][j_], b_[1][j_]); o_[1] = pk_bf16(b_[2][j_], b_[3][j_]); o_[2] = pk_bf16(b_[4][j_], b_[5][j_]); o_[3] = pk_bf16(b_[6][j_], b_[7][j_]); \
                      *(LAS u32x4*)(sw_ + boff[j_]) = o_; } } \
                __builtin_amdgcn_sched_barrier(0); \
                if (VAR != 4 && VAR != 5) { const int tn_ = (tt + (s) + 2) < NT2 ? (tt + (s) + 2) : (NT2 - 1); MOE_LOADB((s), tn_); } \
                __syncthreads(); if (VAR != 2) MOE_COMPUTE(s); } while (0)
                for (int tt = 0; tt < NT2; tt += 2) { MOE_BSTEP(0); MOE_BSTEP(1); }
#undef MOE_BSTEP
#undef MOE_LOADB
            } else {
                unsigned arow[10]; const char* abase = (const char*)(GU ? H2 : WSP(bf16_t, WS_HBUF)); int ldst0;
                {
                    const int ta = t - 256, r0 = ta >> 3, p = ta & 7;
#pragma unroll
                    for (int i = 0; i < 10; ++i) { const int r = r0 + 32 * i, rr = r < rows ? r : rows - 1;
                        arow[i] = (unsigned)(GU ? ROWTOK[ps + m0 + rr] : (ps + m0 + rr)) * (unsigned)(LDA * 2) + (unsigned)((p ^ ((r0 >> 1) & 7)) * 16); }
                    ldst0 = (w - 4) * 8 * 128;
                }
#define MOE_GLDSA(st_, tile) do { _Pragma("unroll") for (int i_ = 0; i_ < 10; ++i_) \
                    __builtin_amdgcn_global_load_lds((const unsigned*)(abase + (size_t)((tile) * 128) + arow[i_]), (LAS unsigned*)(L + (st_) * STG + ldst0 + i_ * 4096), 16, 0, 0); } while (0)
                MOE_GLDSA(0, 0);
#define MOE_ASTEP(s) do { asm volatile("s_waitcnt vmcnt(0)" ::: "memory"); __syncthreads(); \
                if (VAR != 3 && VAR != 5) { const int tn_ = (tt + (s) + 1) < NT2 ? (tt + (s) + 1) : (NT2 - 1); MOE_GLDSA((s) ^ 1, tn_); } \
                if (VAR != 2) MOE_COMPUTE(s); } while (0)
                for (int tt = 0; tt < NT2; tt += 2) { MOE_ASTEP(0); MOE_ASTEP(1); }
                asm volatile("s_waitcnt vmcnt(0)" ::: "memory");
#undef MOE_ASTEP
#undef MOE_GLDSA
            }
#undef MOE_COMPUTE
#undef MOE_MM
#undef MOE_LDB
#undef MOE_LDA
            int te = threadIdx.x; asm volatile("" : "+v"(te));
            const int fr_e = te & 15, fq_e = (te >> 4) & 3, wr4_e = (te >> 7) & 3, wc2_e = (te >> 6) & 1;
#pragma unroll
            for (int m = 0; m < 5; ++m) {
                const int row = 80 * wr4_e + 16 * m + fr_e;
                if (row < rows) {
                    const int gpos = ps + m0 + row;
                    if (GU) {
#pragma unroll
                        for (int ns = 0; ns < 2; ++ns) { const f32x4 g = acc[m][ns], up = acc[m][ns + 2];
                            u32x2 o; o[0] = pk_bf16(g[0] * sigmoidf_(g[0]) * up[0], g[1] * sigmoidf_(g[1]) * up[1]); o[1] = pk_bf16(g[2] * sigmoidf_(g[2]) * up[2], g[3] * sigmoidf_(g[3]) * up[3]);
                            *(u32x2*)(HBUF + (size_t)gpos * 1024 + 64 * nti + 32 * wc2_e + 16 * ns + 4 * fq_e) = o; }
                    } else {
                        const int a = ROWMAP[gpos]; const float wt = ROWW[gpos];
#pragma unroll
                        for (int ns = 0; ns < 4; ++ns) { const f32x4 v = acc[m][ns];
                            u32x2 o; o[0] = pk_bf16(v[0] * wt, v[1] * wt); o[1] = pk_bf16(v[2] * wt, v[3] * wt);
                            *(u32x2*)(YBUF + (size_t)a * 2048 + 128 * nti + 64 * wc2_e + 16 * ns + 4 * fq_e) = o; }
                    }
                }
            }
        }
    }
    __syncthreads();
}

template <bool GU>
__device__ __forceinline__ void moe_gemm8(const Frame& F) {
    constexpr int K = GU ? 2048 : 1024, NT = K / 128, LDB = GU ? 1024 : 2048, LDAB = GU ? 2048 : 1024;
    constexpr int STG = 65536, BOFF = 49152;
    const int* PST = WSP(int, WS_PANEL); const int* ROWTOK = WSP(int, WS_ROWTOK); const int* ROWMAP = WSP(int, WS_ROWMAP); const float* ROWW = WSP(float, WS_ROWW);
    const unsigned char* H2 = WSP(unsigned char, WS_H2); unsigned char* HBUF = WSP(unsigned char, WS_HBUF); bf16_t* YBUF = WSP(bf16_t, WS_YBUF);
    LAS unsigned char* L = F.lds;
    const int nrounds = (NEXP * 16 + F.nb - 1) / F.nb;
    for (int rnd = 0; rnd < nrounds; ++rnd) {
        int unit;
        if ((F.nb & 127) == 0) { const int xcd = F.bid & 7, j = F.bid >> 3, epx = F.nb >> 7;
            unit = ((rnd * 8 + xcd) * epx + (j >> 4)) * 16 + (j & 15); }
        else unit = rnd * F.nb + F.bid;
        if (unit >= NEXP * 16) continue;
        const int e = unit >> 4, nti = unit & 15;
        const int ps = PST[e], Me = PST[e + 1] - ps;
        for (int m0 = 0; m0 < Me; m0 += 320) {
            const int rows = (Me - m0) < 320 ? (Me - m0) : 320;
            int tz = threadIdx.x; asm volatile("" : "+v"(tz));
            const int t = tz, w = __builtin_amdgcn_readfirstlane(tz >> 6), lane = tz & 63, fr = lane & 15, fq = lane >> 4, wr4 = (w >> 1) & 3, wc2 = w & 1;
            const bool bwave = w < 4;
            f32x4 acc[5][4];
#pragma unroll
            for (int m = 0; m < 5; ++m)
#pragma unroll
                for (int ns = 0; ns < 4; ++ns) acc[m][ns] = (f32x4){0.f, 0.f, 0.f, 0.f};
            int boffr[4];
#pragma unroll
            for (int ns = 0; ns < 4; ++ns) boffr[ns] = BOFF + (fq * 128 + moe_phys(64 * wc2 + 16 * ns + fr)) * 16;
            const int arow0 = 80 * wr4 + fr;
            const bool ga = (80 * wr4) < rows, gb = (80 * wr4 + 48) < rows;
#define M8_LDA(dst_, h_, n_, sb_, ks_) do { _Pragma("unroll") for (int q_ = 0; q_ < (n_); ++q_) { const int r_ = arow0 + 16 * ((h_) * 3 + q_); \
                dst_[q_] = *(const LAS v4i_t*)((sb_) + r_ * 128 + (((4 * (ks_) + fq) ^ ((r_ >> 1) & 7)) * 16)); } } while (0)
#define M8_LDB(dst_, sb_, ks_) do { _Pragma("unroll") for (int ns_ = 0; ns_ < 4; ++ns_) dst_[ns_] = *(const LAS v4i_t*)((sb_) + boffr[ns_] + (ks_) * (4 * 128 * 16)); } while (0)
#define M8_MM(bl_, bh_, al_, ah_, h_, n_) do { _Pragma("unroll") for (int q_ = 0; q_ < (n_); ++q_) _Pragma("unroll") for (int ns_ = 0; ns_ < 4; ++ns_) \
                acc[(h_) * 3 + q_][ns_] = __builtin_amdgcn_mfma_scale_f32_16x16x128_f8f6f4(__builtin_shufflevector(bl_[ns_], bh_[ns_], 0, 1, 2, 3, 4, 5, 6, 7), \
                    __builtin_shufflevector(al_[q_], ah_[q_], 0, 1, 2, 3, 4, 5, 6, 7), acc[(h_) * 3 + q_][ns_], 0, 0, 0, 0, 0, 0); } while (0)
#define M8_COMPUTE(st_) do { LAS unsigned char* sb_ = L + (st_) * STG; if (ga) { v4i_t b0_[4], b1_[4], a0_[3], a1_[3], c0_[2], c1_[2]; \
            M8_LDB(b0_, sb_, 0); M8_LDB(b1_, sb_, 1); M8_LDA(a0_, 0, 3, sb_, 0); M8_LDA(a1_, 0, 3, sb_, 1); __builtin_amdgcn_sched_barrier(0); \
            M8_LDA(c0_, 1, 2, sb_, 0); M8_LDA(c1_, 1, 2, sb_, 1); M8_MM(b0_, b1_, a0_, a1_, 0, 3); __builtin_amdgcn_sched_barrier(0); \
            if (gb) M8_MM(b0_, b1_, c0_, c1_, 1, 2); } } while (0)
#if MK_WSTREAM
            {
                (void)bwave;
                unsigned arow[5]; const char* abase = (const char*)(GU ? H2 : (const unsigned char*)HBUF);
                const unsigned char* wbase = (GU ? WSP(unsigned char, WS_W8GU) + (size_t)e * 4194304 + (size_t)nti * 262144 : WSP(unsigned char, WS_W8D) + (size_t)e * 2097152 + (size_t)nti * 131072) + w * 2048 + lane * 16;
                {
                    const int r0 = w * 8 + (lane >> 3), p = lane & 7;
#pragma unroll
                    for (int i = 0; i < 5; ++i) { const int r = r0 + 64 * i, rr = r < rows ? r : rows - 1;
                        arow[i] = (unsigned)(GU ? ROWTOK[ps + m0 + rr] : (ps + m0 + rr)) * (unsigned)LDAB + (unsigned)((p ^ ((r0 >> 1) & 7)) * 16); }
                }
#define M8_GLDS(st_, tile) do { _Pragma("unroll") for (int i_ = 0; i_ < 5; ++i_) \
                    __builtin_amdgcn_global_load_lds((const unsigned*)(abase + (size_t)((tile) * 128) + arow[i_]), (LAS unsigned*)(L + (st_) * STG + w * 1024 + i_ * 8192), 16, 0, 0); \
                _Pragma("unroll") for (int j_ = 0; j_ < 2; ++j_) \
                    __builtin_amdgcn_global_load_lds((const unsigned*)(wbase + (size_t)(tile) * 16384 + j_ * 1024), (LAS unsigned*)(L + (st_) * STG + BOFF + w * 2048 + j_ * 1024), 16, 0, 0); } while (0)
                M8_GLDS(0, 0);
#define M8_STEP(s) do { asm volatile("s_waitcnt vmcnt(0)" ::: "memory"); __syncthreads(); \
                { const int tn_ = (tt + (s) + 1) < NT ? (tt + (s) + 1) : (NT - 1); M8_GLDS((s) ^ 1, tn_); } \
                M8_COMPUTE(s); } while (0)
                for (int tt = 0; tt < NT; tt += 2) { M8_STEP(0); M8_STEP(1); }
                asm volatile("s_waitcnt vmcnt(0)" ::: "memory");
#undef M8_STEP
#undef M8_GLDS
            }
#else
            if (bwave) {
                int boff[4]; u32x4 stg[16]; const char* bbase; unsigned blane;
                {
                    int n4, kp, scol, isup = 0;
                    if (GU) { const int tg = t & 127; n4 = tg & 15; kp = tg >> 4; isup = w >> 1; scol = 64 * nti; bbase = (const char*)(F.in[isup ? 20 : 19] + (size_t)e * 2048 * 1024 + scol); }
                    else    { n4 = t & 31; kp = t >> 5; scol = 128 * nti; bbase = (const char*)(F.in[21] + (size_t)e * 1024 * 2048 + scol); }
                    blane = (unsigned)(((8 * kp) * LDB + 4 * n4) * 4);
#pragma unroll
                    for (int j = 0; j < 4; ++j) { const int g = 4 * n4 + j; const int s0 = GU ? (64 * (g >> 5) + (g & 31) + 32 * isup) : g;
                        boff[j] = BOFF + ((kp >> 1) * 128 + moe_phys(s0)) * 16 + 8 * (kp & 1); }
                }
#define M8_LOADB(tile) do { _Pragma("unroll") for (int h_ = 0; h_ < 2; ++h_) _Pragma("unroll") for (int i_ = 0; i_ < 8; ++i_) \
                    stg[h_ * 8 + i_] = *(const u32x4*)(bbase + ((size_t)(tile) * 128 + 64 * h_ + i_) * (LDB * 4) + blane); } while (0)
                M8_LOADB(0); __builtin_amdgcn_sched_barrier(0);
#define M8_BSTEP(s) do { LAS unsigned char* sw_ = L + (s) * STG; \
                _Pragma("unroll") for (int h_ = 0; h_ < 2; ++h_) { f32x4 b_[8]; _Pragma("unroll") for (int i_ = 0; i_ < 8; ++i_) b_[i_] = __builtin_bit_cast(f32x4, stg[h_ * 8 + i_]) * 64.f; \
                  _Pragma("unroll") for (int j_ = 0; j_ < 4; ++j_) { u32x2 o_; o_[0] = pk_fp8x4(b_[0][j_], b_[1][j_], b_[2][j_], b_[3][j_]); o_[1] = pk_fp8x4(b_[4][j_], b_[5][j_], b_[6][j_], b_[7][j_]); \
                      *(LAS u32x2*)(sw_ + boff[j_] + h_ * 8192) = o_; } } \
                __builtin_amdgcn_sched_barrier(0); \
                { const int tn_ = (tt + (s) + 1) < NT ? (tt + (s) + 1) : (NT - 1); M8_LOADB(tn_); } \
                __syncthreads(); M8_COMPUTE(s); } while (0)
                for (int tt = 0; tt < NT; tt += 2) { M8_BSTEP(0); M8_BSTEP(1); }
#undef M8_BSTEP
#undef M8_LOADB
            } else {
                unsigned arow[10]; const char* abase = (const char*)(GU ? H2 : (const unsigned char*)HBUF); int ldst0;
                {
                    const int ta = t - 256, r0 = ta >> 3, p = ta & 7;
#pragma unroll
                    for (int i = 0; i < 10; ++i) { const int r = r0 + 32 * i, rr = r < rows ? r : rows - 1;
                        arow[i] = (unsigned)(GU ? ROWTOK[ps + m0 + rr] : (ps + m0 + rr)) * (unsigned)LDAB + (unsigned)((p ^ ((r0 >> 1) & 7)) * 16); }
                    ldst0 = (w - 4) * 8 * 128;
                }
#define M8_GLDSA(st_, tile) do { _Pragma("unroll") for (int i_ = 0; i_ < 10; ++i_) \
                    __builtin_amdgcn_global_load_lds((const unsigned*)(abase + (size_t)((tile) * 128) + arow[i_]), (LAS unsigned*)(L + (st_) * STG + ldst0 + i_ * 4096), 16, 0, 0); } while (0)
                M8_GLDSA(0, 0);
#define M8_ASTEP(s) do { asm volatile("s_waitcnt vmcnt(0)" ::: "memory"); __syncthreads(); \
                { const int tn_ = (tt + (s) + 1) < NT ? (tt + (s) + 1) : (NT - 1); M8_GLDSA((s) ^ 1, tn_); } \
                M8_COMPUTE(s); } while (0)
                for (int tt = 0; tt < NT; tt += 2) { M8_ASTEP(0); M8_ASTEP(1); }
                asm volatile("s_waitcnt vmcnt(0)" ::: "memory");
#undef M8_ASTEP
#undef M8_GLDSA
            }
#endif
#undef M8_COMPUTE
#undef M8_MM
#undef M8_LDB
#undef M8_LDA
            int te = threadIdx.x; asm volatile("" : "+v"(te));
            const int fr_e = te & 15, fq_e = (te >> 4) & 3, wr4_e = (te >> 7) & 3, wc2_e = (te >> 6) & 1;
#pragma unroll
            for (int m = 0; m < 5; ++m) {
                const int row = 80 * wr4_e + 16 * m + fr_e;
                if (row < rows) {
                    const int gpos = ps + m0 + row;
                    if (GU) {
#pragma unroll
                        for (int ns = 0; ns < 2; ++ns) { const f32x4 g = acc[m][ns] * 0.015625f, up = acc[m][ns + 2] * 0.0625f;
                            *(unsigned*)(HBUF + (size_t)gpos * 1024 + 64 * nti + 32 * wc2_e + 16 * ns + 4 * fq_e) =
                                pk_fp8x4(g[0] * sigmoidf_(g[0]) * up[0], g[1] * sigmoidf_(g[1]) * up[1], g[2] * sigmoidf_(g[2]) * up[2], g[3] * sigmoidf_(g[3]) * up[3]); }
                    } else {
                        const int a = ROWMAP[gpos]; const float wt = ROWW[gpos] * 0.00390625f;
#pragma unroll
                        for (int ns = 0; ns < 4; ++ns) { const f32x4 v = acc[m][ns];
                            u32x2 o; o[0] = pk_bf16(v[0] * wt, v[1] * wt); o[1] = pk_bf16(v[2] * wt, v[3] * wt);
                            *(u32x2*)(YBUF + (size_t)a * 2048 + 128 * nti + 64 * wc2_e + 16 * ns + 4 * fq_e) = o; }
                    }
                }
            }
        }
    }
    __syncthreads();
}

template <bool GU>
__device__ __forceinline__ void moe_gemm8w(const Frame& F) {
    constexpr int K = GU ? 2048 : 1024, NT = K / 128, LDAB = GU ? 2048 : 1024;
    constexpr int STG = 65536, BOFF = 49152;
    const int* PST = WSP(int, WS_PANEL); const int* ROWTOK = WSP(int, WS_ROWTOK); const int* ROWMAP = WSP(int, WS_ROWMAP); const float* ROWW = WSP(float, WS_ROWW);
    const unsigned char* H2 = WSP(unsigned char, WS_H2); unsigned char* HBUF = WSP(unsigned char, WS_HBUF); bf16_t* YBUF = WSP(bf16_t, WS_YBUF);
    LAS unsigned char* L = F.lds;
    const int nrounds = (NEXP * 16 + F.nb - 1) / F.nb;
    const char* abase = (const char*)(GU ? H2 : (const unsigned char*)HBUF);
    int c_rnd = 0, c_m0 = 0;
#define M8_GET(ok_, e_, nti_, ps_, m0_, rows_) do { ok_ = false; for (;;) { if (c_rnd >= nrounds) break; int unit_; \
        if ((F.nb & 127) == 0) { const int xcd_ = F.bid & 7, j_ = F.bid >> 3, epx_ = F.nb >> 7; unit_ = ((c_rnd * 8 + xcd_) * epx_ + (j_ >> 4)) * 16 + (j_ & 15); } else unit_ = c_rnd * F.nb + F.bid; \
        if (unit_ >= NEXP * 16) { ++c_rnd; c_m0 = 0; continue; } \
        const int pe_ = PST[unit_ >> 4], me_ = PST[(unit_ >> 4) + 1] - pe_; if (c_m0 >= me_) { ++c_rnd; c_m0 = 0; continue; } \
        e_ = unit_ >> 4; nti_ = unit_ & 15; ps_ = pe_; m0_ = c_m0; rows_ = (me_ - c_m0) < 320 ? (me_ - c_m0) : 320; c_m0 += 320; ok_ = true; break; } } while (0)
#define M8_AROW(dst_, ps_, m0_, rows_) do { int tq_ = threadIdx.x; asm volatile("" : "+v"(tq_)); const int wq_ = __builtin_amdgcn_readfirstlane(tq_ >> 6), r0_ = wq_ * 8 + ((tq_ & 63) >> 3), p_ = tq_ & 7; \
        _Pragma("unroll") for (int i_ = 0; i_ < 5; ++i_) { const int r_ = r0_ + 64 * i_, rr_ = r_ < (rows_) ? r_ : (rows_) - 1; \
            dst_[i_] = (unsigned)(GU ? ROWTOK[(ps_) + (m0_) + rr_] : ((ps_) + (m0_) + rr_)) * (unsigned)LDAB + (unsigned)((p_ ^ ((r0_ >> 1) & 7)) * 16); } } while (0)
#define M8_WBASE(e_, nti_) ((GU ? WSP(unsigned char, WS_W8GU) + (size_t)(e_) * 4194304 + (size_t)(nti_) * 262144 : WSP(unsigned char, WS_W8D) + (size_t)(e_) * 2097152 + (size_t)(nti_) * 131072))
#define M8_GLDS(ar_, wb_, st_, tile) do { int tq_ = threadIdx.x; asm volatile("" : "+v"(tq_)); const int wq_ = __builtin_amdgcn_readfirstlane(tq_ >> 6); \
        _Pragma("unroll") for (int i_ = 0; i_ < 5; ++i_) \
            __builtin_amdgcn_global_load_lds((const unsigned*)(abase + (size_t)((tile) * 128) + ar_[i_]), (LAS unsigned*)(L + (st_) * STG + wq_ * 1024 + i_ * 8192), 16, 0, 0); \
        _Pragma("unroll") for (int j_ = 0; j_ < 2; ++j_) \
            __builtin_amdgcn_global_load_lds((const unsigned*)((wb_) + wq_ * 2048 + (tq_ & 63) * 16 + (size_t)(tile) * 16384 + j_ * 1024), (LAS unsigned*)(L + (st_) * STG + BOFF + wq_ * 2048 + j_ * 1024), 16, 0, 0); } while (0)
    bool hc; int e = 0, nti = 0, ps = 0, m0 = 0, rows = 1;
    M8_GET(hc, e, nti, ps, m0, rows);
    unsigned arow[5]; const unsigned char* wbase = nullptr;
    if (hc) { M8_AROW(arow, ps, m0, rows); wbase = M8_WBASE(e, nti); __syncthreads(); M8_GLDS(arow, wbase, 0, 0); }
    while (hc) {
        bool hn; int en = 0, ntin = 0, psn = 0, m0n = 0, rowsn = 1;
        M8_GET(hn, en, ntin, psn, m0n, rowsn);
        unsigned arown[5]; const unsigned char* wbasen = nullptr;
        if (hn) { M8_AROW(arown, psn, m0n, rowsn); wbasen = M8_WBASE(en, ntin); }
        {
            int tz = threadIdx.x; asm volatile("" : "+v"(tz));
            const int w = __builtin_amdgcn_readfirstlane(tz >> 6), lane = tz & 63, fr = lane & 15, fq = lane >> 4, wr4 = (w >> 1) & 3, wc2 = w & 1;
            f32x4 acc[5][4];
#pragma unroll
            for (int m = 0; m < 5; ++m)
#pragma unroll
                for (int ns = 0; ns < 4; ++ns) acc[m][ns] = (f32x4){0.f, 0.f, 0.f, 0.f};
            int boffr[4];
#pragma unroll
            for (int ns = 0; ns < 4; ++ns) boffr[ns] = BOFF + (fq * 128 + moe_phys(64 * wc2 + 16 * ns + fr)) * 16;
            const int arow0 = 80 * wr4 + fr;
            const bool ga = (80 * wr4) < rows, gb = (80 * wr4 + 48) < rows;
#define M8_LDA(dst_, h_, n_, sb_, ks_) do { _Pragma("unroll") for (int q_ = 0; q_ < (n_); ++q_) { const int r_ = arow0 + 16 * ((h_) * 3 + q_); \
                dst_[q_] = *(const LAS v4i_t*)((sb_) + r_ * 128 + (((4 * (ks_) + fq) ^ ((r_ >> 1) & 7)) * 16)); } } while (0)
#define M8_LDB(dst_, sb_, ks_) do { _Pragma("unroll") for (int ns_ = 0; ns_ < 4; ++ns_) dst_[ns_] = *(const LAS v4i_t*)((sb_) + boffr[ns_] + (ks_) * (4 * 128 * 16)); } while (0)
#define M8_MM(bl_, bh_, al_, ah_, h_, n_) do { _Pragma("unroll") for (int q_ = 0; q_ < (n_); ++q_) _Pragma("unroll") for (int ns_ = 0; ns_ < 4; ++ns_) \
                acc[(h_) * 3 + q_][ns_] = __builtin_amdgcn_mfma_scale_f32_16x16x128_f8f6f4(__builtin_shufflevector(bl_[ns_], bh_[ns_], 0, 1, 2, 3, 4, 5, 6, 7), \
                    __builtin_shufflevector(al_[q_], ah_[q_], 0, 1, 2, 3, 4, 5, 6, 7), acc[(h_) * 3 + q_][ns_], 0, 0, 0, 0, 0, 0); } while (0)
#define M8_COMPUTE(st_) do { LAS unsigned char* sb_ = L + (st_) * STG; if (ga) { v4i_t b0_[4], b1_[4], a0_[3], a1_[3], c0_[2], c1_[2]; \
            M8_LDB(b0_, sb_, 0); M8_LDB(b1_, sb_, 1); M8_LDA(a0_, 0, 3, sb_, 0); M8_LDA(a1_, 0, 3, sb_, 1); __builtin_amdgcn_sched_barrier(0); \
            M8_LDA(c0_, 1, 2, sb_, 0); M8_LDA(c1_, 1, 2, sb_, 1); M8_MM(b0_, b1_, a0_, a1_, 0, 3); __builtin_amdgcn_sched_barrier(0); \
            if (gb) M8_MM(b0_, b1_, c0_, c1_, 1, 2); } } while (0)
#define M8_STEP(s) do { asm volatile("s_waitcnt vmcnt(0)" ::: "memory"); __syncthreads(); \
            { const int tn_ = (tt + (s) + 1) < NT ? (tt + (s) + 1) : (NT - 1); M8_GLDS(arow, wbase, (s) ^ 1, tn_); } \
            M8_COMPUTE(s); } while (0)
            for (int tt = 0; tt < NT; tt += 2) { M8_STEP(0); M8_STEP(1); }
            asm volatile("s_waitcnt vmcnt(0)" ::: "memory");
#undef M8_STEP
#undef M8_COMPUTE
#undef M8_MM
#undef M8_LDB
#undef M8_LDA
            if (hn) { __builtin_amdgcn_sched_barrier(0); M8_GLDS(arown, wbasen, 0, 0); __builtin_amdgcn_sched_barrier(0); }
            int te = threadIdx.x; asm volatile("" : "+v"(te));
            const int fr_e = te & 15, fq_e = (te >> 4) & 3, wr4_e = (te >> 7) & 3, wc2_e = (te >> 6) & 1;
#pragma unroll
            for (int m = 0; m < 5; ++m) {
                const int row = 80 * wr4_e + 16 * m + fr_e;
                if (row < rows) {
                    const int gpos = ps + m0 + row;
                    if (GU) {
                        u32x2 o8;
#pragma unroll
                        for (int ns = 0; ns < 2; ++ns) { const f32x4 g = acc[m][ns] * 0.015625f, up = acc[m][ns + 2] * 0.0625f;
                            o8[ns] = pk_fp8x4(g[0] * sigmoidf_(g[0]) * up[0], g[1] * sigmoidf_(g[1]) * up[1], g[2] * sigmoidf_(g[2]) * up[2], g[3] * sigmoidf_(g[3]) * up[3]); }
                        *(u32x2*)(HBUF + (size_t)gpos * 1024 + 64 * nti + 32 * wc2_e + 8 * fq_e) = o8;
                    } else {
                        const int a = ROWMAP[gpos]; const float wt = ROWW[gpos] * 0.00390625f;
#pragma unroll
                        for (int nh = 0; nh < 2; ++nh) { const f32x4 v0 = acc[m][2 * nh], v1 = acc[m][2 * nh + 1];
                            u32x4 o; o[0] = pk_bf16(v0[0] * wt, v0[1] * wt); o[1] = pk_bf16(v0[2] * wt, v0[3] * wt); o[2] = pk_bf16(v1[0] * wt, v1[1] * wt); o[3] = pk_bf16(v1[2] * wt, v1[3] * wt);
                            *(u32x4*)(YBUF + (size_t)a * 2048 + 128 * nti + 64 * wc2_e + 32 * nh + 8 * fq_e) = o; }
                    }
                }
            }
        }
        hc = hn; e = en; nti = ntin; ps = psn; m0 = m0n; rows = rowsn; wbase = wbasen;
#pragma unroll
        for (int i = 0; i < 5; ++i) arow[i] = arown[i];
    }
#undef M8_GLDS
#undef M8_WBASE
#undef M8_AROW
#undef M8_GET
    __syncthreads();
}

__device__ __forceinline__ void p11_final(const Frame& F) {
    const float* X1 = DBG_ONLY_X ? F.in[0] : WSP(float, WS_X1); const float* mod = WSP(float, WS_MOD); const bf16_t* Y = WSP(bf16_t, WS_YBUF); const float* fg = F.in[22];
    for (int row = F.bid * 8 + F.wave; row < T; row += F.nb * 8) {
        const float* g2 = mod + (size_t)(row / SEQ) * 12288 + 5 * 2048;
        f32x4 v[8]; float ss = 0.f;
#pragma unroll
        for (int i = 0; i < 8; ++i) { const int col = (i * 64 + F.lane) * 4;
            const f32x4 xv = *(const f32x4*)(X1 + (size_t)row * D + col), gv = *(const f32x4*)(g2 + col);
#if DBG_NO_MOE
            const u32x2 y0 = (u32x2){0u, 0u}, y1 = y0; (void)Y;
#else
            const u32x2 y0 = *(const u32x2*)(Y + (size_t)(2 * row) * D + col), y1 = *(const u32x2*)(Y + (size_t)(2 * row + 1) * D + col);
#endif
            v[i] = (f32x4){xv[0] + gv[0] * (bf_lo(y0[0]) + bf_lo(y1[0])), xv[1] + gv[1] * (bf_hi(y0[0]) + bf_hi(y1[0])), xv[2] + gv[2] * (bf_lo(y0[1]) + bf_lo(y1[1])), xv[3] + gv[3] * (bf_hi(y0[1]) + bf_hi(y1[1]))};
            ss += v[i][0] * v[i][0] + v[i][1] * v[i][1] + v[i][2] * v[i][2] + v[i][3] * v[i][3]; }
        ss = wave_sum(ss);
        const float rs = rsqrtf(ss * (1.f / D) + EPS);
#pragma unroll
        for (int i = 0; i < 8; ++i) { const int col = (i * 64 + F.lane) * 4; const f32x4 g = *(const f32x4*)(fg + col);
            *(f32x4*)(F.out + (size_t)row * D + col) = (f32x4){v[i][0] * rs * g[0], v[i][1] * rs * g[1], v[i][2] * rs * g[2], v[i][3] * rs * g[3]}; }
    }
}

constexpr int N_PHASES = 12;
__global__ __launch_bounds__(512, 2) void mk_fwd(Args a) {
    extern __shared__ __attribute__((aligned(16))) unsigned char lds_raw[];
    Frame F;
    F.in = a.in; F.out = a.out; F.ws = a.ws; F.lds = (LAS unsigned char*)lds_raw;
    F.tid = threadIdx.x; F.lane = F.tid & 63; F.wave = __builtin_amdgcn_readfirstlane(F.tid >> 6); F.bid = blockIdx.x; F.nb = gridDim.x;
    const int lo = a.ph_lo, hi = a.ph_hi;
    XcdBarrier bar; bar.bar = (unsigned*)(a.ws + WS_CTL); bar.x = 0; bar.st = nullptr;
    if (hi - lo > 1) {
        if (F.tid == 0) *(LAS u32x4*)(F.lds + LDS_BAR_OFF) = (u32x4){0u, 0u, 0u, 0u};
        __syncthreads();
        bar = xcd_barrier_post((unsigned*)(a.ws + WS_CTL), (volatile LAS unsigned*)(F.lds + LDS_BAR_OFF));
    }
#define IN(k) (lo <= (k) && (k) < hi)
#define SEAM(k) do { if (IN(k) && IN((k) + 1)) xcd_barrier(bar); { int tz_ = threadIdx.x; asm volatile("" : "+v"(tz_)); F.tid = tz_; F.lane = tz_ & 63; } } while (0)
    pg8::WStream W{F.in[19], F.in[20], F.in[21], WSP(unsigned char, WS_W8GU), WSP(unsigned char, WS_W8D), 0, 0, 0};
    { const int per = (pg8::WS_STEPS + F.nb - 1) / F.nb; W.gs0 = F.bid * per; W.n = per; if (W.gs0 + W.n > pg8::WS_STEPS) W.n = pg8::WS_STEPS - W.gs0; if (W.n < 0) W.n = 0; if (!MK_WSTREAM) W.n = 0; W.n0 = W.n; }
#define WS_ADV(d_) do { int d__ = (d_); if (d__ > W.n) d__ = W.n; W.gs0 += d__; W.n -= d__; } while (0)
#define WS_CATCHUP(rem_) do { while (W.n > (rem_)) { f32x4 r_[4]; pg8::ws_issue(W, 0, r_); pg8::ws_flush(W, 0, r_); WS_ADV(1); } } while (0)
    if (IN(0)) { p0_mod_partials(F); p0_tables(F); p0_convert(F); if (DBG_DBL == 0) { p0_mod_partials(F); p0_tables(F); p0_convert(F); } }
    SEAM(0);
    if (IN(1)) { p1_norm1(F); if (DBG_DBL == 1) p1_norm1(F); }
    SEAM(1);
    if (IN(2)) {
        pg8::Gemm g{WSP(bf16_t, WS_ABF), WSP(bf16_t, WS_BTIN), MK_FP8_INPROJ ? 1024 : 2048};
        InProjOrder S; S.init(F.nb, F.bid);
        EpiInProj E{WSP(bf16_t, WS_QM), WSP(bf16_t, WS_OMS), WSP(bf16_t, WS_QA), WSP(bf16_t, WS_GBRS), WSP(bf16_t, WS_KM), WSP(bf16_t, WS_VM), WSP(bf16_t, WS_KA), WSP(bf16_t, WS_VAT), WSP(float, WS_GM), WSP(float, WS_ROPE), MK_FP8_INPROJ ? 0.015625f : 1.f};
#if MK_FP8_GATES && !MK_FP8_INPROJ
        { MaskOrder S2; S2.init(~MK_F8MASK & ((1ull << 53) - 1), ~MK_F8CTX & ((1ull << 53) - 1), F.nb, F.bid); const int d_ = pg8::gemm_phase<EpiInProj, MaskOrder, false, MK_WSTREAM != 0>(F.lds, g, S2, E, W); WS_ADV(d_); }
        { pg8::Gemm g8{WSP(bf16_t, WS_ABF8), WSP(bf16_t, WS_BTIN8), 1024}; MaskOrder S8; S8.init(MK_F8MASK, MK_F8CTX, F.nb, F.bid); EpiInProj E8 = E; E8.fs = 0.015625f;
          const int d_ = pg8::gemm_phase<EpiInProj, MaskOrder, true, MK_WSTREAM != 0>(F.lds, g8, S8, E8, W); WS_ADV(d_); }
        WS_CATCHUP(W.n0 / 4);
#else
        pg8::gemm_phase<EpiInProj, InProjOrder, MK_FP8_INPROJ != 0>(F.lds, g, S, E);
#endif
        if (DBG_DBL == 2) pg8::gemm_phase<EpiInProj, InProjOrder, MK_FP8_INPROJ != 0>(F.lds, g, S, E);
    }
    SEAM(2);
    if (IN(3)) { p3_mlstm(F); if (DBG_DBL == 30) p3_mlstm(F); p3_attn(F); if (DBG_DBL == 31) p3_attn(F); }
    SEAM(3);
    if (IN(4)) { p4_postmix(F); if (DBG_DBL == 4) p4_postmix(F); }
    SEAM(4);
    if (IN(5)) {
        pg8::StaticOrder S; S.init(T, 2048, F.nb, F.bid);
        { pg8::Gemm g{WSP(bf16_t, WS_AM), WSP(bf16_t, WS_BTBRM), MK_FP8_MIX ? 1024 : 2048}; EpiBr1 E{WSP(float, WS_TMP), WSP(bf16_t, WS_GBRS)}; const int d_ = pg8::gemm_phase<EpiBr1, pg8::StaticOrder, MK_FP8_MIX != 0, MK_WSTREAM != 0>(F.lds, g, S, E, W); WS_ADV(d_); }
        { pg8::Gemm g{WSP(bf16_t, WS_AO), WSP(bf16_t, WS_BTBRA), MK_FP8_MIX ? 1024 : 2048}; EpiBr2 E{WSP(float, WS_TMP), WSP(bf16_t, WS_GBRS), WSP(bf16_t, WS_AOUT)}; const int d_ = pg8::gemm_phase<EpiBr2, pg8::StaticOrder, MK_FP8_MIX != 0, MK_WSTREAM != 0>(F.lds, g, S, E, W); WS_ADV(d_); }
        if (DBG_DBL == 5) { { pg8::Gemm g{WSP(bf16_t, WS_AM), WSP(bf16_t, WS_BTBRM), MK_FP8_MIX ? 1024 : 2048}; EpiBr1 E{WSP(float, WS_TMP), WSP(bf16_t, WS_GBRS)}; pg8::gemm_phase<EpiBr1, pg8::StaticOrder, MK_FP8_MIX != 0>(F.lds, g, S, E); }
            { pg8::Gemm g{WSP(bf16_t, WS_AO), WSP(bf16_t, WS_BTBRA), MK_FP8_MIX ? 1024 : 2048}; EpiBr2 E{WSP(float, WS_TMP), WSP(bf16_t, WS_GBRS), WSP(bf16_t, WS_AOUT)}; pg8::gemm_phase<EpiBr2, pg8::StaticOrder, MK_FP8_MIX != 0>(F.lds, g, S, E); } }
    }
    SEAM(5);
    if (IN(6)) {
        pg8::StaticOrder S; S.init(T, 2048, F.nb, F.bid);
        pg8::Gemm g{WSP(bf16_t, WS_AOUT), WSP(bf16_t, WS_BTOUT), MK_FP8_MIX ? 1024 : 2048}; EpiOut E{F.in[0], WSP(float, WS_MOD), WSP(float, WS_X1), WSP(float, WS_RSS)}; { const int d_ = pg8::gemm_phase<EpiOut, pg8::StaticOrder, MK_FP8_MIX != 0, MK_WSTREAM != 0>(F.lds, g, S, E, W); WS_ADV(d_); }
        WS_CATCHUP(0);
        if (DBG_DBL == 6) pg8::gemm_phase<EpiOut, pg8::StaticOrder, MK_FP8_MIX != 0>(F.lds, g, S, E);
    }
    SEAM(6);
    if (IN(7)) { p7_norm2_router(F); if (DBG_DBL == 7) { for (int rep_ = 0; rep_ < 4; ++rep_) p7_norm2_router<true>(F); } }
    SEAM(7);
    if (IN(8)) { p8_lists(F); }
    SEAM(8);
    if (IN(9)) { if (MK_FP8_MOE && MK_WSTREAM) moe_gemm8w<true>(F); else if (MK_FP8_MOE) moe_gemm8<true>(F); else moe_gemm<true>(F); if (DBG_DBL == 9) moe_gemm<true>(F); if (DBG_DBL >= 92 && DBG_DBL <= 96) moe_gemm<true, DBG_DBL - 90>(F); }
    SEAM(9);
    if (IN(10)) { if (MK_FP8_MOE && MK_WSTREAM) moe_gemm8w<false>(F); else if (MK_FP8_MOE) moe_gemm8<false>(F); else moe_gemm<false>(F); if (DBG_DBL == 10) moe_gemm<false>(F); }
    SEAM(10);
    if (IN(11)) { p11_final(F); if (DBG_DBL == 11) p11_final(F); }
#undef IN
#undef SEAM
#undef WS_ADV
#undef WS_CATCHUP
}

extern "C" void kernel_launch(void* const* d_in, const int* in_sizes, int n_in, void* d_out, int out_size, void* d_ws, size_t ws_size, hipStream_t stream) {
    static int grid = 0;
    if (grid == 0) {
        if (n_in != 23 || out_size != T * D || ws_size < WS_END) { fprintf(stderr, "kernel_launch: unexpected problem (n_in %d, out %d, ws %zu < %zu)\n", n_in, out_size, ws_size, (size_t)WS_END); grid = -1; return; }
        int dev = 0, cus = 0, per_cu = 0;
        if (hipGetDevice(&dev) != hipSuccess || hipDeviceGetAttribute(&cus, hipDeviceAttributeMultiprocessorCount, dev) != hipSuccess) { grid = -1; return; }
        if (hipFuncSetAttribute((const void*)mk_fwd, hipFuncAttributeMaxDynamicSharedMemorySize, LDS_BYTES) != hipSuccess) { fprintf(stderr, "kernel_launch: hipFuncSetAttribute failed\n"); grid = -1; return; }
        if (hipOccupancyMaxActiveBlocksPerMultiprocessor(&per_cu, (const void*)mk_fwd, NT, LDS_BYTES) != hipSuccess || per_cu < 1) fprintf(stderr, "kernel_launch: occupancy query reports %d\n", per_cu);
        (void)hipGetLastError();
        grid = cus;
    }
    if (grid < 0) return;
    (void)hipMemsetAsync((char*)d_ws + WS_CTL, 0, CTL_BYTES, stream);
    Args a{};
    for (int i = 0; i < 23; ++i) a.in[i] = (const float*)d_in[i];
    a.out = (float*)d_out; a.ws = (unsigned char*)d_ws;
#if MK_ONE_LAUNCH
    a.ph_lo = 0; a.ph_hi = N_PHASES;
    hipLaunchKernelGGL(mk_fwd, dim3(grid), dim3(NT), LDS_BYTES, stream, a);
#else
    for (int p = 0; p < N_PHASES; ++p) { if (DBG_NO_MOE && p >= 7 && p <= 10) continue; if (DBG_ONLY_X && p != 1 && p != 0 && p != 11) continue; a.ph_lo = p; a.ph_hi = p + 1; hipLaunchKernelGGL(mk_fwd, dim3(grid), dim3(NT), LDS_BYTES, stream, a); }
#endif
}
```

```cpp
#include <hip/hip_runtime.h>
#include <stdint.h>
#include <stdio.h>

#define DBG_NO_MOE 0
#ifndef DBG_DBL
#define DBG_DBL -1
#endif
#define DBG_NO_ATTN 0
#define DBG_NO_STATE 0
#define DBG_ONLY_X 0
#ifndef MK_FP8_INPROJ
#define MK_FP8_INPROJ 0
#endif
#ifndef MK_FP8_MIX
#define MK_FP8_MIX 1
#endif
#ifndef MK_FP8_MOE
#define MK_FP8_MOE 1
#ifndef MK_WSTREAM
#define MK_WSTREAM 1
#endif
#ifndef MK_FP8_GATES
#define MK_FP8_GATES 1
#endif
#ifndef MK_F8MASK
#define MK_F8MASK 0x0000FF0FFFFFFFF0ull
#endif
#define MK_F8CTX 0ull
#endif
#ifndef MK_ONE_LAUNCH
#define MK_ONE_LAUNCH 1
#endif

#define LAS __attribute__((address_space(3)))
typedef unsigned short bf16_t;
typedef short bf16x8 __attribute__((ext_vector_type(8)));
typedef short bf16x4 __attribute__((ext_vector_type(4)));
typedef float f32x4 __attribute__((ext_vector_type(4)));
typedef unsigned u32x4 __attribute__((ext_vector_type(4)));
typedef unsigned u32x2 __attribute__((ext_vector_type(2)));

constexpr int D = 2048, NB = 4, SEQ = 2048, CTXL = 256, T = NB * SEQ, TC = NB * CTXL, TR = T + TC;
constexpr int MH = 8, MDQK = 128, MDV = 256;
constexpr int AH = 16, AKV = 4, ADH = 128;
constexpr int NEXP = 64, DEXP = 1024;
constexpr int INW = 13344, INWP = 13568;
constexpr float EPS = 1e-6f;
constexpr int NT = 512;

constexpr size_t al256(size_t x) { return (x + 255) & ~(size_t)255; }
constexpr size_t CTL_BYTES = 65536;
constexpr size_t WS_CTL = 0;
constexpr size_t CTL_CNT = 16384;
constexpr size_t WS_MODP = WS_CTL + CTL_BYTES;
constexpr size_t WS_MOD = WS_MODP + al256((size_t)32 * 5 * 12288 * 4);
constexpr size_t WS_ROPE = WS_MOD + al256((size_t)5 * 12288 * 4);
constexpr size_t WS_WRT = WS_ROPE + al256((size_t)2048 * 2 * 32 * 2 * 4);
constexpr int WRLD = 2048 + 64;
constexpr size_t WS_WRL = WS_WRT + (size_t)80 * WRLD * 2;
constexpr size_t WS_BTIN = WS_WRT + al256((size_t)2 * 80 * WRLD * 2);
constexpr size_t WS_BTBRM = WS_BTIN + al256((size_t)INWP * 2048 * 2);
constexpr size_t WS_BTBRA = WS_BTBRM + al256((size_t)2048 * 2048 * 2);
constexpr size_t WS_BTOUT = WS_BTBRA + al256((size_t)2048 * 2048 * 2);
constexpr size_t WS_BTGU = WS_BTOUT + al256((size_t)2048 * 2048 * 2);
constexpr size_t WS_ABF8 = WS_BTGU;
constexpr size_t WS_BTIN8 = WS_BTGU + al256((size_t)TR * 2048);
constexpr size_t WS_W8GU = WS_BTGU + ((size_t)64 << 20);
constexpr size_t WS_BTD = WS_BTGU + al256((size_t)NEXP * 2048 * 2048 * 2);
constexpr size_t WS_W8D = WS_BTD;
constexpr size_t WS_ABF = WS_BTD + al256((size_t)NEXP * 2048 * 1024 * 2);
constexpr size_t WS_QM = WS_ABF + al256((size_t)TR * 2048 * 2);
constexpr size_t WS_OMS = WS_QM + al256((size_t)T * 1024 * 2);
constexpr size_t WS_QA = WS_OMS + al256((size_t)T * 2048 * 2);
constexpr size_t WS_GBRS = WS_QA + al256((size_t)T * 2048 * 2);
constexpr size_t WS_KM = WS_GBRS + al256((size_t)T * 4096 * 2);
constexpr size_t WS_VM = WS_KM + al256((size_t)TR * 1024 * 2);
constexpr size_t WS_KA = WS_VM + al256((size_t)TR * 2048 * 2);
constexpr size_t WS_VAT = WS_KA + al256((size_t)TR * 512 * 2);
constexpr size_t WS_GM = WS_VAT + al256((size_t)512 * TR * 2);
constexpr size_t WS_HFB = WS_GM + al256((size_t)TR * 32 * 4);
constexpr size_t WS_AO = WS_HFB + al256((size_t)2 * T * 2048 * 2);
constexpr size_t WS_AM = WS_AO + al256((size_t)T * 2048 * 2);
constexpr size_t WS_TMP = WS_AM + al256((size_t)T * 2048 * 2);
constexpr size_t WS_AOUT = WS_TMP + al256((size_t)T * 2048 * 4);
constexpr size_t WS_X1 = WS_AOUT + al256((size_t)T * 2048 * 2);
constexpr size_t WS_H2 = WS_X1 + al256((size_t)T * 2048 * 4);
constexpr size_t WS_EID = WS_H2 + al256((size_t)T * 2048 * 2);
constexpr size_t WS_WTOP = WS_EID + al256((size_t)T * 2 * 4);
constexpr size_t WS_POS = WS_WTOP + al256((size_t)T * 2 * 4);
constexpr int XGROWS = 32768;
constexpr size_t WS_ROWMAP = WS_POS + al256((size_t)T * 2 * 4);
constexpr size_t WS_ROWW = WS_ROWMAP + al256((size_t)XGROWS * 4);
constexpr size_t WS_PANEL = WS_ROWW + al256((size_t)XGROWS * 4);
constexpr size_t WS_ROWTOK = WS_PANEL + al256(1024);
constexpr size_t WS_XG = WS_ROWTOK + al256((size_t)XGROWS * 4);
constexpr size_t WS_RSS = WS_XG + ((size_t)100 << 20);
constexpr size_t WS_HBUF = WS_XG + al256((size_t)XGROWS * 2048 * 2);
constexpr size_t WS_YBUF = WS_HBUF + al256((size_t)XGROWS * 1024 * 2);
constexpr size_t WS_END = WS_YBUF + al256((size_t)2 * T * 2048 * 2);

constexpr int LDS_STAGE = 131072;
constexpr int LDS_BAR_OFF = LDS_STAGE;
constexpr int LDS_TAB_OFF = LDS_STAGE + 64;
constexpr int LDS_PRE_OFF = LDS_STAGE + 4096;
constexpr int LDS_BYTES = LDS_PRE_OFF + 27648;

typedef float f32x2 __attribute__((ext_vector_type(2)));
typedef __bf16 bf16x2_t __attribute__((ext_vector_type(2)));
__device__ __forceinline__ unsigned pk_bf16(float lo, float hi) { const bf16x2_t v = __builtin_convertvector((f32x2){lo, hi}, bf16x2_t); return __builtin_bit_cast(unsigned, v); }
__device__ __forceinline__ unsigned pk_fp8x4(float a, float b, float c, float d) { int p = __builtin_amdgcn_cvt_pk_fp8_f32(a, b, 0, false); p = __builtin_amdgcn_cvt_pk_fp8_f32(c, d, p, true); return (unsigned)p; }
__device__ __forceinline__ float bf_lo(unsigned u) { return __uint_as_float(u << 16); }
__device__ __forceinline__ float bf_hi(unsigned u) { return __uint_as_float(u & 0xffff0000u); }
__device__ __forceinline__ float bf1(unsigned short h) { return __uint_as_float(((unsigned)h) << 16); }
__device__ __forceinline__ float sigmoidf_(float x) { return __builtin_amdgcn_rcpf(1.f + __expf(-x)); }
__device__ __forceinline__ float wave_sum(float v) {
#pragma unroll
    for (int d = 32; d >= 1; d >>= 1) v += __shfl_xor(v, d);
    return v;
}

#define XB_TMO      128
#define XB_XCNT(j)  (256  + 64 * (j))
#define XB_XSUB(j)  (1280 + 64 * (j))
#define XB_XGEN(j)  (2304 + 64 * (j))
#define XB_TOP      3328
#define XB_TOPGEN   3392
#define XCD_BAR_WORDS 3456
#define XB_SPIN_CAP (1u << 18)

__device__ __forceinline__ unsigned xb_ld(unsigned* p)              { return __hip_atomic_load(p, __ATOMIC_RELAXED, __HIP_MEMORY_SCOPE_AGENT); }
__device__ __forceinline__ unsigned xb_add(unsigned* p, unsigned v) { return __hip_atomic_fetch_add(p, v, __ATOMIC_RELAXED, __HIP_MEMORY_SCOPE_AGENT); }
__device__ __forceinline__ unsigned xb_xcc_id() { return (unsigned)__builtin_amdgcn_s_getreg((3 << 11) | 20) & 0xFu; }
#define XB_SPIN(cond, bar) do { unsigned _sp = 0; while (cond) { __builtin_amdgcn_s_sleep(1); \
    if ((++_sp & 255u) == 0u) { if (xb_ld(&(bar)[XB_TMO])) break; if (_sp > XB_SPIN_CAP) { atomicAdd(&(bar)[XB_TMO], 1u); break; } } } } while (0)

struct XcdBarrier { unsigned* bar; unsigned x; volatile LAS unsigned* st; };

__device__ __forceinline__ XcdBarrier xcd_barrier_post(unsigned* bar, volatile LAS unsigned* st) {
    XcdBarrier b; b.bar = bar; b.x = xb_xcc_id(); b.st = st;
    if (threadIdx.x == 0) (void)xb_add(&bar[XB_XCNT(b.x)], 1u);
    return b;
}
__device__ __forceinline__ void xcd_barrier_complete(unsigned* bar, unsigned x, unsigned& nloc, unsigned& nx) {
    const unsigned G = gridDim.x * gridDim.y * gridDim.z;
    unsigned sum, cnt, mine, sp = 0u;
    for (;;) {
        sum = 0u; cnt = 0u; mine = 0u;
#pragma unroll
        for (unsigned j = 0; j < 16; ++j) { const unsigned c = xb_ld(&bar[XB_XCNT(j)]); sum += c; cnt += (c > 0u) ? 1u : 0u; mine = (j == x) ? c : mine; }
        if (sum == G) break;
        __builtin_amdgcn_s_sleep(1);
        if ((++sp & 255u) == 0u) { if (xb_ld(&bar[XB_TMO])) break; if (sp > XB_SPIN_CAP) { atomicAdd(&bar[XB_TMO], 1u); break; } }
    }
    nloc = mine > 0u ? mine : 1u; nx = cnt > 0u ? cnt : 1u;
}
__device__ __forceinline__ void xcd_barrier(const XcdBarrier& b) {
    asm volatile("s_waitcnt vmcnt(0)" ::: "memory");
    __syncthreads();
    if (threadIdx.x == 0) {
        unsigned* bar = b.bar;
        __builtin_amdgcn_s_waitcnt(0);
        unsigned nloc = b.st[0], nx = b.st[1];
        if (nloc == 0u) { xcd_barrier_complete(bar, b.x, nloc, nx); b.st[0] = nloc; b.st[1] = nx; }
        const unsigned old = xb_add(&bar[XB_XSUB(b.x)], 1u);
        const unsigned gen = old / nloc;
        if (old + 1u == (gen + 1u) * nloc) {
            __builtin_amdgcn_fence(__ATOMIC_RELEASE, "agent");
            asm volatile("s_waitcnt vmcnt(0)" ::: "memory");
            const unsigned og = xb_add(&bar[XB_TOP], 1u);
            const unsigned tg = og / nx;
            if (og + 1u == (tg + 1u) * nx) xb_add(&bar[XB_TOPGEN], 1u);
            else XB_SPIN(xb_ld(&bar[XB_TOPGEN]) == tg, bar);
            __builtin_amdgcn_fence(__ATOMIC_ACQUIRE, "agent");
            xb_add(&bar[XB_XGEN(b.x)], 1u);
            asm volatile("s_waitcnt vmcnt(0)" ::: "memory");
        } else {
            XB_SPIN(xb_ld(&bar[XB_XGEN(b.x)]) == gen, bar);
            __builtin_amdgcn_fence(__ATOMIC_ACQUIRE, "agent");
            asm volatile("s_waitcnt vmcnt(0)" ::: "memory");
        }
    }
    __syncthreads();
}

namespace pg8 {
constexpr int BM = 256, BK = 64, HALF = 128, HTB = HALF * BK * 2, STAGE_BYTES = 8 * HTB, NXCD = 8, WGM = 8;
__device__ __forceinline__ int lds_byte(int r, int c) { const int st = (r >> 4) * 2 + (c >> 5), rr = r & 15, cc = c & 31, ob = rr * 64 + cc * 2; return st * 1024 + (ob ^ (((ob >> 9) & 1) << 5)); }
__device__ __forceinline__ void stage_rc(int b, int& R, int& C) { const int st = b / 1024, sb = b % 1024, swz = sb ^ (((sb >> 9) & 1) << 5); R = (st >> 1) * 16 + swz / 64; C = (st & 1) * 32 + (swz % 64) / 2; }
struct Unit { int pm, pn; };
struct Gemm { const bf16_t* A; const bf16_t* Bt; int K; };

typedef int v8i_t __attribute__((ext_vector_type(8)));
typedef int v4i_t __attribute__((ext_vector_type(4)));

constexpr int WS_STEPS = 3 * 16384;
struct WStream { const float* src0; const float* src1; const float* src2; unsigned char* dgu; unsigned char* dd; int gs0, n, n0; };
__device__ __forceinline__ int ws_gs(const WStream& W, int s) { int g = W.gs0 + (s < W.n ? s : W.n - 1); g = g < WS_STEPS ? g : WS_STEPS - 1; return g > 0 ? g : 0; }
__device__ __forceinline__ void ws_issue(const WStream& W, int s, f32x4 (&r)[4]) {
    int tz = threadIdx.x; asm volatile("" : "+v"(tz));
    const int gs = ws_gs(W, s), mat = gs >> 14, q = gs & 16383, e = q >> 8;
    const int sh = (mat == 2) ? 13 : 12;
    const int rg = (mat == 2) ? ((q >> 2) & 63) : ((q >> 1) & 127), part = (mat == 2) ? (q & 3) : (q & 1);
    const float* base = mat == 0 ? W.src0 : (mat == 1 ? W.src1 : W.src2);
    const char* ub = (const char*)base + (size_t)e * 8388608 + ((size_t)(rg * 16) << sh) + (size_t)(part * 2048);
    const unsigned voff = ((unsigned)((tz >> 4) & 3) << (sh + 2)) + (unsigned)(tz >> 6) * 256u + (unsigned)(tz & 15) * 16u;
#pragma unroll
    for (int i = 0; i < 4; ++i) r[i] = __builtin_nontemporal_load((const f32x4*)(ub + voff + ((size_t)i << sh)));
}
__device__ __forceinline__ void ws_flush(const WStream& W, int s, const f32x4 (&r)[4]) {
    int tz = threadIdx.x; asm volatile("" : "+v"(tz));
    const int gs = ws_gs(W, s), mat = gs >> 14, q = gs & 16383, e = q >> 8;
    const int rg = (mat == 2) ? ((q >> 2) & 63) : ((q >> 1) & 127), part = (mat == 2) ? (q & 3) : (q & 1);
    unsigned d[4];
#pragma unroll
    for (int j = 0; j < 4; ++j) d[j] = pk_fp8x4(r[0][j] * 64.f, r[1][j] * 64.f, r[2][j] * 64.f, r[3][j] * 64.f);
    const auto a = __builtin_amdgcn_permlane32_swap(d[0], d[2], false, false); const auto b = __builtin_amdgcn_permlane32_swap(d[1], d[3], false, false);
    const auto c = __builtin_amdgcn_permlane16_swap(a[0], b[0], false, false); const auto f = __builtin_amdgcn_permlane16_swap(a[1], b[1], false, false);
    const u32x4 o = (u32x4){c[0], c[1], f[0], f[1]};
    const int w = tz >> 6, g = 4 * (tz & 15) + ((tz >> 4) & 3);
    unsigned char* ub; int slot;
    const int gp = (g & 32) + 16 * ((g >> 2) & 1) + 4 * ((g & 31) >> 3) + (g & 3);
    if (mat == 2) { ub = W.dd + (size_t)e * 2097152 + (size_t)((part * 4) * 131072 + rg * 2048); slot = (w & 1) * 64 + gp; ub += (size_t)(w >> 1) * 131072; }
    else          { ub = W.dgu + (size_t)e * 4194304 + (size_t)((part * 8) * 262144 + rg * 2048); slot = 64 * (gp >> 5) + (gp & 31) + 32 * mat; ub += (size_t)w * 262144; }
    *(u32x4*)(ub + (unsigned)((slot ^ ((slot >> 3) & 3)) * 16)) = o;
}
template <class Epi, class Sched, bool FP8 = false, bool STRM = false>
__device__ __forceinline__ int gemm_phase(LAS unsigned char* lds, const Gemm g, const Sched& S, const Epi& E, const WStream W = WStream{}) {
    const int tid = threadIdx.x, wid = __builtin_amdgcn_readfirstlane(tid >> 6), lane = tid & 63, wr = wid >> 2, wc = wid & 3, fr = lane & 15, fq = lane >> 4;
    const int K = g.K, nt = K / BK;
    unsigned voffA[2];
#pragma unroll
    for (int i = 0; i < 2; ++i) { int R, C; stage_rc(tid * 16 + i * 8192, R, C); voffA[i] = (unsigned)(R * K + C) * 2u; }
    const size_t kstep = (size_t)(BK * 2);
    const size_t hstep = (size_t)HALF * K * 2;
    const size_t tstep = 2 * hstep;
    const unsigned ldsw = (unsigned)wid * 1024u;
    const int aoff = lds_byte(wr * 64 + fr, fq * 8), boff = lds_byte(wc * 32 + fr, fq * 8);
    const __amdgpu_buffer_rsrc_t rsA = __builtin_amdgcn_make_buffer_rsrc((void*)g.A, 0, 0x7fffffff, 0x00020000), rsB = __builtin_amdgcn_make_buffer_rsrc((void*)g.Bt, 0, 0x7fffffff, 0x00020000);
#define PG8_SA(b, h) (((b) * 2 + (h)) * HTB)
#define PG8_SB(b, h) ((4 + (b) * 2 + (h)) * HTB)
#define PG8_STAGE_X(rs_, base_, bufoff, gbase, voff) do { const unsigned so_ = (unsigned)((const char*)(gbase) - (const char*)(base_)); _Pragma("unroll") for (int _i = 0; _i < 2; ++_i) \
        __builtin_amdgcn_raw_ptr_buffer_load_lds(rs_, (LAS void*)(lds + (bufoff) + ldsw + _i * 8192), 16, (int)(voff)[_i], (int)so_, 0, 0); } while (0)
#define PG8_STAGE(bufoff, gbase, voff) do { if ((bufoff) >= 4 * HTB) PG8_STAGE_X(rsB, g.Bt, bufoff, gbase, voff); else PG8_STAGE_X(rsA, g.A, bufoff, gbase, voff); } while (0)
#define PG8_LDA(dst, b, h) do { _Pragma("unroll") for (int m = 0; m < 4; ++m) _Pragma("unroll") for (int k = 0; k < 2; ++k) dst[m][k] = *(const LAS bf16x8*)(lds + PG8_SA(b, h) + aoff + m * 2048 + k * 1024); } while (0)
#define PG8_LDB(dst, b, h) do { _Pragma("unroll") for (int n = 0; n < 2; ++n) _Pragma("unroll") for (int k = 0; k < 2; ++k) dst[n][k] = *(const LAS bf16x8*)(lds + PG8_SB(b, h) + boff + n * 2048 + k * 1024); } while (0)
#define PG8_MMA(ai, bj, At, Bt) do { __builtin_amdgcn_s_setprio(1); _Pragma("unroll") for (int m = 0; m < 4; ++m) _Pragma("unroll") for (int n = 0; n < 2; ++n) { \
        if (FP8) { const v8i_t bb_ = __builtin_shufflevector(__builtin_bit_cast(v4i_t, Bt[n][0]), __builtin_bit_cast(v4i_t, Bt[n][1]), 0, 1, 2, 3, 4, 5, 6, 7); \
            const v8i_t aa_ = __builtin_shufflevector(__builtin_bit_cast(v4i_t, At[m][0]), __builtin_bit_cast(v4i_t, At[m][1]), 0, 1, 2, 3, 4, 5, 6, 7); \
            acc[ai][bj][m][n] = __builtin_amdgcn_mfma_scale_f32_16x16x128_f8f6f4(bb_, aa_, acc[ai][bj][m][n], 0, 0, 0, 0, 0, 0); } \
        else { _Pragma("unroll") for (int k = 0; k < 2; ++k) acc[ai][bj][m][n] = __builtin_amdgcn_mfma_f32_16x16x32_bf16(Bt[n][k], At[m][k], acc[ai][bj][m][n], 0, 0, 0); } } \
        __builtin_amdgcn_s_setprio(0); } while (0)
#define PG8_WAIT_V(n) asm volatile("s_waitcnt vmcnt(" #n ")" ::: "memory")
#define PG8_WAIT_L(n) asm volatile("s_waitcnt lgkmcnt(" #n ")" ::: "memory")
#define PG8_BAR __builtin_amdgcn_s_barrier()
#define PG8_SCHED __builtin_amdgcn_sched_barrier(0)
    Unit cur, nxt; int ui = 0;
    if (!S.next(0, cur)) return 0;
    f32x4 acc[2][2][4][2];
#pragma unroll
    for (int a = 0; a < 2; ++a)
#pragma unroll
        for (int b = 0; b < 2; ++b)
#pragma unroll
            for (int m = 0; m < 4; ++m)
#pragma unroll
                for (int n = 0; n < 2; ++n) acc[a][b][m][n] = (f32x4){0.f, 0.f, 0.f, 0.f};
    bf16x8 At[4][2], B0[2][2], B1[2][2];
    f32x4 wsA[4], wsB[4]; int sstep = 0;
    if (STRM) { ws_issue(W, 0, wsB); PG8_SCHED; }
    const char* cA = (const char*)g.A + (size_t)cur.pm * tstep; const char* cB = (const char*)g.Bt + (size_t)cur.pn * tstep;
    PG8_STAGE(PG8_SB(0, 0), cB, voffA); PG8_STAGE(PG8_SA(0, 0), cA, voffA); PG8_STAGE(PG8_SB(0, 1), cB + hstep, voffA); PG8_STAGE(PG8_SA(0, 1), cA + hstep, voffA);
    if (wr == 1) PG8_BAR;
    PG8_WAIT_V(4); PG8_BAR;
    PG8_STAGE(PG8_SB(1, 0), cB + kstep, voffA); PG8_STAGE(PG8_SA(1, 0), cA + kstep, voffA); PG8_STAGE(PG8_SB(1, 1), cB + hstep + kstep, voffA);
    PG8_WAIT_V(6); PG8_BAR;
    for (;;) {
        const bool has_next = S.next(ui + 1, nxt);
        const char* nA = has_next ? (const char*)g.A + (size_t)nxt.pm * tstep : cA; const char* nB = has_next ? (const char*)g.Bt + (size_t)nxt.pn * tstep : cB;
        for (int t = 0; t < nt; t += 2) {
            const bool last = (t == nt - 2);
            const char* a1 = cA + (size_t)(t + 1) * kstep;
            const char* a2 = last ? nA : cA + (size_t)(t + 2) * kstep; const char* b2 = last ? nB : cB + (size_t)(t + 2) * kstep;
            const char* a3 = a2 + kstep; const char* b3 = b2 + kstep;
            PG8_LDB(B0, 0, 0); PG8_SCHED; PG8_LDA(At, 0, 0); PG8_STAGE(PG8_SA(1, 1), a1 + hstep, voffA);
            if (STRM) { PG8_SCHED; ws_issue(W, sstep + 1, wsA); PG8_SCHED; }
            PG8_WAIT_L(8); PG8_BAR; PG8_WAIT_L(0); PG8_MMA(0, 0, At, B0); PG8_BAR; PG8_SCHED;
            PG8_LDB(B1, 0, 1); PG8_STAGE(PG8_SB(0, 0), b2, voffA);
            PG8_BAR; PG8_WAIT_L(0); PG8_MMA(0, 1, At, B1); PG8_BAR;
            PG8_LDA(At, 0, 1); PG8_STAGE(PG8_SA(0, 0), a2, voffA);
            PG8_BAR; PG8_WAIT_L(0); PG8_MMA(1, 0, At, B0); PG8_BAR; PG8_SCHED;
            PG8_STAGE(PG8_SB(0, 1), b2 + hstep, voffA);
            if (STRM) PG8_WAIT_V(10); else PG8_WAIT_V(6);
            PG8_BAR; PG8_MMA(1, 1, At, B1); if (STRM) { ws_flush(W, sstep, wsB); PG8_SCHED; } PG8_BAR;
            PG8_LDB(B0, 1, 0); PG8_SCHED; PG8_LDA(At, 1, 0); PG8_STAGE(PG8_SA(0, 1), a2 + hstep, voffA);
            if (STRM) { PG8_SCHED; ws_issue(W, sstep + 2, wsB); PG8_SCHED; }
            PG8_WAIT_L(8); PG8_BAR; PG8_WAIT_L(0); PG8_MMA(0, 0, At, B0); PG8_BAR; PG8_SCHED;
            PG8_LDB(B1, 1, 1); PG8_STAGE(PG8_SB(1, 0), b3, voffA);
            PG8_BAR; PG8_WAIT_L(0); PG8_MMA(0, 1, At, B1); PG8_BAR;
            PG8_LDA(At, 1, 1); PG8_STAGE(PG8_SA(1, 0), a3, voffA);
            PG8_BAR; PG8_WAIT_L(0); PG8_MMA(1, 0, At, B0); PG8_BAR; PG8_SCHED;
            PG8_STAGE(PG8_SB(1, 1), b3 + hstep, voffA);
            if (STRM) PG8_WAIT_V(10); else PG8_WAIT_V(6);
            PG8_BAR; PG8_MMA(1, 1, At, B1); if (STRM) { ws_flush(W, sstep + 1, wsA); PG8_SCHED; sstep += 2; } PG8_BAR;
        }
        { int tz = threadIdx.x; asm volatile("" : "+v"(tz));
          const int wid2 = __builtin_amdgcn_readfirstlane(tz >> 6), lane2 = tz & 63; E(acc, cur, wid2 >> 2, wid2 & 3, lane2 & 15, lane2 >> 4); }
        if (!has_next) break;
#pragma unroll
        for (int a = 0; a < 2; ++a)
#pragma unroll
            for (int b = 0; b < 2; ++b)
#pragma unroll
                for (int m = 0; m < 4; ++m)
#pragma unroll
                    for (int n = 0; n < 2; ++n) acc[a][b][m][n] = (f32x4){0.f, 0.f, 0.f, 0.f};
        cur = nxt; cA = nA; cB = nB; ++ui;
    }
    PG8_WAIT_V(0);
    if (wr == 0) PG8_BAR;
    PG8_BAR;
    if (STRM) { ws_flush(W, sstep, wsB); ++sstep; }
#undef PG8_SA
#undef PG8_SB
#undef PG8_STAGE
#undef PG8_LDA
#undef PG8_LDB
#undef PG8_MMA
#undef PG8_WAIT_V
#undef PG8_WAIT_L
#undef PG8_BAR
#undef PG8_SCHED
    return sstep;
}

struct StaticOrder {
    int nM, nN, nwg, G, c;
    __device__ void init(int M, int N, int G_, int c_) { nM = M / BM; nN = N / BM; nwg = nM * nN; G = G_; c = c_; }
    __device__ bool map(long L, Unit& u) const {
        if (L >= nwg) return false;
        int wgid = (int)L; { const int q = nwg / NXCD, r = nwg % NXCD, xcd = wgid % NXCD, off = wgid / NXCD; wgid = (xcd < r ? xcd * (q + 1) : r * (q + 1) + (xcd - r) * q) + off; }
        const int nig = WGM * nN, gid = wgid / nig, fm = gid * WGM, gsz = (nM - fm) < WGM ? (nM - fm) : WGM;
        u.pm = fm + ((wgid % nig) % gsz); u.pn = (wgid % nig) / gsz; return true;
    }
    __device__ bool next(int i, Unit& u) const { return map((long)i * G + c, u); }
};
}
using pg8::Unit; using pg8::v4i_t; using pg8::v8i_t;

struct Args {
    const float* in[23];
    float* out;
    unsigned char* ws;
    int ph_lo, ph_hi;
};
struct Frame {
    const float* const* in;
    float* out; unsigned char* ws;
    LAS unsigned char* lds;
    int tid, lane, wave, bid, nb;
};
#define WSP(T_, off) ((T_*)(F.ws + (off)))

__device__ __forceinline__ void p0_mod_partials(const Frame& F) {
    const float* c = F.in[1]; const float* c_ctx = F.in[3]; const float* w_mod = F.in[4];
    float* modp = WSP(float, WS_MODP);
    LAS float* s = (LAS float*)(F.lds);
    LAS float* red = (LAS float*)(F.lds + 8192);
    const int t = F.tid, cg = t % 96, kq = t / 96;
    for (int idx = F.bid; idx < 32 * 8; idx += F.nb) {
        const int ct = idx & 31, ks = idx >> 5;
        __syncthreads();
        for (int i = t; i < 1280; i += NT) { const int r = i >> 8, kk = i & 255; const float cv = (r < 4) ? c[r * D + ks * 256 + kk] : c_ctx[ks * 256 + kk]; s[i] = cv / (1.f + __expf(-cv)); }
        __syncthreads();
        if (kq < 4) {
            float acc[5][4];
#pragma unroll
            for (int r = 0; r < 5; ++r)
#pragma unroll
                for (int e = 0; e < 4; ++e) acc[r][e] = 0.f;
            const float* wp = w_mod + (size_t)(ks * 256 + kq * 64) * 12288 + ct * 384 + cg * 4;
#pragma unroll 16
            for (int i = 0; i < 64; ++i) {
                const f32x4 w = *(const f32x4*)(wp + (size_t)i * 12288);
#pragma unroll
                for (int r = 0; r < 5; ++r) { const float sv = s[r * 256 + kq * 64 + i];
#pragma unroll
                    for (int e = 0; e < 4; ++e) acc[r][e] += sv * w[e]; }
            }
#pragma unroll
            for (int r = 0; r < 5; ++r) *(LAS f32x4*)(red + (kq * 5 + r) * 384 + cg * 4) = (f32x4){acc[r][0], acc[r][1], acc[r][2], acc[r][3]};
        }
        __syncthreads();
        if (t < 384) {
#pragma unroll
            for (int r = 0; r < 5; ++r) { float v = 0.f;
#pragma unroll
                for (int q = 0; q < 4; ++q) v += red[(q * 5 + r) * 384 + t];
                modp[((size_t)ks * 5 + r) * 12288 + ct * 384 + t] = v; }
        }
    }
    __syncthreads();
}

__device__ __forceinline__ void cvt_tile(const Frame& F, const float* src, int ld, int width, int perm, bf16_t* dst, int Kd) {
    constexpr int LDT = 136;
    LAS unsigned char* Tt = F.lds;
    const int t = F.tid, n4 = t & 31, kp = t >> 5;
    const bool valid = (4 * n4) < width;
#pragma unroll
    for (int pass = 0; pass < 4; ++pass) {
        const int k = pass * 32 + 2 * kp;
        f32x4 a = (f32x4){0.f, 0.f, 0.f, 0.f}, b = a;
        if (valid) { a = *(const f32x4*)(src + (size_t)k * ld + 4 * n4); b = *(const f32x4*)(src + (size_t)(k + 1) * ld + 4 * n4); }
#pragma unroll
        for (int e = 0; e < 4; ++e) {
            const int nl = 4 * n4 + e;
            const int p1_ = (perm & 1) ? (64 * (nl >> 6) + 2 * (nl & 31) + ((nl >> 5) & 1)) : nl;
            const int prow = (perm & 2) ? ((p1_ & ~31) + 16 * ((p1_ >> 2) & 1) + 4 * ((p1_ & 31) >> 3) + (p1_ & 3)) : p1_;
            const int pc = (k >> 3) ^ ((prow >> 2) & 15);
            *(LAS unsigned*)(Tt + prow * (LDT * 2) + pc * 16 + (k & 7) * 2) = pk_bf16(a[e], b[e]);
        }
    }
    __syncthreads();
#pragma unroll
    for (int i = 0; i < 4; ++i) {
        const int id = t + 512 * i, row = id >> 4, pc = id & 15;
        const u32x4 v = *(const LAS u32x4*)(Tt + row * (LDT * 2) + ((pc ^ ((row >> 2) & 15)) * 16));
        *(u32x4*)(dst + (size_t)row * Kd + pc * 8) = v;
    }
    __syncthreads();
}

__device__ __forceinline__ void cvt_tile8(const Frame& F, const float* src, int ld, int width, int perm, unsigned char* dst, int Kd) {
    constexpr int LDT = 144;
    LAS unsigned char* Tt = F.lds;
    const int t = F.tid, n4 = t & 31, kp = t >> 5;
    const bool valid = (4 * n4) < width;
#pragma unroll
    for (int pass = 0; pass < 4; ++pass) {
        const int k = pass * 32 + 2 * kp;
        f32x4 a = (f32x4){0.f, 0.f, 0.f, 0.f}, b = a;
        if (valid) { a = *(const f32x4*)(src + (size_t)k * ld + 4 * n4); b = *(const f32x4*)(src + (size_t)(k + 1) * ld + 4 * n4); }
#pragma unroll
        for (int e = 0; e < 4; ++e) {
            const int nl = 4 * n4 + e;
            const int p1_ = (perm & 1) ? (64 * (nl >> 6) + 2 * (nl & 31) + ((nl >> 5) & 1)) : nl;
            const int prow = (perm & 2) ? ((p1_ & ~31) + 16 * ((p1_ >> 2) & 1) + 4 * ((p1_ & 31) >> 3) + (p1_ & 3)) : p1_;
            const int pc = (k >> 4) ^ ((prow >> 2) & 7);
            *(LAS unsigned short*)(Tt + prow * LDT + pc * 16 + (k & 15)) = (unsigned short)(__builtin_amdgcn_cvt_pk_fp8_f32(a[e] * 64.f, b[e] * 64.f, 0, false) & 0xffff);
        }
    }
    __syncthreads();
#pragma unroll
    for (int i = 0; i < 2; ++i) {
        const int id = t + 512 * i, row = id >> 3, pc = id & 7;
        const u32x4 v = *(const LAS u32x4*)(Tt + row * LDT + ((pc ^ ((row >> 2) & 7)) * 16));
        *(u32x4*)(dst + (size_t)row * Kd + pc * 16) = v;
    }
    __syncthreads();
}

__device__ __forceinline__ void p0_convert(const Frame& F) {
    const float* w_in = F.in[7];
    bf16_t* btin = WSP(bf16_t, WS_BTIN);
    const int J0 = 106 * 16, J1 = J0 + 3 * 256;
    for (int job = F.bid; job < J1; job += F.nb) {
        if (job < J0) {
            const int nt = job >> 4, kt = job & 15;
            const int drow = nt * 128;
            int scol, width = 128, perm = 0;
            if (drow < 1024) { scol = drow; perm = 2; }
            else if (drow < 3072) { scol = 4096 + (drow - 1024); perm = 2; }
            else if (drow < 5120) { scol = 6176 + (drow - 3072); perm = 3; }
            else if (drow < 9216) { scol = 9248 + (drow - 5120); perm = 2; }
            else if (drow < 10240) { scol = 1024 + (drow - 9216); perm = 2; }
            else if (drow < 12288) { scol = 2048 + (drow - 10240); perm = 2; }
            else if (drow < 12800) { scol = 8224 + (drow - 12288); perm = 3; }
            else if (drow < 13312) scol = 8736 + (drow - 12800);
            else if (drow < 13440) { scol = 6144; width = 32; }
            else { scol = 0; width = 0; }
#if MK_FP8_INPROJ
            cvt_tile8(F, w_in + (size_t)(kt * 128) * INW + scol, INW, width, perm, (unsigned char*)btin + (size_t)drow * 2048 + kt * 128, 2048);
#else
            const int pn_ = drow >> 8;
            const bool lat8 = MK_FP8_GATES && ((MK_F8MASK >> pn_) & 1ull), ctx8 = MK_FP8_GATES && ((MK_F8CTX >> pn_) & 1ull);
            if (lat8 || ctx8) cvt_tile8(F, w_in + (size_t)(kt * 128) * INW + scol, INW, width, perm, WSP(unsigned char, WS_BTIN8) + (size_t)drow * 2048 + kt * 128, 2048);
            if (!lat8 || (pn_ >= 36 && !ctx8)) cvt_tile(F, w_in + (size_t)(kt * 128) * INW + scol, INW, width, perm, btin + (size_t)drow * 2048 + kt * 128, 2048);
#endif
        } else {
            const int j = job - J0, which = j >> 8, nt = (j >> 4) & 15, kt = j & 15;
            const float* src = F.in[11 + which];
            bf16_t* dst = WSP(bf16_t, which == 0 ? WS_BTBRM : (which == 1 ? WS_BTBRA : WS_BTOUT));
#if MK_FP8_MIX
            cvt_tile8(F, src + (size_t)(kt * 128) * 2048 + nt * 128, 2048, 128, 2, (unsigned char*)dst + (size_t)(nt * 128) * 2048 + kt * 128, 2048);
#else
            cvt_tile(F, src + (size_t)(kt * 128) * 2048 + nt * 128, 2048, 128, 2, dst + (size_t)(nt * 128) * 2048 + kt * 128, 2048);
#endif
        }
    }
}

__device__ __forceinline__ void p0_tables(const Frame& F) {
    float* rope = WSP(float, WS_ROPE);
    const int gt = F.bid * NT + F.tid, gn = F.nb * NT;
    for (int idx = gt; idx < 2048 * 2 * 32; idx += gn) {
        const int i = idx & 31, axis = (idx >> 5) & 1, t = idx >> 6;
        const float pos = (float)(axis ? (t & 63) : (t >> 6));
        const float inv_freq = exp2f(-(float)i * (13.287712379549449f / 32.f));
        float rev = pos * inv_freq * 0.15915494309189535f;
        rev -= floorf(rev + 0.5f);
        rope[2 * idx] = __builtin_amdgcn_cosf(rev); rope[2 * idx + 1] = __builtin_amdgcn_sinf(rev);
    }
    bf16_t* wrh = WSP(bf16_t, WS_WRT); bf16_t* wrl = WSP(bf16_t, WS_WRL);
    const float* wrg = F.in[15]; const float* wre = F.in[17];
    for (int idx = gt; idx < 80 * 2048; idx += gn) {
        const int cc = idx >> 11, k = idx & 2047;
        const float wv = (cc < 8) ? wrg[k * 8 + cc] : ((cc < 72) ? wre[k * 64 + (cc - 8)] : 0.f);
        const unsigned hi = pk_bf16(wv, 0.f) & 0xffffu; const float hf = __uint_as_float(hi << 16);
        wrh[cc * WRLD + k] = (bf16_t)hi; wrl[cc * WRLD + k] = (bf16_t)(pk_bf16(wv - hf, 0.f) & 0xffffu);
    }
}

__device__ __forceinline__ void p1_norm1(const Frame& F) {
    const float* x = F.in[0]; const float* ctx = F.in[2]; const float* b_mod = F.in[5]; const float* g1n = F.in[6];
    const float* modp = WSP(float, WS_MODP); float* mod = WSP(float, WS_MOD); bf16_t* abf = WSP(bf16_t, WS_ABF);
    const int t = F.tid;
    for (int idx = F.bid * NT + t; idx < 5 * 12288; idx += F.nb * NT) {
        const int r = idx / 12288, col = idx % 12288; float v = b_mod[col];
#pragma unroll
        for (int ks = 0; ks < 8; ++ks) v += modp[((size_t)ks * 5 + r) * 12288 + col];
        mod[idx] = v;
    }
    LAS float* Asc = (LAS float*)(F.lds);
    LAS float* Bsh = (LAS float*)(F.lds + 8192);
    for (int tr = F.bid; tr < 512; tr += F.nb) {
        const bool isctx = tr >= 256;
        const int mr = isctx ? 4 : (tr * 32) / SEQ, row0 = isctx ? T + 4 * (tr - 256) : 32 * tr, nrows = isctx ? 4 : 32;
        __syncthreads();
        for (int col = t; col < 2048; col += NT) {
            float sh = b_mod[col], sc = b_mod[2048 + col];
#pragma unroll
            for (int ks = 0; ks < 8; ++ks) { sh += modp[((size_t)ks * 5 + mr) * 12288 + col]; sc += modp[((size_t)ks * 5 + mr) * 12288 + 2048 + col]; }
            Asc[col] = g1n[col] * (1.f + sc); Bsh[col] = sh;
        }
        __syncthreads();
        for (int rr = F.wave; rr < nrows; rr += 8) {
            const int row = row0 + rr;
            const float* src = (row < T) ? (x + (size_t)row * D) : (ctx + (size_t)(row - T) * D);
            f32x4 v[8]; float ss = 0.f;
#pragma unroll
            for (int i = 0; i < 8; ++i) { v[i] = *(const f32x4*)(src + (i * 64 + F.lane) * 4); ss += v[i][0] * v[i][0] + v[i][1] * v[i][1] + v[i][2] * v[i][2] + v[i][3] * v[i][3]; }
            ss = wave_sum(ss);
            const float rs = rsqrtf(ss * (1.f / D) + EPS);
#pragma unroll
            for (int i = 0; i < 8; ++i) {
                const int col = (i * 64 + F.lane) * 4;
                const f32x4 a = *(const LAS f32x4*)(Asc + col), b = *(const LAS f32x4*)(Bsh + col);
#if MK_FP8_INPROJ
                *(unsigned*)((unsigned char*)abf + (size_t)row * D + col) = pk_fp8x4(v[i][0] * rs * a[0] + b[0], v[i][1] * rs * a[1] + b[1], v[i][2] * rs * a[2] + b[2], v[i][3] * rs * a[3] + b[3]);
#else
                u32x2 o; o[0] = pk_bf16(v[i][0] * rs * a[0] + b[0], v[i][1] * rs * a[1] + b[1]); o[1] = pk_bf16(v[i][2] * rs * a[2] + b[2], v[i][3] * rs * a[3] + b[3]);
                *(u32x2*)(abf + (size_t)row * D + col) = o;
                if (MK_FP8_GATES) *(unsigned*)(WSP(unsigned char, WS_ABF8) + (size_t)row * D + col) = pk_fp8x4(v[i][0] * rs * a[0] + b[0], v[i][1] * rs * a[1] + b[1], v[i][2] * rs * a[2] + b[2], v[i][3] * rs * a[3] + b[3]);
#endif
            }
        }
    }
    __syncthreads();
}

struct InProjOrder {
    pg8::StaticOrder so; int G, c;
    __device__ void init(int G_, int c_) { so.init(T, INWP, G_, c_); G = G_; c = c_; }
    __device__ bool next(int i, Unit& u) const {
        const long L = (long)i * G + c;
        if (L < 32 * 53) return so.map(L, u);
        const int j = (int)(L - 32 * 53);
        if (j >= 4 * 17) return false;
        u.pm = 32 + (j & 3); u.pn = 36 + (j >> 2); return true;
    }
};
struct MaskOrder {
    pg8::StaticOrder so; unsigned long long mask, cmask; int G, c, nl, nc;
    __device__ static int sel(unsigned long long m, int k) { int p = 0; for (;;) { if (m & 1ull) { if (k == 0) break; --k; } m >>= 1; ++p; } return p; }
    __device__ void init(unsigned long long m, unsigned long long mctx, int G_, int c_) { mask = m; cmask = mctx >> 36; nl = __builtin_popcountll(m); nc = __builtin_popcountll(mctx >> 36); so.init(T, (nl > 0 ? nl : 1) * 256, G_, c_); G = G_; c = c_; }
    __device__ bool next(int i, Unit& u) const {
        const long L = (long)i * G + c;
        if (L < 32 * nl) { so.map(L, u); u.pn = sel(mask, u.pn); return true; }
        const int j = (int)(L - 32 * nl);
        if (j >= 4 * nc) return false;
        u.pm = 32 + (j & 3); u.pn = 36 + sel(cmask, j >> 2); return true;
    }
};
struct EpiInProj {
    bf16_t *QM, *OMS, *QA, *GBRS, *KM, *VM, *KA, *VAT; float* GM; const float* ROPE; float fs;
    __device__ __forceinline__ void operator()(const f32x4 (&acc)[2][2][4][2], const Unit& u, int wr, int wc, int fr, int fq) const {
        const int pn = u.pn; const float FS = fs;
        const int row0 = u.pm * 256 + wr * 64 + fr;
        const int cw = wc * 32 + 4 * fq;
        if (pn >= 52) {
            if (wc == 0) {
#pragma unroll
                for (int ai = 0; ai < 2; ++ai)
#pragma unroll
                    for (int m = 0; m < 4; ++m) { const int row = row0 + ai * 128 + m * 16;
#pragma unroll
                        for (int n = 0; n < 2; ++n) *(f32x4*)(GM + (size_t)row * 32 + n * 16 + 4 * fq) = acc[ai][0][m][n] * FS; }
            }
            return;
        }
        if (pn >= 50) {
            const int lc0 = (pn - 50) * 256;
#pragma unroll
            for (int ai = 0; ai < 2; ++ai)
#pragma unroll
                for (int m = 0; m < 4; ++m) { const int row = row0 + ai * 128 + m * 16;
#pragma unroll
                    for (int bj = 0; bj < 2; ++bj)
#pragma unroll
                        for (int n = 0; n < 2; ++n) { const int col = lc0 + bj * 128 + n * 16 + cw; const f32x4 v = acc[ai][bj][m][n] * FS;
                            const int t_ = fr & 3; const bool b0_ = t_ & 1, b1_ = t_ & 2;
                            int x0 = __float_as_int(v[0]), x1 = __float_as_int(v[1]), x2 = __float_as_int(v[2]), x3 = __float_as_int(v[3]);
                            { const int sa = b0_ ? x0 : x1, sb = b0_ ? x2 : x3; const int ra = __builtin_amdgcn_mov_dpp(sa, 0xB1, 0xF, 0xF, true), rb = __builtin_amdgcn_mov_dpp(sb, 0xB1, 0xF, 0xF, true);
                              if (b0_) { x0 = ra; x2 = rb; } else { x1 = ra; x3 = rb; } }
                            { const int sa = b1_ ? x0 : x2, sb = b1_ ? x1 : x3; const int ra = __builtin_amdgcn_mov_dpp(sa, 0x4E, 0xF, 0xF, true), rb = __builtin_amdgcn_mov_dpp(sb, 0x4E, 0xF, 0xF, true);
                              if (b1_) { x0 = ra; x1 = rb; } else { x2 = ra; x3 = rb; } }
                            u32x2 o; o[0] = pk_bf16(__int_as_float(x0), __int_as_float(x1)); o[1] = pk_bf16(__int_as_float(x2), __int_as_float(x3));
                            *(u32x2*)(VAT + (size_t)(col + t_) * TR + (row - t_)) = o; } }
            return;
        }
        int kind, lc0, ld; bf16_t* base;
        if (pn < 4)       { kind = 0; base = QM;   ld = 1024; lc0 = pn * 256; }
        else if (pn < 12) { kind = 1; base = OMS;  ld = 2048; lc0 = (pn - 4) * 256; }
        else if (pn < 20) { kind = 2; base = QA;   ld = 2048; lc0 = (pn - 12) * 256; }
        else if (pn < 36) { kind = 1; base = GBRS; ld = 4096; lc0 = (pn - 20) * 256; }
        else if (pn < 40) { kind = 3; base = KM;   ld = 1024; lc0 = (pn - 36) * 256; }
        else if (pn < 48) { kind = 0; base = VM;   ld = 2048; lc0 = (pn - 40) * 256; }
        else              { kind = (u.pm < 32) ? 2 : 0; base = KA; ld = 512; lc0 = (pn - 48) * 256; }
        if (kind == 2) {
#pragma unroll
            for (int ai = 0; ai < 2; ++ai)
#pragma unroll
                for (int m = 0; m < 4; ++m) { const int row = row0 + ai * 128 + m * 16; const int tpos = row & (SEQ - 1);
#pragma unroll
                    for (int bj = 0; bj < 2; ++bj) { const int col = lc0 + bj * 128 + wc * 32 + 8 * fq; const f32x4 v0 = acc[ai][bj][m][0] * FS, v1 = acc[ai][bj][m][1] * FS;
                        const int p = col & 127, axis = p >> 6, i0 = (p & 63) >> 1;
                        const float* cp = ROPE + ((size_t)(tpos * 2 + axis) * 32 + i0) * 2; const f32x4 c0 = *(const f32x4*)cp, c1 = *(const f32x4*)(cp + 4);
                        u32x4 o; o[0] = pk_bf16(v0[0] * c0[0] - v0[1] * c0[1], v0[1] * c0[0] + v0[0] * c0[1]); o[1] = pk_bf16(v0[2] * c0[2] - v0[3] * c0[3], v0[3] * c0[2] + v0[2] * c0[3]);
                        o[2] = pk_bf16(v1[0] * c1[0] - v1[1] * c1[1], v1[1] * c1[0] + v1[0] * c1[1]); o[3] = pk_bf16(v1[2] * c1[2] - v1[3] * c1[3], v1[3] * c1[2] + v1[2] * c1[3]);
                        *(u32x4*)(base + (size_t)row * ld + col) = o; } }
        } else if (kind == 1) {
#pragma unroll
            for (int ai = 0; ai < 2; ++ai)
#pragma unroll
                for (int m = 0; m < 4; ++m) { const int row = row0 + ai * 128 + m * 16;
#pragma unroll
                    for (int bj = 0; bj < 2; ++bj) { const int col = lc0 + bj * 128 + wc * 32 + 8 * fq; const f32x4 v0 = acc[ai][bj][m][0] * FS, v1 = acc[ai][bj][m][1] * FS;
                        u32x4 o; o[0] = pk_bf16(sigmoidf_(v0[0]), sigmoidf_(v0[1])); o[1] = pk_bf16(sigmoidf_(v0[2]), sigmoidf_(v0[3])); o[2] = pk_bf16(sigmoidf_(v1[0]), sigmoidf_(v1[1])); o[3] = pk_bf16(sigmoidf_(v1[2]), sigmoidf_(v1[3]));
                        *(u32x4*)(base + (size_t)row * ld + col) = o; } }
        } else {
            int oz = 0; asm volatile("" : "+v"(oz));
            const float sc = oz ? 2.f : ((kind == 3) ? 0.08838834764831845f : 1.f);
#pragma unroll
            for (int ai = 0; ai < 2; ++ai)
#pragma unroll
                for (int m = 0; m < 4; ++m) { const int row = row0 + ai * 128 + m * 16;
#pragma unroll
                    for (int bj = 0; bj < 2; ++bj) { const int col = lc0 + bj * 128 + wc * 32 + 8 * fq; const f32x4 v0 = acc[ai][bj][m][0] * FS, v1 = acc[ai][bj][m][1] * FS;
                        u32x4 o; o[0] = pk_bf16(v0[0] * sc, v0[1] * sc); o[1] = pk_bf16(v0[2] * sc, v0[3] * sc); o[2] = pk_bf16(v1[0] * sc, v1[1] * sc); o[3] = pk_bf16(v1[2] * sc, v1[3] * sc);
                        *(u32x4*)(base + (size_t)row * ld + col) = o; } }
        }
    }
};

__device__ __forceinline__ void p3_mlstm(const Frame& F) {
    const bf16_t* QM = WSP(bf16_t, WS_QM); const bf16_t* KM = WSP(bf16_t, WS_KM); const bf16_t* VM = WSP(bf16_t, WS_VM);
    const float* GM = WSP(float, WS_GM); const float* gate_b = F.in[8];
    bf16_t* HFB = WSP(bf16_t, WS_HFB);
    LAS unsigned char* L = F.lds;
    constexpr int oQ = 0, oK = 17408, oV = 34816, oKT = 44032, oVT = 62464, oS = 71680, oCT = 80896, oN = 98304, oSC = 98816, oCT2 = 102400, oN2 = 119808;
    const int t = F.tid, lane = F.lane, w = F.wave, r = lane & 15, fq = lane >> 4;
    for (int item = F.bid; item < 256; item += F.nb) {
        const int vs = item & 3, dir = (item >> 2) & 1, h = (item >> 3) & 7, b = item >> 6;
        __syncthreads();
        for (int i = t; i < 17408 / 4; i += NT) ((LAS unsigned*)(L + oCT))[i] = 0u;
        if (t < 128) ((LAS float*)(L + oN))[t] = 0.f;
        f32x4 accC[4];
#pragma unroll
        for (int vt = 0; vt < 4; ++vt) accC[vt] = (f32x4){0.f, 0.f, 0.f, 0.f};
        const float gbi = gate_b[(2 * dir) * 8 + h], gbf = gate_b[(2 * dir + 1) * 8 + h];
        u32x4 qreg[2], kreg[2], vreg;
        auto rowof = [&](int j, int p) -> int {
            if (j < 4) { const int tok = dir ? (CTXL - 1 - (64 * j + p)) : (64 * j + p); return T + b * CTXL + tok; }
            const int tok = dir ? (SEQ - 1 - (64 * (j - 4) + p)) : (64 * (j - 4) + p); return b * SEQ + tok;
        };
#define ML_LOAD(j) do { \
            _Pragma("unroll") for (int i_ = 0; i_ < 2; ++i_) { const int id_ = t + 512 * i_, p_ = id_ >> 4, c16_ = id_ & 15; const int row_ = rowof((j), p_); \
                if ((j) >= 4) qreg[i_] = *(const u32x4*)(QM + (size_t)row_ * 1024 + h * 128 + c16_ * 8); \
                kreg[i_] = *(const u32x4*)(KM + (size_t)row_ * 1024 + h * 128 + c16_ * 8); } \
            { const int p_ = t >> 3, c8_ = t & 7; const int row_ = rowof((j), p_); vreg = *(const u32x4*)(VM + (size_t)row_ * 2048 + h * 256 + vs * 64 + c8_ * 8); } } while (0)
        LAS float* preB = (LAS float*)(L + LDS_PRE_OFF), *preU = preB + 36 * 64, *preA = preU + 36 * 64;
        LAS float* preM = (LAS float*)(L + oSC + 3072);
        for (int jj = w; jj < 36; jj += 8) {
            const int row_ = rowof(jj, lane);
            const float ig = GM[(size_t)row_ * 32 + (2 * dir) * 8 + h] + gbi, f = GM[(size_t)row_ * 32 + (2 * dir + 1) * 8 + h] + gbf;
            const float lf = fminf(f, 0.f) - __logf(1.f + __expf(-fabsf(f)));
            float bs = lf;
#pragma unroll
            for (int d = 1; d < 64; d <<= 1) { const float o = __shfl_up(bs, d); if (lane >= d) bs += o; }
            const float uu = ig - bs;
            float a = uu;
#pragma unroll
            for (int d = 1; d < 64; d <<= 1) { const float o = __shfl_up(a, d); if (lane >= d) a = fmaxf(a, o); }
            preB[jj * 64 + lane] = bs; preU[jj * 64 + lane] = uu; preA[jj * 64 + lane] = a;
        }
        __syncthreads();
        if (t == 0) { float m = 0.f; for (int jj = 0; jj < 36; ++jj) { preM[jj] = m; m = preB[jj * 64 + 63] + fmaxf(m, preA[jj * 64 + 63]); } }
        ML_LOAD(0);
        for (int j = 0; j < 36; ++j) {
            const bool lat = j >= 4;
            const int par = j & 1;
            LAS float* sc_u = (LAS float*)(L + oSC + par * 1536), *sc_M = sc_u + 64, *sc_wi = sc_u + 128, *sc_fl = sc_u + 192, *sc_ws = sc_u + 256, *sc_wc = sc_u + 320;
            LAS unsigned char* sCTp = L + (par ? oCT2 : oCT); LAS unsigned char* sCTn = L + (par ? oCT : oCT2);
            LAS float* sNp = (LAS float*)(L + (par ? oN2 : oN)); LAS float* sNn = (LAS float*)(L + (par ? oN : oN2));
#pragma unroll
            for (int i = 0; i < 2; ++i) { const int id = t + 512 * i, p = id >> 4, c16 = id & 15;
                if (lat) *(LAS u32x4*)(L + oQ + p * 272 + c16 * 16) = qreg[i];
                *(LAS u32x4*)(L + oK + p * 272 + c16 * 16) = kreg[i]; }
            { const int p = t >> 3, c8 = t & 7; *(LAS u32x4*)(L + oV + p * 144 + c8 * 16) = vreg; }
            if (w == 0) {
                const float mj = preM[j], bs = preB[j * 64 + lane], uu = preU[j * 64 + lane], Mp = fmaxf(mj, preA[j * 64 + lane]), M63 = fmaxf(mj, preA[j * 64 + 63]);
                sc_u[lane] = uu; sc_M[lane] = Mp; sc_wi[lane] = __expf(mj - Mp); sc_fl[lane] = __expf(-(bs + Mp)); sc_ws[lane] = __expf(uu - M63);
                if (lane == 0) sc_wc[0] = __expf(mj - M63);
            }
            __syncthreads();
            const float wcs = sc_wc[0];
            if (j + 1 < 36) ML_LOAD(j + 1);
            { const int kp2 = t & 63, s0 = (t >> 6) * 8; float lo[8], hi[8];
#pragma unroll
                for (int e = 0; e < 8; ++e) { const unsigned x = *(const LAS unsigned*)(L + oK + (s0 + e) * 272 + kp2 * 4); const float ws = sc_ws[s0 + e]; lo[e] = bf_lo(x) * ws; hi[e] = bf_hi(x) * ws; }
                u32x4 o; o[0] = pk_bf16(lo[0], lo[1]); o[1] = pk_bf16(lo[2], lo[3]); o[2] = pk_bf16(lo[4], lo[5]); o[3] = pk_bf16(lo[6], lo[7]);
                *(LAS u32x4*)(L + oKT + (2 * kp2) * 144 + s0 * 2) = o;
                o[0] = pk_bf16(hi[0], hi[1]); o[1] = pk_bf16(hi[2], hi[3]); o[2] = pk_bf16(hi[4], hi[5]); o[3] = pk_bf16(hi[6], hi[7]);
                *(LAS u32x4*)(L + oKT + (2 * kp2 + 1) * 144 + s0 * 2) = o; }
            if (t < 256) { const int vp2 = t & 31, s0 = (t >> 5) * 8; unsigned xs[8];
#pragma unroll
                for (int e = 0; e < 8; ++e) xs[e] = *(const LAS unsigned*)(L + oV + (s0 + e) * 144 + vp2 * 4);
                u32x4 o; o[0] = (xs[0] & 0xffffu) | (xs[1] << 16); o[1] = (xs[2] & 0xffffu) | (xs[3] << 16); o[2] = (xs[4] & 0xffffu) | (xs[5] << 16); o[3] = (xs[6] & 0xffffu) | (xs[7] << 16);
                *(LAS u32x4*)(L + oVT + (2 * vp2) * 144 + s0 * 2) = o;
                o[0] = (xs[0] >> 16) | (xs[1] & 0xffff0000u); o[1] = (xs[2] >> 16) | (xs[3] & 0xffff0000u); o[2] = (xs[4] >> 16) | (xs[5] & 0xffff0000u); o[3] = (xs[6] >> 16) | (xs[7] & 0xffff0000u);
                *(LAS u32x4*)(L + oVT + (2 * vp2 + 1) * 144 + s0 * 2) = o; }
            const int pt = w >> 1, c0 = 2 * (w & 1);
            bf16x8 qa[4];
            if (lat) {
#pragma unroll
                for (int ks = 0; ks < 4; ++ks) qa[ks] = *(const LAS bf16x8*)(L + oQ + (16 * pt + r) * 272 + (32 * ks + 8 * fq) * 2);
#pragma unroll
                for (int si = 0; si < 2; ++si) { const int st = c0 + si;
                    f32x4 acc = (f32x4){0.f, 0.f, 0.f, 0.f};
                    if (st <= pt) {
#pragma unroll
                        for (int ks = 0; ks < 4; ++ks) {
                            const bf16x8 bk = *(const LAS bf16x8*)(L + oK + (16 * st + r) * 272 + (32 * ks + 8 * fq) * 2);
                            acc = __builtin_amdgcn_mfma_f32_16x16x32_bf16(qa[ks], bk, acc, 0, 0, 0); }
                    }
                    const int s = 16 * st + r; const float us = sc_u[s];
#pragma unroll
                    for (int rg = 0; rg < 4; ++rg) { const int p = 16 * pt + 4 * fq + rg;
                        const float val = (s <= p) ? acc[rg] * __expf(us - sc_M[p]) : 0.f;
                        *(LAS unsigned short*)(L + oS + p * 144 + s * 2) = (unsigned short)(pk_bf16(val, 0.f) & 0xffffu); }
                }
            }
            __syncthreads();
            if (lat) {
                float part = 0.f;
                { const int prow = 16 * pt + r;
#pragma unroll
                    for (int ks = 0; ks < 4; ++ks) { const u32x4 q8 = __builtin_bit_cast(u32x4, qa[ks]);
                        const f32x4 n0 = *(const LAS f32x4*)(sNp + 32 * ks + 8 * fq), n1 = *(const LAS f32x4*)(sNp + 32 * ks + 8 * fq + 4);
                        part += bf_lo(q8[0]) * n0[0] + bf_hi(q8[0]) * n0[1] + bf_lo(q8[1]) * n0[2] + bf_hi(q8[1]) * n0[3] + bf_lo(q8[2]) * n1[0] + bf_hi(q8[2]) * n1[1] + bf_lo(q8[3]) * n1[2] + bf_hi(q8[3]) * n1[3]; }
                    part *= DBG_NO_STATE ? 0.f : sc_wi[prow];
#pragma unroll
                    for (int ss = 0; ss < 16; ss += 8) { const u32x4 s8 = *(const LAS u32x4*)(L + oS + prow * 144 + (16 * fq + ss) * 2);
#pragma unroll
                        for (int e = 0; e < 4; ++e) part += bf_lo(s8[e]) + bf_hi(s8[e]); }
                    part += __shfl_xor(part, 16); part += __shfl_xor(part, 32);
                    part = __builtin_amdgcn_rcpf(fmaxf(fabsf(part), sc_fl[prow]));
                }
                const float inv_p = part, wi_p = DBG_NO_STATE ? 0.f : sc_wi[16 * pt + r];
                const int orow = rowof(j, 16 * pt + r);
#pragma unroll
                for (int vi = 0; vi < 2; ++vi) { const int vt = c0 + vi;
                    f32x4 acc = (f32x4){0.f, 0.f, 0.f, 0.f};
#pragma unroll
                    for (int ks = 0; ks < 4; ++ks) {
                        const bf16x8 bc = *(const LAS bf16x8*)(sCTp + (16 * vt + r) * 272 + (32 * ks + 8 * fq) * 2);
                        acc = __builtin_amdgcn_mfma_f32_16x16x32_bf16(bc, qa[ks], acc, 0, 0, 0); }
                    acc *= wi_p;
#pragma unroll
                    for (int ks = 0; ks < 2; ++ks) { const bf16x8 a = *(const LAS bf16x8*)(L + oS + (16 * pt + r) * 144 + (32 * ks + 8 * fq) * 2);
                        const bf16x8 bv = *(const LAS bf16x8*)(L + oVT + (16 * vt + r) * 144 + (32 * ks + 8 * fq) * 2);
                        acc = __builtin_amdgcn_mfma_f32_16x16x32_bf16(bv, a, acc, 0, 0, 0); }
                    u32x2 o; o[0] = pk_bf16(acc[0] * inv_p, acc[1] * inv_p); o[1] = pk_bf16(acc[2] * inv_p, acc[3] * inv_p);
                    *(u32x2*)(HFB + ((size_t)dir * T + orow) * 2048 + h * 256 + vs * 64 + 16 * vt + 4 * fq) = o;
                }
            }
            {
                const int kt = w;
#pragma unroll
                for (int vt = 0; vt < 4; ++vt) accC[vt] *= wcs;
#pragma unroll
                for (int ks = 0; ks < 2; ++ks) { const bf16x8 a = *(const LAS bf16x8*)(L + oKT + (16 * kt + r) * 144 + (32 * ks + 8 * fq) * 2);
#pragma unroll
                    for (int vt = 0; vt < 4; ++vt) { const bf16x8 bv = *(const LAS bf16x8*)(L + oVT + (16 * vt + r) * 144 + (32 * ks + 8 * fq) * 2);
                        accC[vt] = __builtin_amdgcn_mfma_f32_16x16x32_bf16(a, bv, accC[vt], 0, 0, 0); } }
#pragma unroll
                for (int vt = 0; vt < 4; ++vt) { u32x2 o; o[0] = pk_bf16(accC[vt][0], accC[vt][1]); o[1] = pk_bf16(accC[vt][2], accC[vt][3]);
                    *(LAS u32x2*)(sCTn + (16 * vt + r) * 272 + (16 * kt + 4 * fq) * 2) = o; }
                if (t < 128) { float sum = 0.f;
#pragma unroll
                    for (int ss = 0; ss < 64; ss += 8) { const u32x4 k8 = *(const LAS u32x4*)(L + oKT + t * 144 + ss * 2);
#pragma unroll
                        for (int e = 0; e < 4; ++e) sum += bf_lo(k8[e]) + bf_hi(k8[e]); }
                    sNn[t] = wcs * sNp[t] + sum; }
            }
        }
#undef ML_LOAD
    }
    __syncthreads();
}

__device__ __forceinline__ void p3_attn(const Frame& F) {
    const bf16_t* QA = WSP(bf16_t, WS_QA); const bf16_t* KA = WSP(bf16_t, WS_KA); const bf16_t* VAT = WSP(bf16_t, WS_VAT);
    bf16_t* AO = WSP(bf16_t, WS_AO); const float* sink = F.in[10];
    LAS unsigned char* L = F.lds;
    constexpr int KB = 17408, VB = 18432, BUF = KB + VB;
    constexpr float SC = 0.12751743074602542f;
    const int t = F.tid, lane = F.lane, w = F.wave, r = lane & 15, fq = lane >> 4;
    for (int item = F.bid; item < 512; item += F.nb) {
        const int n = item & 15, hp = (item >> 4) & 7, b = item >> 7;
        const int kvh = hp >> 1, head = 2 * hp + (w >> 2), qlo = 128 * n + 32 * (w & 3);
        bf16x8 qf[2][4];
#pragma unroll
        for (int qt = 0; qt < 2; ++qt)
#pragma unroll
            for (int ks = 0; ks < 4; ++ks) qf[qt][ks] = *(const bf16x8*)(QA + (size_t)(b * SEQ + qlo + 16 * qt + r) * 2048 + head * 128 + 32 * ks + 8 * fq);
        const int tlo = (n == 0) ? 2 : 0, thi = (n == 15) ? 4 : 6, ntiles = 4 + thi - tlo;
        f32x4 oacc[8][2];
#pragma unroll
        for (int dt = 0; dt < 8; ++dt) { oacc[dt][0] = (f32x4){0.f, 0.f, 0.f, 0.f}; oacc[dt][1] = (f32x4){0.f, 0.f, 0.f, 0.f}; }
        float mrun[2] = {-1e30f, -1e30f}, lsum[2] = {0.f, 0.f};
        u32x4 kr[2], vr[2];
#define AT_ROW0(i) (((i) < 4) ? (T + b * CTXL + 64 * (i)) : (b * SEQ + 128 * (n - 1) + 64 * (tlo + (i) - 4)))
#define AT_LOAD(i) do { const int row0_ = AT_ROW0(i); \
            _Pragma("unroll") for (int ii_ = 0; ii_ < 2; ++ii_) { const int id_ = t + 512 * ii_; \
                kr[ii_] = *(const u32x4*)(KA + (size_t)(row0_ + (id_ >> 4)) * 512 + kvh * 128 + (id_ & 15) * 8); \
                vr[ii_] = *(const u32x4*)(VAT + (size_t)(kvh * 128 + (id_ >> 3)) * TR + row0_ + (id_ & 7) * 8); } } while (0)
        const int vst = (t >> 3) * 144 + 64 * ((t >> 2) & 1) + 32 * (t & 1) + 8 * ((t >> 1) & 1);
#define AT_STORE(buf) do { _Pragma("unroll") for (int ii_ = 0; ii_ < 2; ++ii_) { const int id_ = t + 512 * ii_; \
                *(LAS u32x4*)(L + (buf) * BUF + (id_ >> 4) * 272 + (id_ & 15) * 16) = kr[ii_]; \
                { LAS unsigned char* vp_ = L + (buf) * BUF + KB + vst + ii_ * (64 * 144);     \
                  *(LAS u32x2*)vp_ = (u32x2){vr[ii_][0], vr[ii_][1]}; *(LAS u32x2*)(vp_ + 16) = (u32x2){vr[ii_][2], vr[ii_][3]}; } } } while (0)
        __syncthreads();
        AT_LOAD(0); AT_STORE(0);
        __syncthreads();
        for (int i = 0; i < ntiles; ++i) {
            if (i + 1 < ntiles) AT_LOAD(i + 1);
            const bool local = i >= 4;
            const int kp0 = 128 * (n - 1) + 64 * (tlo + i - 4);
            const bool active = !local || (kp0 + 63 >= qlo - 128 && kp0 <= qlo + 31 + 128);
            const bool need_mask = local && !(qlo + 31 - kp0 <= 128 && kp0 + 63 - qlo <= 128);
            if (active) {
                LAS unsigned char* sK = L + (i & 1) * BUF; LAS unsigned char* sV = sK + KB;
                f32x4 sacc[4][2];
#pragma unroll
                for (int kt = 0; kt < 4; ++kt) { sacc[kt][0] = (f32x4){0.f, 0.f, 0.f, 0.f}; sacc[kt][1] = (f32x4){0.f, 0.f, 0.f, 0.f}; }
#pragma unroll
                for (int ks = 0; ks < 4; ++ks)
#pragma unroll
                    for (int kt = 0; kt < 4; ++kt) { const bf16x8 a = *(const LAS bf16x8*)(sK + (16 * kt + r) * 272 + (32 * ks + 8 * fq) * 2);
                        sacc[kt][0] = __builtin_amdgcn_mfma_f32_16x16x32_bf16(a, qf[0][ks], sacc[kt][0], 0, 0, 0);
                        sacc[kt][1] = __builtin_amdgcn_mfma_f32_16x16x32_bf16(a, qf[1][ks], sacc[kt][1], 0, 0, 0); }
                bf16x8 pf[2][2];
#pragma unroll
                for (int qt = 0; qt < 2; ++qt) {
                    const int qp = qlo + 16 * qt + r;
                    float mt = -1e30f;
                    if (need_mask) {
#pragma unroll
                        for (int kt = 0; kt < 4; ++kt)
#pragma unroll
                            for (int rg = 0; rg < 4; ++rg) { float s = sacc[kt][qt][rg];
                                const int dd = qp - (kp0 + 16 * kt + 4 * fq + rg); if (dd > 128 || dd < -128) s = -1e30f;
                                sacc[kt][qt][rg] = s; mt = fmaxf(mt, s); }
                    } else {
#pragma unroll
                        for (int kt = 0; kt < 4; ++kt)
#pragma unroll
                            for (int rg = 0; rg < 4; ++rg) mt = fmaxf(mt, sacc[kt][qt][rg]);
                    }
                    mt = fmaxf(mt, __shfl_xor(mt, 16)); mt = fmaxf(mt, __shfl_xor(mt, 32));
                    const float mnew = fmaxf(mrun[qt], mt * SC), alpha = __builtin_amdgcn_exp2f(mrun[qt] - mnew);
                    mrun[qt] = mnew;
                    float ps = 0.f;
#pragma unroll
                    for (int kt = 0; kt < 4; ++kt)
#pragma unroll
                        for (int rg = 0; rg < 4; ++rg) { const float p = __builtin_amdgcn_exp2f(fmaf(sacc[kt][qt][rg], SC, -mnew)); sacc[kt][qt][rg] = p; ps += p; }
                    lsum[qt] = lsum[qt] * alpha + ps;
#pragma unroll
                    for (int dt = 0; dt < 8; ++dt) oacc[dt][qt] *= alpha;
#pragma unroll
                    for (int k2 = 0; k2 < 2; ++k2) { u32x4 o;
                        o[0] = pk_bf16(sacc[2 * k2][qt][0], sacc[2 * k2][qt][1]); o[1] = pk_bf16(sacc[2 * k2][qt][2], sacc[2 * k2][qt][3]);
                        o[2] = pk_bf16(sacc[2 * k2 + 1][qt][0], sacc[2 * k2 + 1][qt][1]); o[3] = pk_bf16(sacc[2 * k2 + 1][qt][2], sacc[2 * k2 + 1][qt][3]);
                        pf[qt][k2] = __builtin_bit_cast(bf16x8, o); }
                }
#pragma unroll
                for (int k2 = 0; k2 < 2; ++k2)
#pragma unroll
                    for (int dh = 0; dh < 2; ++dh) { bf16x8 a[4];
#pragma unroll
                        for (int d4 = 0; d4 < 4; ++d4) a[d4] = *(const LAS bf16x8*)(sV + (16 * (4 * dh + d4) + r) * 144 + 64 * k2 + 16 * fq);
#pragma unroll
                        for (int d4 = 0; d4 < 4; ++d4) { const int dt = 4 * dh + d4;
                            oacc[dt][0] = __builtin_amdgcn_mfma_f32_16x16x32_bf16(a[d4], pf[0][k2], oacc[dt][0], 0, 0, 0);
                            oacc[dt][1] = __builtin_amdgcn_mfma_f32_16x16x32_bf16(a[d4], pf[1][k2], oacc[dt][1], 0, 0, 0); }
                        __builtin_amdgcn_sched_barrier(0); }
            }
            if (i + 1 < ntiles) AT_STORE((i + 1) & 1);
            __syncthreads();
        }
#undef AT_ROW0
#undef AT_LOAD
#undef AT_STORE
        LAS unsigned char* sO = L + w * 8704;
        const float sk = sink[head] * 1.4426950408889634f;
#pragma unroll
        for (int qt = 0; qt < 2; ++qt) {
            float l = lsum[qt]; l += __shfl_xor(l, 16); l += __shfl_xor(l, 32); l += exp2f(sk - mrun[qt]);
            const float inv = __builtin_amdgcn_rcpf(l);
#pragma unroll
#if MK_FP8_MIX
            for (int dt = 0; dt < 8; ++dt) *(LAS unsigned*)(sO + (16 * qt + r) * 144 + 16 * dt + 4 * fq) = pk_fp8x4(oacc[dt][qt][0] * inv, oacc[dt][qt][1] * inv, oacc[dt][qt][2] * inv, oacc[dt][qt][3] * inv);
        }
#pragma unroll
        for (int i = 0; i < 4; ++i) { const int id = i * 64 + lane, row = id >> 3, cc = id & 7;
            const u32x4 v = *(const LAS u32x4*)(sO + row * 144 + cc * 16);
            *(u32x4*)((unsigned char*)AO + (size_t)(b * SEQ + qlo + row) * 2048 + head * 128 + cc * 16) = v; }
#else
            for (int dt = 0; dt < 8; ++dt) { u32x2 o; o[0] = pk_bf16(oacc[dt][qt][0] * inv, oacc[dt][qt][1] * inv); o[1] = pk_bf16(oacc[dt][qt][2] * inv, oacc[dt][qt][3] * inv);
                *(LAS u32x2*)(sO + (16 * qt + r) * 272 + (16 * dt + 4 * fq) * 2) = o; }
        }
#pragma unroll
        for (int i = 0; i < 8; ++i) { const int id = i * 64 + lane, row = id >> 4, cc = id & 15;
            const u32x4 v = *(const LAS u32x4*)(sO + row * 272 + cc * 16);
            *(u32x4*)(AO + (size_t)(b * SEQ + qlo + row) * 2048 + head * 128 + cc * 8) = v; }
#endif
    }
    __syncthreads();
}

__device__ __forceinline__ void p4_postmix(const Frame& F) {
    const bf16_t* HF = WSP(bf16_t, WS_HFB); const bf16_t* HB = HF + (size_t)T * 2048; const bf16_t* OMS = WSP(bf16_t, WS_OMS);
    const float* ng = F.in[9]; bf16_t* AM = WSP(bf16_t, WS_AM);
    for (int row = F.bid * 8 + F.wave; row < T; row += F.nb * 8) {
#pragma unroll
        for (int i = 0; i < 4; ++i) {
            const int col = i * 512 + F.lane * 8;
            const u32x4 a = *(const u32x4*)(HF + (size_t)row * 2048 + col), bq = *(const u32x4*)(HB + (size_t)row * 2048 + col), o8 = *(const u32x4*)(OMS + (size_t)row * 2048 + col);
            float hs[8]; float ss = 0.f;
#pragma unroll
            for (int e = 0; e < 4; ++e) { hs[2 * e] = bf_lo(a[e]) + bf_lo(bq[e]); hs[2 * e + 1] = bf_hi(a[e]) + bf_hi(bq[e]); ss += hs[2 * e] * hs[2 * e] + hs[2 * e + 1] * hs[2 * e + 1]; }
#pragma unroll
            for (int d = 16; d >= 1; d >>= 1) ss += __shfl_xor(ss, d);
            const float rs = rsqrtf(ss * (1.f / 256.f) + EPS);
            const f32x4 g0 = *(const f32x4*)(ng + col), g1 = *(const f32x4*)(ng + col + 4);
            u32x4 o;
            o[0] = pk_bf16(hs[0] * rs * g0[0] * bf_lo(o8[0]), hs[1] * rs * g0[1] * bf_hi(o8[0]));
            o[1] = pk_bf16(hs[2] * rs * g0[2] * bf_lo(o8[1]), hs[3] * rs * g0[3] * bf_hi(o8[1]));
            o[2] = pk_bf16(hs[4] * rs * g1[0] * bf_lo(o8[2]), hs[5] * rs * g1[1] * bf_hi(o8[2]));
            o[3] = pk_bf16(hs[6] * rs * g1[2] * bf_lo(o8[3]), hs[7] * rs * g1[3] * bf_hi(o8[3]));
#if MK_FP8_MIX
            { u32x2 o8v; o8v[0] = pk_fp8x4(bf_lo(o[0]), bf_hi(o[0]), bf_lo(o[1]), bf_hi(o[1])); o8v[1] = pk_fp8x4(bf_lo(o[2]), bf_hi(o[2]), bf_lo(o[3]), bf_hi(o[3]));
              *(u32x2*)((unsigned char*)AM + (size_t)row * 2048 + col) = o8v; }
#else
            *(u32x4*)(AM + (size_t)row * 2048 + col) = o;
#endif
        }
    }
}

struct EpiBr1 {
    float* TMP; const bf16_t* GBRS;
    __device__ __forceinline__ void operator()(const f32x4 (&acc)[2][2][4][2], const Unit& u, int wr, int wc, int fr, int fq) const {
        const int row0 = u.pm * 256 + wr * 64 + fr, col0 = u.pn * 256 + wc * 32 + 8 * fq;
#pragma unroll
        for (int ai = 0; ai < 2; ++ai)
#pragma unroll
            for (int m = 0; m < 4; ++m) { const int row = row0 + ai * 128 + m * 16;
#pragma unroll
                for (int bj = 0; bj < 2; ++bj) { const int col = col0 + bj * 128; const f32x4 v0 = acc[ai][bj][m][0] * (MK_FP8_MIX ? 0.015625f : 1.f), v1 = acc[ai][bj][m][1] * (MK_FP8_MIX ? 0.015625f : 1.f);
                    const u32x4 g = *(const u32x4*)(GBRS + (size_t)row * 4096 + col);
                    u32x4 o; o[0] = pk_bf16(v0[0] * bf_lo(g[0]), v0[1] * bf_hi(g[0])); o[1] = pk_bf16(v0[2] * bf_lo(g[1]), v0[3] * bf_hi(g[1]));
                    o[2] = pk_bf16(v1[0] * bf_lo(g[2]), v1[1] * bf_hi(g[2])); o[3] = pk_bf16(v1[2] * bf_lo(g[3]), v1[3] * bf_hi(g[3]));
                    *(u32x4*)((bf16_t*)TMP + (size_t)row * 2048 + col) = o; } }
    }
};
struct EpiBr2 {
    const float* TMP; const bf16_t* GBRS; bf16_t* AOUT;
    __device__ __forceinline__ void operator()(const f32x4 (&acc)[2][2][4][2], const Unit& u, int wr, int wc, int fr, int fq) const {
        const int row0 = u.pm * 256 + wr * 64 + fr, col0 = u.pn * 256 + wc * 32 + 8 * fq;
#pragma unroll
        for (int ai = 0; ai < 2; ++ai)
#pragma unroll
            for (int m = 0; m < 4; ++m) { const int row = row0 + ai * 128 + m * 16;
#pragma unroll
                for (int bj = 0; bj < 2; ++bj) { const int col = col0 + bj * 128; const f32x4 v0 = acc[ai][bj][m][0] * (MK_FP8_MIX ? 0.015625f : 1.f), v1 = acc[ai][bj][m][1] * (MK_FP8_MIX ? 0.015625f : 1.f);
                    const u32x4 g = *(const u32x4*)(GBRS + (size_t)row * 4096 + 2048 + col);
                    const u32x4 tmb = *(const u32x4*)((const bf16_t*)TMP + (size_t)row * 2048 + col);
                    const float zz = DBG_NO_ATTN ? 0.f : 1.f;
                    u32x4 o; o[0] = pk_bf16(bf_lo(tmb[0]) + zz * v0[0] * bf_lo(g[0]), bf_hi(tmb[0]) + zz * v0[1] * bf_hi(g[0])); o[1] = pk_bf16(bf_lo(tmb[1]) + zz * v0[2] * bf_lo(g[1]), bf_hi(tmb[1]) + zz * v0[3] * bf_hi(g[1]));
                    o[2] = pk_bf16(bf_lo(tmb[2]) + zz * v1[0] * bf_lo(g[2]), bf_hi(tmb[2]) + zz * v1[1] * bf_hi(g[2])); o[3] = pk_bf16(bf_lo(tmb[3]) + zz * v1[2] * bf_lo(g[3]), bf_hi(tmb[3]) + zz * v1[3] * bf_hi(g[3]));
#if MK_FP8_MIX
                    { u32x2 o8; o8[0] = pk_fp8x4(bf_lo(o[0]), bf_hi(o[0]), bf_lo(o[1]), bf_hi(o[1])); o8[1] = pk_fp8x4(bf_lo(o[2]), bf_hi(o[2]), bf_lo(o[3]), bf_hi(o[3]));
                      *(u32x2*)((unsigned char*)AOUT + (size_t)row * 2048 + col) = o8; } } }
#else
                    *(u32x4*)(AOUT + (size_t)row * 2048 + col) = o; } }
#endif
    }
};
struct EpiOut {
    const float* X; const float* MOD; float* X1; float* RSS;
    __device__ __forceinline__ void operator()(const f32x4 (&acc)[2][2][4][2], const Unit& u, int wr, int wc, int fr, int fq) const {
        const int row0 = u.pm * 256 + wr * 64 + fr, col0 = u.pn * 256 + wc * 32 + 8 * fq;
        const float* g1 = MOD + (size_t)((u.pm * 256) / SEQ) * 12288 + 2 * 2048;
        float ssq[2][4];
#pragma unroll
        for (int ai = 0; ai < 2; ++ai)
#pragma unroll
            for (int m = 0; m < 4; ++m) ssq[ai][m] = 0.f;
#pragma unroll
        for (int bj = 0; bj < 2; ++bj)
#pragma unroll
            for (int n = 0; n < 2; ++n) { const int col = col0 + bj * 128 + n * 4; const f32x4 gv = *(const f32x4*)(g1 + col);
#pragma unroll
                for (int ai = 0; ai < 2; ++ai)
#pragma unroll
                    for (int m = 0; m < 4; ++m) { const int row = row0 + ai * 128 + m * 16; const f32x4 v = acc[ai][bj][m][n] * (MK_FP8_MIX ? 0.015625f : 1.f);
                        const f32x4 xv = *(const f32x4*)(X + (size_t)row * 2048 + col);
                        const f32x4 o = xv + gv * v; ssq[ai][m] += (o[0] * o[0] + o[1] * o[1]) + (o[2] * o[2] + o[3] * o[3]);
                        *(f32x4*)(X1 + (size_t)row * 2048 + col) = o; } }
#pragma unroll
        for (int ai = 0; ai < 2; ++ai)
#pragma unroll
            for (int m = 0; m < 4; ++m) { float q = ssq[ai][m]; q += __shfl_xor(q, 16); q += __shfl_xor(q, 32);
                if (fq == 0) RSS[(size_t)(row0 + ai * 128 + m * 16) * 32 + u.pn * 4 + wc] = q; }
    }
};

template <bool DUMMY = false>
__device__ __forceinline__ void p7_norm2_router(const Frame& F) {
    const float* X1 = WSP(float, WS_X1); const float* mod = WSP(float, WS_MOD); const float* g2n = F.in[14]; const float* rss = WSP(float, WS_RSS);
    const float* brg = F.in[16]; const float* bre = F.in[18]; const bf16_t* wrh = WSP(bf16_t, WS_WRT); const bf16_t* wrl = WSP(bf16_t, WS_WRL);
    bf16_t* H2 = WSP(bf16_t, DUMMY ? WS_XG : WS_H2); int* EID = WSP(int, DUMMY ? WS_XG + (64u << 20) : WS_EID); float* WTOP = WSP(float, DUMMY ? WS_XG + (65u << 20) : WS_WTOP); int* POS = WSP(int, DUMMY ? WS_XG + (66u << 20) : WS_POS);
    unsigned* cnt = DUMMY ? (unsigned*)(F.ws + WS_XG + (67u << 20)) : (unsigned*)(F.ws + WS_CTL + CTL_CNT);
    LAS float* Asc = (LAS float*)(F.lds); LAS float* Bsh = (LAS float*)(F.lds + 8192);
    LAS float* lss = (LAS float*)(F.lds + 16384);
    LAS float* lpart = (LAS float*)(F.lds + 16384 + 1024);
    LAS float* lfin = (LAS float*)(F.lds + 16384 + 1024 + 81920);
    const int t = F.tid, lane = F.lane, w = F.wave, r = lane & 15, fq = lane >> 4;
    int cur_mr = -1;
    for (int rg = F.bid; rg < T / 32; rg += F.nb) {
        const int mr = (rg * 32) / SEQ;
        __syncthreads();
        if (mr != cur_mr) {
#pragma unroll
            for (int ci = 0; ci < 2048 / NT; ++ci) { const int col = t + ci * NT; Asc[col] = g2n[col] * (1.f + mod[(size_t)mr * 12288 + 4 * 2048 + col]); Bsh[col] = mod[(size_t)mr * 12288 + 3 * 2048 + col]; }
            cur_mr = mr;
        }
        const float* src = X1 + (size_t)(rg * 32 + r) * D + w * 256 + 8 * fq;
        float rs2[2];
#pragma unroll
        for (int tl = 0; tl < 2; ++tl) {
            const float* rp = rss + (size_t)(rg * 32 + tl * 16 + r) * 32 + fq * 8;
            const f32x4 p0 = *(const f32x4*)rp, p1 = *(const f32x4*)(rp + 4);
            float tot = ((p0[0] + p0[1]) + (p0[2] + p0[3])) + ((p1[0] + p1[1]) + (p1[2] + p1[3]));
            tot += __shfl_xor(tot, 16); tot += __shfl_xor(tot, 32);
            rs2[tl] = rsqrtf(tot * (1.f / D) + EPS);
        }
        __syncthreads();
        f32x4 acc[2][5];
#pragma unroll
        for (int tl = 0; tl < 2; ++tl)
#pragma unroll
            for (int ct = 0; ct < 5; ++ct) acc[tl][ct] = (f32x4){0.f, 0.f, 0.f, 0.f};
#pragma unroll 2
        for (int s0_ = 0; s0_ < 8; ++s0_) {
            const int s_ = (s0_ + F.bid) & 7;
            const int kk = w * 256 + s_ * 32 + 8 * fq;
            bf16x8 bh[5], bl[5];
#pragma unroll
            for (int ct = 0; ct < 5; ++ct) { bh[ct] = *(const bf16x8*)(wrh + (size_t)(16 * ct + r) * WRLD + kk); bl[ct] = *(const bf16x8*)(wrl + (size_t)(16 * ct + r) * WRLD + kk); }
            const f32x4 a0 = *(const LAS f32x4*)(Asc + kk), a1 = *(const LAS f32x4*)(Asc + kk + 4), b0 = *(const LAS f32x4*)(Bsh + kk), b1 = *(const LAS f32x4*)(Bsh + kk + 4);
#pragma unroll
            for (int tl = 0; tl < 2; ++tl) {
                const int row = rg * 32 + tl * 16 + r; const float rs = rs2[tl];
                const f32x4 v0 = *(const f32x4*)(src + (size_t)tl * 16 * D + s_ * 32), v1 = *(const f32x4*)(src + (size_t)tl * 16 * D + s_ * 32 + 4);
                float hv[8];
#pragma unroll
                for (int e = 0; e < 4; ++e) { hv[e] = v0[e] * rs * a0[e] + b0[e]; hv[4 + e] = v1[e] * rs * a1[e] + b1[e]; }
                u32x4 hi, lo;
#pragma unroll
                for (int e = 0; e < 4; ++e) { hi[e] = pk_bf16(hv[2 * e], hv[2 * e + 1]); lo[e] = pk_bf16(hv[2 * e] - bf_lo(hi[e]), hv[2 * e + 1] - bf_hi(hi[e])); }
#if MK_FP8_MOE
                { u32x2 h8; h8[0] = pk_fp8x4(hv[0], hv[1], hv[2], hv[3]); h8[1] = pk_fp8x4(hv[4], hv[5], hv[6], hv[7]); *(u32x2*)((unsigned char*)H2 + (size_t)row * D + kk) = h8; }
#else
                *(u32x4*)(H2 + (size_t)row * D + kk) = hi;
#endif
                const bf16x8 ah = __builtin_bit_cast(bf16x8, hi), al = __builtin_bit_cast(bf16x8, lo);
#pragma unroll
                for (int ct = 0; ct < 5; ++ct) {
                    acc[tl][ct] = __builtin_amdgcn_mfma_f32_16x16x32_bf16(ah, bh[ct], acc[tl][ct], 0, 0, 0);
                    acc[tl][ct] = __builtin_amdgcn_mfma_f32_16x16x32_bf16(ah, bl[ct], acc[tl][ct], 0, 0, 0);
                    acc[tl][ct] = __builtin_amdgcn_mfma_f32_16x16x32_bf16(al, bh[ct], acc[tl][ct], 0, 0, 0);
                }
            }
        }
#pragma unroll
        for (int tl = 0; tl < 2; ++tl)
#pragma unroll
            for (int ct = 0; ct < 5; ++ct)
#pragma unroll
                for (int rg_ = 0; rg_ < 4; ++rg_) lpart[((w * 2 + tl) * 16 + 4 * fq + rg_) * 80 + 16 * ct + r] = acc[tl][ct][rg_];
        __syncthreads();
        for (int idx = t; idx < 32 * 72; idx += NT) {
            const int tk = idx / 72, c_ = idx - tk * 72, tl = tk >> 4, rr = tk & 15;
            float v = (c_ < 8) ? brg[c_] : bre[c_ - 8];
#pragma unroll
            for (int q = 0; q < 8; ++q) v += lpart[((q * 2 + tl) * 16 + rr) * 80 + c_];
            lfin[idx] = v;
        }
        __syncthreads();
        if (t < 32) {
            const int tok = rg * 32 + t;
            float gl[8]; float gmax = -3.0e38f; int gs = 0;
#pragma unroll
            for (int i = 0; i < 8; ++i) { gl[i] = lfin[t * 72 + i]; if (gl[i] > gmax) { gmax = gl[i]; gs = i; } }
            float den = 0.f;
#pragma unroll
            for (int i = 0; i < 8; ++i) den += __expf(gl[i] - gmax);
            const float pg = 1.f / den;
            float v1 = -3.0e38f, v2 = -3.0e38f; int i1 = 0, i2 = 0;
#pragma unroll
            for (int i = 0; i < 8; ++i) { const float ev = lfin[t * 72 + 8 + gs * 8 + i];
                if (ev > v1) { v2 = v1; i2 = i1; v1 = ev; i1 = i; } else if (ev > v2) { v2 = ev; i2 = i; } }
            const float w1 = 1.f / (1.f + __expf(v2 - v1)), w2 = 1.f - w1;
            const int e1 = gs * 8 + i1, e2 = gs * 8 + i2;
            const unsigned p1 = atomicAdd(&cnt[e1], 1u), p2 = atomicAdd(&cnt[e2], 1u);
            EID[2 * tok] = e1; EID[2 * tok + 1] = e2; WTOP[2 * tok] = w1 * pg; WTOP[2 * tok + 1] = w2 * pg; POS[2 * tok] = (int)p1; POS[2 * tok + 1] = (int)p2;
        }
    }
    __syncthreads();
}

__device__ __forceinline__ void p8_lists(const Frame& F) {
    const unsigned* cnt = (const unsigned*)(F.ws + WS_CTL + CTL_CNT);
    const int* EID = WSP(int, WS_EID); const float* WTOP = WSP(float, WS_WTOP); const int* POS = WSP(int, WS_POS);
    int* ROWMAP = WSP(int, WS_ROWMAP); float* ROWW = WSP(float, WS_ROWW); int* ROWTOK = WSP(int, WS_ROWTOK); int* PST = WSP(int, WS_PANEL);
    LAS int* pstart = (LAS int*)(F.lds + LDS_TAB_OFF);
    __syncthreads();
    if (F.tid == 0) {
        int acc = 0;
        for (int e = 0; e < NEXP; ++e) { pstart[e] = acc; if (F.bid == 0) PST[e] = acc; acc += (int)cnt[e]; }
        pstart[NEXP] = acc; if (F.bid == 0) PST[NEXP] = acc;
    }
    __syncthreads();
    for (int a = F.bid * NT + F.tid; a < 2 * T; a += F.nb * NT) {
        const int pos = pstart[EID[a]] + POS[a];
        ROWMAP[pos] = a; ROWW[pos] = WTOP[a]; ROWTOK[pos] = a >> 1;
    }
}

__device__ __forceinline__ int moe_phys(int s) { return s ^ ((s >> 3) & 3); }
template <bool GU, int VAR = 0>
__device__ __forceinline__ void moe_gemm(const Frame& F) {
    constexpr int K = GU ? 2048 : 1024, NT2 = K / 64, LDB = GU ? 1024 : 2048, LDA = GU ? 2048 : 1024;
    constexpr int STG = 65536, BOFF = 49152;
    const int* PST = WSP(int, WS_PANEL); const int* ROWTOK = WSP(int, WS_ROWTOK); const int* ROWMAP = WSP(int, WS_ROWMAP); const float* ROWW = WSP(float, WS_ROWW);
    const bf16_t* H2 = WSP(bf16_t, WS_H2); bf16_t* HBUF = WSP(bf16_t, VAR ? WS_XG : WS_HBUF); bf16_t* YBUF = WSP(bf16_t, WS_YBUF);
    LAS unsigned char* L = F.lds;
    const int nrounds = (NEXP * 16 + F.nb - 1) / F.nb;
    for (int rnd = 0; rnd < nrounds; ++rnd) {
        int unit;
        if ((F.nb & 127) == 0) { const int xcd = F.bid & 7, j = F.bid >> 3, epx = F.nb >> 7;
            unit = ((rnd * 8 + xcd) * epx + (j >> 4)) * 16 + (j & 15); }
        else unit = rnd * F.nb + F.bid;
        if (unit >= NEXP * 16) continue;
        const int e = unit >> 4, nti = unit & 15;
        const int ps = PST[e], Me = PST[e + 1] - ps;
        for (int m0 = 0; m0 < Me; m0 += 320) {
            const int rows = (Me - m0) < 320 ? (Me - m0) : 320;
            int tz = threadIdx.x; asm volatile("" : "+v"(tz));
            const int t = tz, w = __builtin_amdgcn_readfirstlane(tz >> 6), lane = tz & 63, fr = lane & 15, fq = lane >> 4, wr4 = (w >> 1) & 3, wc2 = w & 1;
            const bool bwave = w < 4;
            f32x4 acc[5][4];
#pragma unroll
            for (int m = 0; m < 5; ++m)
#pragma unroll
                for (int ns = 0; ns < 4; ++ns) acc[m][ns] = (f32x4){0.f, 0.f, 0.f, 0.f};
            int boffr[4];
#pragma unroll
            for (int ns = 0; ns < 4; ++ns) boffr[ns] = BOFF + (fq * 128 + moe_phys(64 * wc2 + 16 * ns + fr)) * 16;
            const int arow0 = 80 * wr4 + fr;
            const bool ga = (80 * wr4) < rows, gb = (80 * wr4 + 48) < rows;
#define MOE_LDA(dst_, h_, n_, sb_, ks_) do { _Pragma("unroll") for (int q_ = 0; q_ < (n_); ++q_) { const int r_ = arow0 + 16 * ((h_) * 3 + q_); \
                dst_[q_] = *(const LAS bf16x8*)((sb_) + r_ * 128 + (((4 * (ks_) + fq) ^ ((r_ >> 1) & 7)) * 16)); } } while (0)
#define MOE_LDB(dst_, sb_, ks_) do { _Pragma("unroll") for (int ns_ = 0; ns_ < 4; ++ns_) dst_[ns_] = *(const LAS bf16x8*)((sb_) + boffr[ns_] + (ks_) * (4 * 128 * 16)); } while (0)
#define MOE_MM(bf_, af_, h_, n_) do { _Pragma("unroll") for (int q_ = 0; q_ < (n_); ++q_) _Pragma("unroll") for (int ns_ = 0; ns_ < 4; ++ns_) \
                acc[(h_) * 3 + q_][ns_] = __builtin_amdgcn_mfma_f32_16x16x32_bf16(bf_[ns_], af_[q_], acc[(h_) * 3 + q_][ns_], 0, 0, 0); } while (0)
#define MOE_COMPUTE(st_) do { LAS unsigned char* sb_ = L + (st_) * STG; if (ga) { bf16x8 b0_[4], b1_[4], a0_[3], a1_[2], a2_[3], a3_[2]; \
            MOE_LDB(b0_, sb_, 0); MOE_LDA(a0_, 0, 3, sb_, 0); MOE_LDA(a1_, 1, 2, sb_, 0); __builtin_amdgcn_sched_barrier(0); \
            MOE_MM(b0_, a0_, 0, 3); MOE_LDB(b1_, sb_, 1); MOE_LDA(a2_, 0, 3, sb_, 1); __builtin_amdgcn_sched_barrier(0); \
            if (gb) MOE_MM(b0_, a1_, 1, 2); MOE_LDA(a3_, 1, 2, sb_, 1); __builtin_amdgcn_sched_barrier(0); \
            MOE_MM(b1_, a2_, 0, 3); if (gb) MOE_MM(b1_, a3_, 1, 2); } } while (0)
            if (bwave) {
                int boff[4]; u32x4 stg[16]; const char* bbase; unsigned blane;
                {
                    int n4, kp, scol, isup = 0;
                    if (GU) { const int tg = t & 127; n4 = tg & 15; kp = tg >> 4; isup = w >> 1; scol = 64 * nti; bbase = (const char*)(F.in[isup ? 20 : 19] + (size_t)e * 2048 * 1024 + scol); }
                    else    { n4 = t & 31; kp = t >> 5; scol = 128 * nti; bbase = (const char*)(F.in[21] + (size_t)e * 1024 * 2048 + scol); }
                    blane = (unsigned)(((8 * kp) * LDB + 4 * n4) * 4);
#pragma unroll
                    for (int j = 0; j < 4; ++j) { const int g = 4 * n4 + j; const int s0 = GU ? (64 * (g >> 5) + (g & 31) + 32 * isup) : g;
                        boff[j] = BOFF + (kp * 128 + moe_phys(s0)) * 16; }
                }
#define MOE_LOADB(slot, tile) do { _Pragma("unroll") for (int i_ = 0; i_ < 8; ++i_) stg[(slot) * 8 + i_] = *(const u32x4*)(bbase + ((size_t)(tile) * 64 + i_) * (LDB * 4) + blane); } while (0)
                MOE_LOADB(0, 0); __builtin_amdgcn_sched_barrier(0); MOE_LOADB(1, 1); __builtin_amdgcn_sched_barrier(0);
#define MOE_BSTEP(s) do { LAS unsigned char* sw_ = L + (s) * STG; \
                { f32x4 b_[8]; _Pragma("unroll") for (int i_ = 0; i_ < 8; ++i_) b_[i_] = __builtin_bit_cast(f32x4, stg[(s) * 8 + i_]); \
                  _Pragma("unroll") for (int j_ = 0; j_ < 4; ++j_) { u32x4 o_; o_[0] = pk_bf16(b_[0][j_], b_[1][j_]); o_[1] = pk_bf16(b_[2][j_], b_[3][j_]); o_[2] = pk_bf16(b_[4][j_], b_[5][j_]); o_[3] = pk_bf16(b_[6][j_], b_[7][j_]); \
                      *(LAS u32x4*)(sw_ + boff[j_]) = o_; } } \
                __builtin_amdgcn_sched_barrier(0); \
                if (VAR != 4 && VAR != 5) { const int tn_ = (tt + (s) + 2) < NT2 ? (tt + (s) + 2) : (NT2 - 1); MOE_LOADB((s), tn_); } \
                __syncthreads(); if (VAR != 2) MOE_COMPUTE(s); } while (0)
                for (int tt = 0; tt < NT2; tt += 2) { MOE_BSTEP(0); MOE_BSTEP(1); }
#undef MOE_BSTEP
#undef MOE_LOADB
            } else {
                unsigned arow[10]; const char* abase = (const char*)(GU ? H2 : WSP(bf16_t, WS_HBUF)); int ldst0;
                {
                    const int ta = t - 256, r0 = ta >> 3, p = ta & 7;
#pragma unroll
                    for (int i = 0; i < 10; ++i) { const int r = r0 + 32 * i, rr = r < rows ? r : rows - 1;
                        arow[i] = (unsigned)(GU ? ROWTOK[ps + m0 + rr] : (ps + m0 + rr)) * (unsigned)(LDA * 2) + (unsigned)((p ^ ((r0 >> 1) & 7)) * 16); }
                    ldst0 = (w - 4) * 8 * 128;
                }
#define MOE_GLDSA(st_, tile) do { _Pragma("unroll") for (int i_ = 0; i_ < 10; ++i_) \
                    __builtin_amdgcn_global_load_lds((const unsigned*)(abase + (size_t)((tile) * 128) + arow[i_]), (LAS unsigned*)(L + (st_) * STG + ldst0 + i_ * 4096), 16, 0, 0); } while (0)
                MOE_GLDSA(0, 0);
#define MOE_ASTEP(s) do { asm volatile("s_waitcnt vmcnt(0)" ::: "memory"); __syncthreads(); \
                if (VAR != 3 && VAR != 5) { const int tn_ = (tt + (s) + 1) < NT2 ? (tt + (s) + 1) : (NT2 - 1); MOE_GLDSA((s) ^ 1, tn_); } \
                if (VAR != 2) MOE_COMPUTE(s); } while (0)
                for (int tt = 0; tt < NT2; tt += 2) { MOE_ASTEP(0); MOE_ASTEP(1); }
                asm volatile("s_waitcnt vmcnt(0)" ::: "memory");
#undef MOE_ASTEP
#undef MOE_GLDSA
            }
#undef MOE_COMPUTE
#undef MOE_MM
#undef MOE_LDB
#undef MOE_LDA
            int te = threadIdx.x; asm volatile("" : "+v"(te));
            const int fr_e = te & 15, fq_e = (te >> 4) & 3, wr4_e = (te >> 7) & 3, wc2_e = (te >> 6) & 1;
#pragma unroll
            for (int m = 0; m < 5; ++m) {
                const int row = 80 * wr4_e + 16 * m + fr_e;
                if (row < rows) {
                    const int gpos = ps + m0 + row;
                    if (GU) {
#pragma unroll
                        for (int ns = 0; ns < 2; ++ns) { const f32x4 g = acc[m][ns], up = acc[m][ns + 2];
                            u32x2 o; o[0] = pk_bf16(g[0] * sigmoidf_(g[0]) * up[0], g[1] * sigmoidf_(g[1]) * up[1]); o[1] = pk_bf16(g[2] * sigmoidf_(g[2]) * up[2], g[3] * sigmoidf_(g[3]) * up[3]);
                            *(u32x2*)(HBUF + (size_t)gpos * 1024 + 64 * nti + 32 * wc2_e + 16 * ns + 4 * fq_e) = o; }
                    } else {
                        const int a = ROWMAP[gpos]; const float wt = ROWW[gpos];
#pragma unroll
                        for (int ns = 0; ns < 4; ++ns) { const f32x4 v = acc[m][ns];
                            u32x2 o; o[0] = pk_bf16(v[0] * wt, v[1] * wt); o[1] = pk_bf16(v[2] * wt, v[3] * wt);
                            *(u32x2*)(YBUF + (size_t)a * 2048 + 128 * nti + 64 * wc2_e + 16 * ns + 4 * fq_e) = o; }
                    }
                }
            }
        }
    }
    __syncthreads();
}

template <bool GU>
__device__ __forceinline__ void moe_gemm8(const Frame& F) {
    constexpr int K = GU ? 2048 : 1024, NT = K / 128, LDB = GU ? 1024 : 2048, LDAB = GU ? 2048 : 1024;
    constexpr int STG = 65536, BOFF = 49152;
    const int* PST = WSP(int, WS_PANEL); const int* ROWTOK = WSP(int, WS_ROWTOK); const int* ROWMAP = WSP(int, WS_ROWMAP); const float* ROWW = WSP(float, WS_ROWW);
    const unsigned char* H2 = WSP(unsigned char, WS_H2); unsigned char* HBUF = WSP(unsigned char, WS_HBUF); bf16_t* YBUF = WSP(bf16_t, WS_YBUF);
    LAS unsigned char* L = F.lds;
    const int nrounds = (NEXP * 16 + F.nb - 1) / F.nb;
    for (int rnd = 0; rnd < nrounds; ++rnd) {
        int unit;
        if ((F.nb & 127) == 0) { const int xcd = F.bid & 7, j = F.bid >> 3, epx = F.nb >> 7;
            unit = ((rnd * 8 + xcd) * epx + (j >> 4)) * 16 + (j & 15); }
        else unit = rnd * F.nb + F.bid;
        if (unit >= NEXP * 16) continue;
        const int e = unit >> 4, nti = unit & 15;
        const int ps = PST[e], Me = PST[e + 1] - ps;
        for (int m0 = 0; m0 < Me; m0 += 320) {
            const int rows = (Me - m0) < 320 ? (Me - m0) : 320;
            int tz = threadIdx.x; asm volatile("" : "+v"(tz));
            const int t = tz, w = __builtin_amdgcn_readfirstlane(tz >> 6), lane = tz & 63, fr = lane & 15, fq = lane >> 4, wr4 = (w >> 1) & 3, wc2 = w & 1;
            const bool bwave = w < 4;
            f32x4 acc[5][4];
#pragma unroll
            for (int m = 0; m < 5; ++m)
#pragma unroll
                for (int ns = 0; ns < 4; ++ns) acc[m][ns] = (f32x4){0.f, 0.f, 0.f, 0.f};
            int boffr[4];
#pragma unroll
            for (int ns = 0; ns < 4; ++ns) boffr[ns] = BOFF + (fq * 128 + moe_phys(64 * wc2 + 16 * ns + fr)) * 16;
            const int arow0 = 80 * wr4 + fr;
            const bool ga = (80 * wr4) < rows, gb = (80 * wr4 + 48) < rows;
#define M8_LDA(dst_, h_, n_, sb_, ks_) do { _Pragma("unroll") for (int q_ = 0; q_ < (n_); ++q_) { const int r_ = arow0 + 16 * ((h_) * 3 + q_); \
                dst_[q_] = *(const LAS v4i_t*)((sb_) + r_ * 128 + (((4 * (ks_) + fq) ^ ((r_ >> 1) & 7)) * 16)); } } while (0)
#define M8_LDB(dst_, sb_, ks_) do { _Pragma("unroll") for (int ns_ = 0; ns_ < 4; ++ns_) dst_[ns_] = *(const LAS v4i_t*)((sb_) + boffr[ns_] + (ks_) * (4 * 128 * 16)); } while (0)
#define M8_MM(bl_, bh_, al_, ah_, h_, n_) do { _Pragma("unroll") for (int q_ = 0; q_ < (n_); ++q_) _Pragma("unroll") for (int ns_ = 0; ns_ < 4; ++ns_) \
                acc[(h_) * 3 + q_][ns_] = __builtin_amdgcn_mfma_scale_f32_16x16x128_f8f6f4(__builtin_shufflevector(bl_[ns_], bh_[ns_], 0, 1, 2, 3, 4, 5, 6, 7), \
                    __builtin_shufflevector(al_[q_], ah_[q_], 0, 1, 2, 3, 4, 5, 6, 7), acc[(h_) * 3 + q_][ns_], 0, 0, 0, 0, 0, 0); } while (0)
#define M8_COMPUTE(st_) do { LAS unsigned char* sb_ = L + (st_) * STG; if (ga) { v4i_t b0_[4], b1_[4], a0_[3], a1_[3], c0_[2], c1_[2]; \
            M8_LDB(b0_, sb_, 0); M8_LDB(b1_, sb_, 1); M8_LDA(a0_, 0, 3, sb_, 0); M8_LDA(a1_, 0, 3, sb_, 1); __builtin_amdgcn_sched_barrier(0); \
            M8_LDA(c0_, 1, 2, sb_, 0); M8_LDA(c1_, 1, 2, sb_, 1); M8_MM(b0_, b1_, a0_, a1_, 0, 3); __builtin_amdgcn_sched_barrier(0); \
            if (gb) M8_MM(b0_, b1_, c0_, c1_, 1, 2); } } while (0)
#if MK_WSTREAM
            {
                (void)bwave;
                unsigned arow[5]; const char* abase = (const char*)(GU ? H2 : (const unsigned char*)HBUF);
                const unsigned char* wbase = (GU ? WSP(unsigned char, WS_W8GU) + (size_t)e * 4194304 + (size_t)nti * 262144 : WSP(unsigned char, WS_W8D) + (size_t)e * 2097152 + (size_t)nti * 131072) + w * 2048 + lane * 16;
                {
                    const int r0 = w * 8 + (lane >> 3), p = lane & 7;
#pragma unroll
                    for (int i = 0; i < 5; ++i) { const int r = r0 + 64 * i, rr = r < rows ? r : rows - 1;
                        arow[i] = (unsigned)(GU ? ROWTOK[ps + m0 + rr] : (ps + m0 + rr)) * (unsigned)LDAB + (unsigned)((p ^ ((r0 >> 1) & 7)) * 16); }
                }
#define M8_GLDS(st_, tile) do { _Pragma("unroll") for (int i_ = 0; i_ < 5; ++i_) \
                    __builtin_amdgcn_global_load_lds((const unsigned*)(abase + (size_t)((tile) * 128) + arow[i_]), (LAS unsigned*)(L + (st_) * STG + w * 1024 + i_ * 8192), 16, 0, 0); \
                _Pragma("unroll") for (int j_ = 0; j_ < 2; ++j_) \
                    __builtin_amdgcn_global_load_lds((const unsigned*)(wbase + (size_t)(tile) * 16384 + j_ * 1024), (LAS unsigned*)(L + (st_) * STG + BOFF + w * 2048 + j_ * 1024), 16, 0, 0); } while (0)
                M8_GLDS(0, 0);
#define M8_STEP(s) do { asm volatile("s_waitcnt vmcnt(0)" ::: "memory"); __syncthreads(); \
                { const int tn_ = (tt + (s) + 1) < NT ? (tt + (s) + 1) : (NT - 1); M8_GLDS((s) ^ 1, tn_); } \
                M8_COMPUTE(s); } while (0)
                for (int tt = 0; tt < NT; tt += 2) { M8_STEP(0); M8_STEP(1); }
                asm volatile("s_waitcnt vmcnt(0)" ::: "memory");
#undef M8_STEP
#undef M8_GLDS
            }
#else
            if (bwave) {
                int boff[4]; u32x4 stg[16]; const char* bbase; unsigned blane;
                {
                    int n4, kp, scol, isup = 0;
                    if (GU) { const int tg = t & 127; n4 = tg & 15; kp = tg >> 4; isup = w >> 1; scol = 64 * nti; bbase = (const char*)(F.in[isup ? 20 : 19] + (size_t)e * 2048 * 1024 + scol); }
                    else    { n4 = t & 31; kp = t >> 5; scol = 128 * nti; bbase = (const char*)(F.in[21] + (size_t)e * 1024 * 2048 + scol); }
                    blane = (unsigned)(((8 * kp) * LDB + 4 * n4) * 4);
#pragma unroll
                    for (int j = 0; j < 4; ++j) { const int g = 4 * n4 + j; const int s0 = GU ? (64 * (g >> 5) + (g & 31) + 32 * isup) : g;
                        boff[j] = BOFF + ((kp >> 1) * 128 + moe_phys(s0)) * 16 + 8 * (kp & 1); }
                }
#define M8_LOADB(tile) do { _Pragma("unroll") for (int h_ = 0; h_ < 2; ++h_) _Pragma("unroll") for (int i_ = 0; i_ < 8; ++i_) \
                    stg[h_ * 8 + i_] = *(const u32x4*)(bbase + ((size_t)(tile) * 128 + 64 * h_ + i_) * (LDB * 4) + blane); } while (0)
                M8_LOADB(0); __builtin_amdgcn_sched_barrier(0);
#define M8_BSTEP(s) do { LAS unsigned char* sw_ = L + (s) * STG; \
                _Pragma("unroll") for (int h_ = 0; h_ < 2; ++h_) { f32x4 b_[8]; _Pragma("unroll") for (int i_ = 0; i_ < 8; ++i_) b_[i_] = __builtin_bit_cast(f32x4, stg[h_ * 8 + i_]) * 64.f; \
                  _Pragma("unroll") for (int j_ = 0; j_ < 4; ++j_) { u32x2 o_; o_[0] = pk_fp8x4(b_[0][j_], b_[1][j_], b_[2][j_], b_[3][j_]); o_[1] = pk_fp8x4(b_[4][j_], b_[5][j_], b_[6][j_], b_[7][j_]); \
                      *(LAS u32x2*)(sw_ + boff[j_] + h_ * 8192) = o_; } } \
                __builtin_amdgcn_sched_barrier(0); \
                { const int tn_ = (tt + (s) + 1) < NT ? (tt + (s) + 1) : (NT - 1); M8_LOADB(tn_); } \
                __syncthreads(); M8_COMPUTE(s); } while (0)
                for (int tt = 0; tt < NT; tt += 2) { M8_BSTEP(0); M8_BSTEP(1); }
#undef M8_BSTEP
#undef M8_LOADB
            } else {
                unsigned arow[10]; const char* abase = (const char*)(GU ? H2 : (const unsigned char*)HBUF); int ldst0;
                {
                    const int ta = t - 256, r0 = ta >> 3, p = ta & 7;
#pragma unroll
                    for (int i = 0; i < 10; ++i) { const int r = r0 + 32 * i, rr = r < rows ? r : rows - 1;
                        arow[i] = (unsigned)(GU ? ROWTOK[ps + m0 + rr] : (ps + m0 + rr)) * (unsigned)LDAB + (unsigned)((p ^ ((r0 >> 1) & 7)) * 16); }
                    ldst0 = (w - 4) * 8 * 128;
                }
#define M8_GLDSA(st_, tile) do { _Pragma("unroll") for (int i_ = 0; i_ < 10; ++i_) \
                    __builtin_amdgcn_global_load_lds((const unsigned*)(abase + (size_t)((tile) * 128) + arow[i_]), (LAS unsigned*)(L + (st_) * STG + ldst0 + i_ * 4096), 16, 0, 0); } while (0)
                M8_GLDSA(0, 0);
#define M8_ASTEP(s) do { asm volatile("s_waitcnt vmcnt(0)" ::: "memory"); __syncthreads(); \
                { const int tn_ = (tt + (s) + 1) < NT ? (tt + (s) + 1) : (NT - 1); M8_GLDSA((s) ^ 1, tn_); } \
                M8_COMPUTE(s); } while (0)
                for (int tt = 0; tt < NT; tt += 2) { M8_ASTEP(0); M8_ASTEP(1); }
                asm volatile("s_waitcnt vmcnt(0)" ::: "memory");
#undef M8_ASTEP
#undef M8_GLDSA
            }
#endif
#undef M8_COMPUTE
#undef M8_MM
#undef M8_LDB
#undef M8_LDA
            int te = threadIdx.x; asm volatile("" : "+v"(te));
            const int fr_e = te & 15, fq_e = (te >> 4) & 3, wr4_e = (te >> 7) & 3, wc2_e = (te >> 6) & 1;
#pragma unroll
            for (int m = 0; m < 5; ++m) {
                const int row = 80 * wr4_e + 16 * m + fr_e;
                if (row < rows) {
                    const int gpos = ps + m0 + row;
                    if (GU) {
#pragma unroll
                        for (int ns = 0; ns < 2; ++ns) { const f32x4 g = acc[m][ns] * 0.015625f, up = acc[m][ns + 2] * 0.0625f;
                            *(unsigned*)(HBUF + (size_t)gpos * 1024 + 64 * nti + 32 * wc2_e + 16 * ns + 4 * fq_e) =
                                pk_fp8x4(g[0] * sigmoidf_(g[0]) * up[0], g[1] * sigmoidf_(g[1]) * up[1], g[2] * sigmoidf_(g[2]) * up[2], g[3] * sigmoidf_(g[3]) * up[3]); }
                    } else {
                        const int a = ROWMAP[gpos]; const float wt = ROWW[gpos] * 0.00390625f;
#pragma unroll
                        for (int ns = 0; ns < 4; ++ns) { const f32x4 v = acc[m][ns];
                            u32x2 o; o[0] = pk_bf16(v[0] * wt, v[1] * wt); o[1] = pk_bf16(v[2] * wt, v[3] * wt);
                            *(u32x2*)(YBUF + (size_t)a * 2048 + 128 * nti + 64 * wc2_e + 16 * ns + 4 * fq_e) = o; }
                    }
                }
            }
        }
    }
    __syncthreads();
}

template <bool GU>
__device__ __forceinline__ void moe_gemm8w(const Frame& F) {
    constexpr int K = GU ? 2048 : 1024, NT = K / 128, LDAB = GU ? 2048 : 1024;
    constexpr int STG = 65536, BOFF = 49152;
    const int* PST = WSP(int, WS_PANEL); const int* ROWTOK = WSP(int, WS_ROWTOK); const int* ROWMAP = WSP(int, WS_ROWMAP); const float* ROWW = WSP(float, WS_ROWW);
    const unsigned char* H2 = WSP(unsigned char, WS_H2); unsigned char* HBUF = WSP(unsigned char, WS_HBUF); bf16_t* YBUF = WSP(bf16_t, WS_YBUF);
    LAS unsigned char* L = F.lds;
    const int nrounds = (NEXP * 16 + F.nb - 1) / F.nb;
    const char* abase = (const char*)(GU ? H2 : (const unsigned char*)HBUF);
    int c_rnd = 0, c_m0 = 0;
#define M8_GET(ok_, e_, nti_, ps_, m0_, rows_) do { ok_ = false; for (;;) { if (c_rnd >= nrounds) break; int unit_; \
        if ((F.nb & 127) == 0) { const int xcd_ = F.bid & 7, j_ = F.bid >> 3, epx_ = F.nb >> 7; unit_ = ((c_rnd * 8 + xcd_) * epx_ + (j_ >> 4)) * 16 + (j_ & 15); } else unit_ = c_rnd * F.nb + F.bid; \
        if (unit_ >= NEXP * 16) { ++c_rnd; c_m0 = 0; continue; } \
        const int pe_ = PST[unit_ >> 4], me_ = PST[(unit_ >> 4) + 1] - pe_; if (c_m0 >= me_) { ++c_rnd; c_m0 = 0; continue; } \
        e_ = unit_ >> 4; nti_ = unit_ & 15; ps_ = pe_; m0_ = c_m0; rows_ = (me_ - c_m0) < 320 ? (me_ - c_m0) : 320; c_m0 += 320; ok_ = true; break; } } while (0)
#define M8_AROW(dst_, ps_, m0_, rows_) do { int tq_ = threadIdx.x; asm volatile("" : "+v"(tq_)); const int wq_ = __builtin_amdgcn_readfirstlane(tq_ >> 6), r0_ = wq_ * 8 + ((tq_ & 63) >> 3), p_ = tq_ & 7; \
        _Pragma("unroll") for (int i_ = 0; i_ < 5; ++i_) { const int r_ = r0_ + 64 * i_, rr_ = r_ < (rows_) ? r_ : (rows_) - 1; \
            dst_[i_] = (unsigned)(GU ? ROWTOK[(ps_) + (m0_) + rr_] : ((ps_) + (m0_) + rr_)) * (unsigned)LDAB + (unsigned)((p_ ^ ((r0_ >> 1) & 7)) * 16); } } while (0)
#define M8_WBASE(e_, nti_) ((GU ? WSP(unsigned char, WS_W8GU) + (size_t)(e_) * 4194304 + (size_t)(nti_) * 262144 : WSP(unsigned char, WS_W8D) + (size_t)(e_) * 2097152 + (size_t)(nti_) * 131072))
#define M8_GLDS(ar_, wb_, st_, tile) do { int tq_ = threadIdx.x; asm volatile("" : "+v"(tq_)); const int wq_ = __builtin_amdgcn_readfirstlane(tq_ >> 6); \
        _Pragma("unroll") for (int i_ = 0; i_ < 5; ++i_) \
            __builtin_amdgcn_global_load_lds((const unsigned*)(abase + (size_t)((tile) * 128) + ar_[i_]), (LAS unsigned*)(L + (st_) * STG + wq_ * 1024 + i_ * 8192), 16, 0, 0); \
        _Pragma("unroll") for (int j_ = 0; j_ < 2; ++j_) \
            __builtin_amdgcn_global_load_lds((const unsigned*)((wb_) + wq_ * 2048 + (tq_ & 63) * 16 + (size_t)(tile) * 16384 + j_ * 1024), (LAS unsigned*)(L + (st_) * STG + BOFF + wq_ * 2048 + j_ * 1024), 16, 0, 0); } while (0)
    bool hc; int e = 0, nti = 0, ps = 0, m0 = 0, rows = 1;
    M8_GET(hc, e, nti, ps, m0, rows);
    unsigned arow[5]; const unsigned char* wbase = nullptr;
    if (hc) { M8_AROW(arow, ps, m0, rows); wbase = M8_WBASE(e, nti); __syncthreads(); M8_GLDS(arow, wbase, 0, 0); }
    while (hc) {
        bool hn; int en = 0, ntin = 0, psn = 0, m0n = 0, rowsn = 1;
        M8_GET(hn, en, ntin, psn, m0n, rowsn);
        unsigned arown[5]; const unsigned char* wbasen = nullptr;
        if (hn) { M8_AROW(arown, psn, m0n, rowsn); wbasen = M8_WBASE(en, ntin); }
        {
            int tz = threadIdx.x; asm volatile("" : "+v"(tz));
            const int w = __builtin_amdgcn_readfirstlane(tz >> 6), lane = tz & 63, fr = lane & 15, fq = lane >> 4, wr4 = (w >> 1) & 3, wc2 = w & 1;
            f32x4 acc[5][4];
#pragma unroll
            for (int m = 0; m < 5; ++m)
#pragma unroll
                for (int ns = 0; ns < 4; ++ns) acc[m][ns] = (f32x4){0.f, 0.f, 0.f, 0.f};
            int boffr[4];
#pragma unroll
            for (int ns = 0; ns < 4; ++ns) boffr[ns] = BOFF + (fq * 128 + moe_phys(64 * wc2 + 16 * ns + fr)) * 16;
            const int arow0 = 80 * wr4 + fr;
            const bool ga = (80 * wr4) < rows, gb = (80 * wr4 + 48) < rows;
#define M8_LDA(dst_, h_, n_, sb_, ks_) do { _Pragma("unroll") for (int q_ = 0; q_ < (n_); ++q_) { const int r_ = arow0 + 16 * ((h_) * 3 + q_); \
                dst_[q_] = *(const LAS v4i_t*)((sb_) + r_ * 128 + (((4 * (ks_) + fq) ^ ((r_ >> 1) & 7)) * 16)); } } while (0)
#define M8_LDB(dst_, sb_, ks_) do { _Pragma("unroll") for (int ns_ = 0; ns_ < 4; ++ns_) dst_[ns_] = *(const LAS v4i_t*)((sb_) + boffr[ns_] + (ks_) * (4 * 128 * 16)); } while (0)
#define M8_MM(bl_, bh_, al_, ah_, h_, n_) do { _Pragma("unroll") for (int q_ = 0; q_ < (n_); ++q_) _Pragma("unroll") for (int ns_ = 0; ns_ < 4; ++ns_) \
                acc[(h_) * 3 + q_][ns_] = __builtin_amdgcn_mfma_scale_f32_16x16x128_f8f6f4(__builtin_shufflevector(bl_[ns_], bh_[ns_], 0, 1, 2, 3, 4, 5, 6, 7), \
                    __builtin_shufflevector(al_[q_], ah_[q_], 0, 1, 2, 3, 4, 5, 6, 7), acc[(h_) * 3 + q_][ns_], 0, 0, 0, 0, 0, 0); } while (0)
#define M8_COMPUTE(st_) do { LAS unsigned char* sb_ = L + (st_) * STG; if (ga) { v4i_t b0_[4], b1_[4], a0_[3], a1_[3], c0_[2], c1_[2]; \
            M8_LDB(b0_, sb_, 0); M8_LDB(b1_, sb_, 1); M8_LDA(a0_, 0, 3, sb_, 0); M8_LDA(a1_, 0, 3, sb_, 1); __builtin_amdgcn_sched_barrier(0); \
            M8_LDA(c0_, 1, 2, sb_, 0); M8_LDA(c1_, 1, 2, sb_, 1); M8_MM(b0_, b1_, a0_, a1_, 0, 3); __builtin_amdgcn_sched_barrier(0); \
            if (gb) M8_MM(b0_, b1_, c0_, c1_, 1, 2); } } while (0)
#define M8_STEP(s) do { asm volatile("s_waitcnt vmcnt(0)" ::: "memory"); __syncthreads(); \
            { const int tn_ = (tt + (s) + 1) < NT ? (tt + (s) + 1) : (NT - 1); M8_GLDS(arow, wbase, (s) ^ 1, tn_); } \
            M8_COMPUTE(s); } while (0)
            for (int tt = 0; tt < NT; tt += 2) { M8_STEP(0); M8_STEP(1); }
            asm volatile("s_waitcnt vmcnt(0)" ::: "memory");
#undef M8_STEP
#undef M8_COMPUTE
#undef M8_MM
#undef M8_LDB
#undef M8_LDA
            if (hn) { __builtin_amdgcn_sched_barrier(0); M8_GLDS(arown, wbasen, 0, 0); __builtin_amdgcn_sched_barrier(0); }
            int te = threadIdx.x; asm volatile("" : "+v"(te));
            const int fr_e = te & 15, fq_e = (te >> 4) & 3, wr4_e = (te >> 7) & 3, wc2_e = (te >> 6) & 1;
#pragma unroll
            for (int m = 0; m < 5; ++m) {
                const int row = 80 * wr4_e + 16 * m + fr_e;
                if (row < rows) {
                    const int gpos = ps + m0 + row;
                    if (GU) {
                        u32x2 o8;
#pragma unroll
                        for (int ns = 0; ns < 2; ++ns) { const f32x4 g = acc[m][ns] * 0.015625f, up = acc[m][ns + 2] * 0.0625f;
                            o8[ns] = pk_fp8x4(g[0] * sigmoidf_(g[0]) * up[0], g[1] * sigmoidf_(g[1]) * up[1], g[2] * sigmoidf_(g[2]) * up[2], g[3] * sigmoidf_(g[3]) * up[3]); }
                        *(u32x2*)(HBUF + (size_t)gpos * 1024 + 64 * nti + 32 * wc2_e + 8 * fq_e) = o8;
                    } else {
                        const int a = ROWMAP[gpos]; const float wt = ROWW[gpos] * 0.00390625f;
#pragma unroll
                        for (int nh = 0; nh < 2; ++nh) { const f32x4 v0 = acc[m][2 * nh], v1 = acc[m][2 * nh + 1];
                            u32x4 o; o[0] = pk_bf16(v0[0] * wt, v0[1] * wt); o[1] = pk_bf16(v0[2] * wt, v0[3] * wt); o[2] = pk_bf16(v1[0] * wt, v1[1] * wt); o[3] = pk_bf16(v1[2] * wt, v1[3] * wt);
                            *(u32x4*)(YBUF + (size_t)a * 2048 + 128 * nti + 64 * wc2_e + 32 * nh + 8 * fq_e) = o; }
                    }
                }
            }
        }
        hc = hn; e = en; nti = ntin; ps = psn; m0 = m0n; rows = rowsn; wbase = wbasen;
#pragma unroll
        for (int i = 0; i < 5; ++i) arow[i] = arown[i];
    }
#undef M8_GLDS
#undef M8_WBASE
#undef M8_AROW
#undef M8_GET
    __syncthreads();
}

__device__ __forceinline__ void p11_final(const Frame& F) {
    const float* X1 = DBG_ONLY_X ? F.in[0] : WSP(float, WS_X1); const float* mod = WSP(float, WS_MOD); const bf16_t* Y = WSP(bf16_t, WS_YBUF); const float* fg = F.in[22];
    for (int row = F.bid * 8 + F.wave; row < T; row += F.nb * 8) {
        const float* g2 = mod + (size_t)(row / SEQ) * 12288 + 5 * 2048;
        f32x4 v[8]; float ss = 0.f;
#pragma unroll
        for (int i = 0; i < 8; ++i) { const int col = (i * 64 + F.lane) * 4;
            const f32x4 xv = *(const f32x4*)(X1 + (size_t)row * D + col), gv = *(const f32x4*)(g2 + col);
#if DBG_NO_MOE
            const u32x2 y0 = (u32x2){0u, 0u}, y1 = y0; (void)Y;
#else
            const u32x2 y0 = *(const u32x2*)(Y + (size_t)(2 * row) * D + col), y1 = *(const u32x2*)(Y + (size_t)(2 * row + 1) * D + col);
#endif
            v[i] = (f32x4){xv[0] + gv[0] * (bf_lo(y0[0]) + bf_lo(y1[0])), xv[1] + gv[1] * (bf_hi(y0[0]) + bf_hi(y1[0])), xv[2] + gv[2] * (bf_lo(y0[1]) + bf_lo(y1[1])), xv[3] + gv[3] * (bf_hi(y0[1]) + bf_hi(y1[1]))};
            ss += v[i][0] * v[i][0] + v[i][1] * v[i][1] + v[i][2] * v[i][2] + v[i][3] * v[i][3]; }
        ss = wave_sum(ss);
        const float rs = rsqrtf(ss * (1.f / D) + EPS);
#pragma unroll
        for (int i = 0; i < 8; ++i) { const int col = (i * 64 + F.lane) * 4; const f32x4 g = *(const f32x4*)(fg + col);
            *(f32x4*)(F.out + (size_t)row * D + col) = (f32x4){v[i][0] * rs * g[0], v[i][1] * rs * g[1], v[i][2] * rs * g[2], v[i][3] * rs * g[3]}; }
    }
}

constexpr int N_PHASES = 12;
__global__ __launch_bounds__(512, 2) void mk_fwd(Args a) {
    extern __shared__ __attribute__((aligned(16))) unsigned char lds_raw[];
    Frame F;
    F.in = a.in; F.out = a.out; F.ws = a.ws; F.lds = (LAS unsigned char*)lds_raw;
    F.tid = threadIdx.x; F.lane = F.tid & 63; F.wave = __builtin_amdgcn_readfirstlane(F.tid >> 6); F.bid = blockIdx.x; F.nb = gridDim.x;
    const int lo = a.ph_lo, hi = a.ph_hi;
    XcdBarrier bar; bar.bar = (unsigned*)(a.ws + WS_CTL); bar.x = 0; bar.st = nullptr;
    if (hi - lo > 1) {
        if (F.tid == 0) *(LAS u32x4*)(F.lds + LDS_BAR_OFF) = (u32x4){0u, 0u, 0u, 0u};
        __syncthreads();
        bar = xcd_barrier_post((unsigned*)(a.ws + WS_CTL), (volatile LAS unsigned*)(F.lds + LDS_BAR_OFF));
    }
#define IN(k) (lo <= (k) && (k) < hi)
#define SEAM(k) do { if (IN(k) && IN((k) + 1)) xcd_barrier(bar); { int tz_ = threadIdx.x; asm volatile("" : "+v"(tz_)); F.tid = tz_; F.lane = tz_ & 63; } } while (0)
    pg8::WStream W{F.in[19], F.in[20], F.in[21], WSP(unsigned char, WS_W8GU), WSP(unsigned char, WS_W8D), 0, 0, 0};
    { const int per = (pg8::WS_STEPS + F.nb - 1) / F.nb; W.gs0 = F.bid * per; W.n = per; if (W.gs0 + W.n > pg8::WS_STEPS) W.n = pg8::WS_STEPS - W.gs0; if (W.n < 0) W.n = 0; if (!MK_WSTREAM) W.n = 0; W.n0 = W.n; }
#define WS_ADV(d_) do { int d__ = (d_); if (d__ > W.n) d__ = W.n; W.gs0 += d__; W.n -= d__; } while (0)
#define WS_CATCHUP(rem_) do { while (W.n > (rem_)) { f32x4 r_[4]; pg8::ws_issue(W, 0, r_); pg8::ws_flush(W, 0, r_); WS_ADV(1); } } while (0)
    if (IN(0)) { p0_mod_partials(F); p0_tables(F); p0_convert(F); if (DBG_DBL == 0) { p0_mod_partials(F); p0_tables(F); p0_convert(F); } }
    SEAM(0);
    if (IN(1)) { p1_norm1(F); if (DBG_DBL == 1) p1_norm1(F); }
    SEAM(1);
    if (IN(2)) {
        pg8::Gemm g{WSP(bf16_t, WS_ABF), WSP(bf16_t, WS_BTIN), MK_FP8_INPROJ ? 1024 : 2048};
        InProjOrder S; S.init(F.nb, F.bid);
        EpiInProj E{WSP(bf16_t, WS_QM), WSP(bf16_t, WS_OMS), WSP(bf16_t, WS_QA), WSP(bf16_t, WS_GBRS), WSP(bf16_t, WS_KM), WSP(bf16_t, WS_VM), WSP(bf16_t, WS_KA), WSP(bf16_t, WS_VAT), WSP(float, WS_GM), WSP(float, WS_ROPE), MK_FP8_INPROJ ? 0.015625f : 1.f};
#if MK_FP8_GATES && !MK_FP8_INPROJ
        { MaskOrder S2; S2.init(~MK_F8MASK & ((1ull << 53) - 1), ~MK_F8CTX & ((1ull << 53) - 1), F.nb, F.bid); const int d_ = pg8::gemm_phase<EpiInProj, MaskOrder, false, MK_WSTREAM != 0>(F.lds, g, S2, E, W); WS_ADV(d_); }
        { pg8::Gemm g8{WSP(bf16_t, WS_ABF8), WSP(bf16_t, WS_BTIN8), 1024}; MaskOrder S8; S8.init(MK_F8MASK, MK_F8CTX, F.nb, F.bid); EpiInProj E8 = E; E8.fs = 0.015625f;
          const int d_ = pg8::gemm_phase<EpiInProj, MaskOrder, true, MK_WSTREAM != 0>(F.lds, g8, S8, E8, W); WS_ADV(d_); }
        WS_CATCHUP(W.n0 / 4);
#else
        pg8::gemm_phase<EpiInProj, InProjOrder, MK_FP8_INPROJ != 0>(F.lds, g, S, E);
#endif
        if (DBG_DBL == 2) pg8::gemm_phase<EpiInProj, InProjOrder, MK_FP8_INPROJ != 0>(F.lds, g, S, E);
    }
    SEAM(2);
    if (IN(3)) { p3_mlstm(F); if (DBG_DBL == 30) p3_mlstm(F); p3_attn(F); if (DBG_DBL == 31) p3_attn(F); }
    SEAM(3);
    if (IN(4)) { p4_postmix(F); if (DBG_DBL == 4) p4_postmix(F); }
    SEAM(4);
    if (IN(5)) {
        pg8::StaticOrder S; S.init(T, 2048, F.nb, F.bid);
        { pg8::Gemm g{WSP(bf16_t, WS_AM), WSP(bf16_t, WS_BTBRM), MK_FP8_MIX ? 1024 : 2048}; EpiBr1 E{WSP(float, WS_TMP), WSP(bf16_t, WS_GBRS)}; const int d_ = pg8::gemm_phase<EpiBr1, pg8::StaticOrder, MK_FP8_MIX != 0, MK_WSTREAM != 0>(F.lds, g, S, E, W); WS_ADV(d_); }
        { pg8::Gemm g{WSP(bf16_t, WS_AO), WSP(bf16_t, WS_BTBRA), MK_FP8_MIX ? 1024 : 2048}; EpiBr2 E{WSP(float, WS_TMP), WSP(bf16_t, WS_GBRS), WSP(bf16_t, WS_AOUT)}; const int d_ = pg8::gemm_phase<EpiBr2, pg8::StaticOrder, MK_FP8_MIX != 0, MK_WSTREAM != 0>(F.lds, g, S, E, W); WS_ADV(d_); }
        if (DBG_DBL == 5) { { pg8::Gemm g{WSP(bf16_t, WS_AM), WSP(bf16_t, WS_BTBRM), MK_FP8_MIX ? 1024 : 2048}; EpiBr1 E{WSP(float, WS_TMP), WSP(bf16_t, WS_GBRS)}; pg8::gemm_phase<EpiBr1, pg8::StaticOrder, MK_FP8_MIX != 0>(F.lds, g, S, E); }
            { pg8::Gemm g{WSP(bf16_t, WS_AO), WSP(bf16_t, WS_BTBRA), MK_FP8_MIX ? 1024 : 2048}; EpiBr2 E{WSP(float, WS_TMP), WSP(bf16_t, WS_GBRS), WSP(bf16_t, WS_AOUT)}; pg8::gemm_phase<EpiBr2, pg8::StaticOrder, MK_FP8_MIX != 0>(F.lds, g, S, E); } }
    }
    SEAM(5);
    if (IN(6)) {
        pg8::StaticOrder S; S.init(T, 2048, F.nb, F.bid);
        pg8::Gemm g{WSP(bf16_t, WS_AOUT), WSP(bf16_t, WS_BTOUT), MK_FP8_MIX ? 1024 : 2048}; EpiOut E{F.in[0], WSP(float, WS_MOD), WSP(float, WS_X1), WSP(float, WS_RSS)}; { const int d_ = pg8::gemm_phase<EpiOut, pg8::StaticOrder, MK_FP8_MIX != 0, MK_WSTREAM != 0>(F.lds, g, S, E, W); WS_ADV(d_); }
        WS_CATCHUP(0);
        if (DBG_DBL == 6) pg8::gemm_phase<EpiOut, pg8::StaticOrder, MK_FP8_MIX != 0>(F.lds, g, S, E);
    }
    SEAM(6);
    if (IN(7)) { p7_norm2_router(F); if (DBG_DBL == 7) { for (int rep_ = 0; rep_ < 4; ++rep_) p7_norm2_router<true>(F); } }
    SEAM(7);
    if (IN(8)) { p8_lists(F); }
    SEAM(8);
    if (IN(9)) { if (MK_FP8_MOE && MK_WSTREAM) moe_gemm8w<true>(F); else if (MK_FP8_MOE) moe_gemm8<true>(F); else moe_gemm<true>(F); if (DBG_DBL == 9) moe_gemm<true>(F); if (DBG_DBL >= 92 && DBG_DBL <= 96) moe_gemm<true, DBG_DBL - 90>(F); }
    SEAM(9);
    if (IN(10)) { if (MK_FP8_MOE && MK_WSTREAM) moe_gemm8w<false>(F); else if (MK_FP8_MOE) moe_gemm8<false>(F); else moe_gemm<false>(F); if (DBG_DBL == 10) moe_gemm<false>(F); }
    SEAM(10);
    if (IN(11)) { p11_final(F); if (DBG_DBL == 11) p11_final(F); }
#undef IN
#undef SEAM
#undef WS_ADV
#undef WS_CATCHUP
}

extern "C" void kernel_launch(void* const* d_in, const int* in_sizes, int n_in, void* d_out, int out_size, void* d_ws, size_t ws_size, hipStream_t stream) {
    static int grid = 0;
    if (grid == 0) {
        if (n_in != 23 || out_size != T * D || ws_size < WS_END) { fprintf(stderr, "kernel_launch: unexpected problem (n_in %d, out %d, ws %zu < %zu)\n", n_in, out_size, ws_size, (size_t)WS_END); grid = -1; return; }
        int dev = 0, cus = 0, per_cu = 0;
        if (hipGetDevice(&dev) != hipSuccess || hipDeviceGetAttribute(&cus, hipDeviceAttributeMultiprocessorCount, dev) != hipSuccess) { grid = -1; return; }
        if (hipFuncSetAttribute((const void*)mk_fwd, hipFuncAttributeMaxDynamicSharedMemorySize, LDS_BYTES) != hipSuccess) { fprintf(stderr, "kernel_launch: hipFuncSetAttribute failed\n"); grid = -1; return; }
        if (hipOccupancyMaxActiveBlocksPerMultiprocessor(&per_cu, (const void*)mk_fwd, NT, LDS_BYTES) != hipSuccess || per_cu < 1) fprintf(stderr, "kernel_launch: occupancy query reports %d\n", per_cu);
        (void)hipGetLastError();
        grid = cus;
    }
    if (grid < 0) return;
    (void)hipMemsetAsync((char*)d_ws + WS_CTL, 0, CTL_BYTES, stream);
    Args a{};
    for (int i = 0; i < 23; ++i) a.in[i] = (const float*)d_in[i];
    a.out = (float*)d_out; a.ws = (unsigned char*)d_ws;
#if MK_ONE_LAUNCH
    a.ph_lo = 0; a.ph_hi = N_PHASES;
    hipLaunchKernelGGL(mk_fwd, dim3(grid), dim3(NT), LDS_BYTES, stream, a);
#else
    for (int p = 0; p < N_PHASES; ++p) { if (DBG_NO_MOE && p >= 7 && p <= 10) continue; if (DBG_ONLY_X && p != 1 && p != 0 && p != 11) continue; a.ph_lo = p; a.ph_hi = p + 1; hipLaunchKernelGGL(mk_fwd, dim3(grid), dim3(NT), LDS_BYTES, stream, a); }
#endif
}
```
